# Optimizing an MI355X kernel written in HIP

```python
import math
import jax, jax.numpy as jnp
from jax import lax
import numpy as np

D_MODEL = 4096
BATCH = 2
SEQ = 8192
DEPTH = 2

GRID_W = 64
CTX_LEN = 256
EPS = 1e-6
N_MOD = 6
CONV_WIDTH = 3
CONV_DIM = 2048
DA_HEADS = 16
DA_QK = 64
DA_V = 2 * DA_QK
DA_QK_WIDTH = DA_HEADS * 2 * DA_QK
DA_V_WIDTH = DA_HEADS * DA_V
Q_BLOCK = 128
ROPE_THETA = 10000.0
CHUNK = 128
MLP_DIM = 2048
MLP_GROUPS = 16
MLP_GROUP_DIM = MLP_DIM // MLP_GROUPS
IN_SIZES = (CONV_DIM, CONV_DIM, CONV_DIM,
            DA_QK_WIDTH, DA_QK_WIDTH, DA_V_WIDTH,
            MLP_DIM, MLP_DIM,
            D_MODEL, D_MODEL, D_MODEL)
IN_DIM = sum(IN_SIZES)
FFN_HIDDEN = ((8 * D_MODEL + 3 * 256 - 1) // (3 * 256)) * 256

kernel_name = "hybrid_conv_diffattn_gmlp_dit_block"


def _rms(x, g):
    xf = x.astype(jnp.float32)
    xf = xf * lax.rsqrt(jnp.mean(xf * xf, axis=-1, keepdims=True) + EPS)
    return (xf * g.astype(jnp.float32)).astype(x.dtype)


def _axial_rope_tables(rows):
    row = jnp.repeat(jnp.arange(rows, dtype=jnp.float32), GRID_W)
    col = jnp.tile(jnp.arange(GRID_W, dtype=jnp.float32), rows)
    pairs = DA_QK // 4
    inv = ROPE_THETA ** (-jnp.arange(pairs, dtype=jnp.float32) / pairs)
    ang = jnp.concatenate([row[:, None] * inv, col[:, None] * inv], axis=-1)
    return jnp.cos(ang), jnp.sin(ang)


def _rope(x, cos, sin):
    half = DA_QK // 2
    cs = cos[None, :, None, None, :].astype(x.dtype)
    sn = sin[None, :, None, None, :].astype(x.dtype)
    x1, x2 = x[..., :half], x[..., half:]
    return jnp.concatenate([x1 * cs - x2 * sn, x2 * cs + x1 * sn], axis=-1)


def _in_proj(h, g, shift, scale, w_in):
    xn = _rms(h, g) * (1.0 + scale) + shift
    z = xn @ w_in
    return jnp.split(z, list(np.cumsum(IN_SIZES)[:-1]), axis=-1)


def _attn_qkv(q, k, v, q_g, k_g, cos, sin):
    b, n, _ = q.shape
    q = _rms(q.reshape(b, n, DA_HEADS, 2, DA_QK), q_g)
    k = _rms(k.reshape(b, n, DA_HEADS, 2, DA_QK), k_g)
    if cos is not None:
        q = _rope(q, cos, sin)
        k = _rope(k, cos, sin)
    return q, k, v.reshape(b, n, DA_HEADS, DA_V)


def _diff_core(q, k, v, lam):
    s = jnp.einsum('bqhmd,bkhmd->bmhqk', q, k, preferred_element_type=jnp.float32) * (DA_QK ** -0.5)
    p = jax.nn.softmax(s, axis=-1)
    w = p[:, 0] - lam * p[:, 1]
    return jnp.einsum('bhqk,bkhd->bqhd', w, v.astype(jnp.float32)).astype(v.dtype)


def _diff_attn_latent(q, k_all, v_all, lam):
    b, n = q.shape[:2]
    qb = q.reshape(b, n // Q_BLOCK, Q_BLOCK, DA_HEADS, 2, DA_QK).transpose(1, 0, 2, 3, 4, 5)
    o = lax.map(lambda qblk: _diff_core(qblk, k_all, v_all, lam), qb)
    return o.transpose(1, 0, 2, 3, 4).reshape(b, n, DA_HEADS, DA_V)


def _short_conv(bg, cg, xin, w, bias):
    z = cg * xin
    n = z.shape[1]
    zp = jnp.pad(z, ((0, 0), (1, 1), (0, 0)))
    y = zp[:, 0:n] * w[0] + zp[:, 1:n + 1] * w[1] + zp[:, 2:n + 2] * w[2] + bias
    return bg * y


def _chunk_mlp(u, v, g_norm, w_s, b_s):
    u = jax.nn.gelu(u)
    v = _rms(jax.nn.gelu(v), g_norm)
    b, n, _ = v.shape
    vc = v.reshape(b, n // CHUNK, CHUNK, MLP_GROUPS, MLP_GROUP_DIM)
    s = jnp.einsum('gpq,bnqgc->bnpgc', w_s, vc) + b_s.T[None, None, :, :, None]
    return u * s.reshape(b, n, MLP_DIM)


def _mixer_out(parts, attn_o, lam_init, conv_w, conv_b, w_out_conv, subln_g, w_out_attn,
               mlp_norm_g, w_spatial, b_spatial, w_out_mlp, w_o):
    bg, cg, xin, _, _, _, u, v, ga, gb, gc = parts
    b, n = attn_o.shape[:2]
    y_conv = _short_conv(bg, cg, xin, conv_w, conv_b) @ w_out_conv
    o = (_rms(attn_o, subln_g) * (1.0 - lam_init)).reshape(b, n, DA_V_WIDTH)
    y_attn = o @ w_out_attn
    y_mlp = _chunk_mlp(u, v, mlp_norm_g, w_spatial, b_spatial) @ w_out_mlp
    y = jax.nn.sigmoid(ga) * y_conv + jax.nn.sigmoid(gb) * y_attn + jax.nn.sigmoid(gc) * y_mlp
    return y @ w_o


def _swiglu(h, g, shift, scale, w_gate, w_up, w_down):
    xn = _rms(h, g) * (1.0 + scale) + shift
    return (jax.nn.silu(xn @ w_gate) * (xn @ w_up)) @ w_down


def setup_inputs(seed: int = 0) -> dict:
    key = jax.random.key(seed)
    ks = jax.random.split(key, 26)
    f32 = jnp.float32

    def nrm(k, shape, scale):
        return jax.random.normal(k, shape, f32) * scale

    L, D = DEPTH, D_MODEL
    return {
        "x": nrm(ks[0], (BATCH, SEQ, D), 1.0),
        "c": nrm(ks[1], (BATCH, D), 1.0),
        "ctx": nrm(ks[2], (BATCH, CTX_LEN, D), 1.0),
        "c_ctx": nrm(ks[3], (D,), 1.0),
        "ada_w": nrm(ks[4], (L, D, N_MOD * D), 0.5 * D ** -0.5),
        "ada_b": nrm(ks[5], (L, N_MOD * D), 0.01),
        "norm_mix_g": 1.0 + nrm(ks[6], (L, D), 0.02),
        "norm_ffn_g": 1.0 + nrm(ks[7], (L, D), 0.02),
        "w_in": nrm(ks[8], (L, D, IN_DIM), D ** -0.5),
        "conv_w": nrm(ks[9], (L, CONV_WIDTH, CONV_DIM), CONV_WIDTH ** -0.5),
        "conv_b": nrm(ks[10], (L, CONV_DIM), 0.01),
        "w_out_conv": nrm(ks[11], (L, CONV_DIM, D), CONV_DIM ** -0.5),
        "q_norm_g": 1.0 + nrm(ks[12], (L, DA_QK), 0.02),
        "k_norm_g": 1.0 + nrm(ks[13], (L, DA_QK), 0.02),
        "lambda_qk": nrm(ks[14], (L, 4, DA_QK), 0.1),
        "subln_g": 1.0 + nrm(ks[15], (L, DA_V), 0.02),
        "w_out_attn": nrm(ks[16], (L, DA_V_WIDTH, D), DA_V_WIDTH ** -0.5),
        "mlp_norm_g": 1.0 + nrm(ks[17], (L, MLP_DIM), 0.02),
        "w_spatial": nrm(ks[18], (L, MLP_GROUPS, CHUNK, CHUNK), 0.5 * CHUNK ** -0.5),
        "b_spatial": 1.0 + nrm(ks[19], (L, MLP_GROUPS, CHUNK), 0.01),
        "w_out_mlp": nrm(ks[20], (L, MLP_DIM, D), MLP_DIM ** -0.5),
        "w_o": nrm(ks[21], (L, D, D), D ** -0.5),
        "w_ffn_gate": nrm(ks[22], (L, D, FFN_HIDDEN), D ** -0.5),
        "w_ffn_up": nrm(ks[23], (L, D, FFN_HIDDEN), D ** -0.5),
        "w_ffn_down": nrm(ks[24], (L, FFN_HIDDEN, D), FFN_HIDDEN ** -0.5),
    }


def reference(x, c, ctx, c_ctx, ada_w, ada_b, norm_mix_g, norm_ffn_g, w_in, conv_w, conv_b,
              w_out_conv, q_norm_g, k_norm_g, lambda_qk, subln_g, w_out_attn, mlp_norm_g,
              w_spatial, b_spatial, w_out_mlp, w_o, w_ffn_gate, w_ffn_up, w_ffn_down):
    rows = x.shape[1] // GRID_W
    cos, sin = _axial_rope_tables(rows)
    h, hc = x, ctx
    for i in range(DEPTH):
        last = i == DEPTH - 1
        lam_init = 0.8 - 0.6 * math.exp(-0.3 * i)
        lq = lambda_qk[i].astype(jnp.float32)
        lam = jnp.exp(jnp.sum(lq[0] * lq[1])) - jnp.exp(jnp.sum(lq[2] * lq[3])) + lam_init

        mod = (jax.nn.silu(c) @ ada_w[i] + ada_b[i])[:, None, :]
        mod_c = (jax.nn.silu(c_ctx) @ ada_w[i] + ada_b[i])[None, None, :]
        sh1, sc1, g1, sh2, sc2, g2 = jnp.split(mod, N_MOD, axis=-1)
        ch1, cs1, cg1, ch2, cs2, cg2 = jnp.split(mod_c, N_MOD, axis=-1)

        parts_x = _in_proj(h, norm_mix_g[i], sh1, sc1, w_in[i])
        parts_c = _in_proj(hc, norm_mix_g[i], ch1, cs1, w_in[i])
        qx, kx, vx = _attn_qkv(parts_x[3], parts_x[4], parts_x[5], q_norm_g[i], k_norm_g[i], cos, sin)
        qc, kc, vc = _attn_qkv(parts_c[3], parts_c[4], parts_c[5], q_norm_g[i], k_norm_g[i], None, None)
        k_all = jnp.concatenate([kx, kc], axis=1)
        v_all = jnp.concatenate([vx, vc], axis=1)
        attn_x = _diff_attn_latent(qx, k_all, v_all, lam)

        h_new = h + g1 * _mixer_out(parts_x, attn_x, lam_init, conv_w[i], conv_b[i], w_out_conv[i],
                                     subln_g[i], w_out_attn[i], mlp_norm_g[i], w_spatial[i],
                                     b_spatial[i], w_out_mlp[i], w_o[i])
        h_new = h_new + g2 * _swiglu(h_new, norm_ffn_g[i], sh2, sc2, w_ffn_gate[i], w_ffn_up[i], w_ffn_down[i])

        if not last:
            attn_c = _diff_core(qc, kc, vc, lam)
            hc = hc + cg1 * _mixer_out(parts_c, attn_c, lam_init, conv_w[i], conv_b[i], w_out_conv[i],
                                       subln_g[i], w_out_attn[i], mlp_norm_g[i], w_spatial[i],
                                       b_spatial[i], w_out_mlp[i], w_o[i])
            hc = hc + cg2 * _swiglu(hc, norm_ffn_g[i], ch2, cs2, w_ffn_gate[i], w_ffn_up[i], w_ffn_down[i])
        h = h_new
    return h
```

```cpp
#include <hip/hip_runtime.h>
#include <hip/hip_bf16.h>
#include <cstdio>
#include <cstdint>

constexpr int DM = 4096, NBATCH = 2, SEQ = 8192, CTXL = 256, DEPTH = 2;
constexpr int ML = NBATCH * SEQ, MC = NBATCH * CTXL, MT = ML + MC;
constexpr int IN_DIM = 28672, FF = 11008, NMOD = 6 * DM;
constexpr int ZC_BG = 0, ZC_CG = 2048, ZC_XIN = 4096, ZC_Q = 6144, ZC_K = 8192, ZC_V = 10240, ZC_U = 12288, ZC_VM = 14336, ZC_GATE = 16384;
constexpr float EPS = 1e-6f;
constexpr int NTM = MT / 256;

namespace pg8 {
#define PG8_LAS __attribute__((address_space(3)))
typedef unsigned short bf16_t;
typedef short bf16x8 __attribute__((ext_vector_type(8)));
typedef float f32x4 __attribute__((ext_vector_type(4)));
typedef unsigned u32x4 __attribute__((ext_vector_type(4)));
constexpr int BM = 256, BK = 64, HALF = 128, HTB = HALF * BK * 2  , STAGE_BYTES = 8 * HTB, NXCD = 8, WGM = 8;

__host__ __device__ __forceinline__ int lds_byte(int r, int c) { const int st = (r >> 4) * 2 + (c >> 5), rr = r & 15, cc = c & 31, ob = rr * 64 + cc * 2; return st * 1024 + (ob ^ (((ob >> 9) & 1) << 5)); }
__host__ __device__ __forceinline__ void stage_rc(int b, int& R, int& C) { const int st = b / 1024, sb = b % 1024, swz = sb ^ (((sb >> 9) & 1) << 5); R = (st >> 1) * 16 + swz / 64; C = (st & 1) * 32 + (swz % 64) / 2; }
__host__ __device__ __forceinline__ int perm32(int rho) { const int n = rho >> 4, i = rho & 15; return 8 * (i >> 2) + 4 * n + (i & 3); }

struct Unit { int pm, pn; };
struct Gemm { const bf16_t* A; const bf16_t* Bt; int M, N, K; };

struct StaticOrder {
    int nM, nN, nwg, G, c;
    __host__ __device__ void init(int M, int N, int G_, int c_) { nM = M / BM; nN = N / BM; nwg = nM * nN; G = G_; c = c_; }
    __host__ __device__ bool next(int i, Unit& u) const {
        const long L = (long)i * G + c; if (L >= nwg) return false;
        int wgid = (int)L; { const int q = nwg / NXCD, r = nwg % NXCD, xcd = wgid % NXCD, off = wgid / NXCD; wgid = (xcd < r ? xcd * (q + 1) : r * (q + 1) + (xcd - r) * q) + off; }
        const int nig = WGM * nN, gid = wgid / nig, fm = gid * WGM, gsz = (nM - fm) < WGM ? (nM - fm) : WGM;
        u.pm = fm + ((wgid % nig) % gsz); u.pn = (wgid % nig) / gsz; return true;
    }
    __device__ __forceinline__ void a_ready(const Unit&) const {}
    __device__ __forceinline__ void done(const Unit&) const {}
};

__device__ __forceinline__ unsigned cvt_pk_bf16(float lo, float hi) { unsigned r; asm volatile("v_cvt_pk_bf16_f32 %0, %1, %2" : "=v"(r) : "v"(lo), "v"(hi)); return r; }
typedef float f32x2 __attribute__((ext_vector_type(2)));
__device__ __forceinline__ float fsigmoid(float x) { return __builtin_amdgcn_rcpf(1.f + __builtin_amdgcn_exp2f(-1.4426950408889634f * x)); }
__device__ __forceinline__ float fgelu(float x) { const float t = x * (1.f + 0.044715f * x * x); return x * __builtin_amdgcn_rcpf(1.f + __builtin_amdgcn_exp2f(-2.3022081981f * t)); }
__device__ __forceinline__ float bflo(unsigned w) { return __uint_as_float(w << 16); }
__device__ __forceinline__ float bfhi(unsigned w) { return __uint_as_float(w & 0xffff0000u); }

struct EpiZ {
    static constexpr bool PERM = true, AFTER_DRAIN = false;
    bf16_t* Z;
    __device__ __forceinline__ void operator()(const f32x4 (&acc)[2][2][4][2], const Unit& u, int wr, int wc, int fr, int fq) const {
        const int row0 = u.pm * BM + wr * 64 + fr, col0 = u.pn * BM + wc * 32 + 8 * fq;
        const int mode = u.pn < 48 ? 0 : (u.pn < 64 ? 1 : 2);
#pragma unroll
        for (int ai = 0; ai < 2; ++ai)
#pragma unroll
            for (int m = 0; m < 4; ++m) { bf16_t* rowp = Z + (size_t)(row0 + ai * HALF + m * 16) * IN_DIM + col0;
#pragma unroll
                for (int bj = 0; bj < 2; ++bj) { f32x4 v0 = acc[ai][bj][m][0], v1 = acc[ai][bj][m][1];
                    if (mode == 1) {
#pragma unroll
                        for (int e = 0; e < 4; ++e) { v0[e] = fgelu(v0[e]); v1[e] = fgelu(v1[e]); } }
                    else if (mode == 2) {
#pragma unroll
                        for (int e = 0; e < 4; ++e) { v0[e] = fsigmoid(v0[e]); v1[e] = fsigmoid(v1[e]); } }
                    u32x4 w; w.x = cvt_pk_bf16(v0[0], v0[1]); w.y = cvt_pk_bf16(v0[2], v0[3]); w.z = cvt_pk_bf16(v1[0], v1[1]); w.w = cvt_pk_bf16(v1[2], v1[3]);
                    *(u32x4*)(rowp + bj * HALF) = w; } }
    }
};

struct EpiBr {
    static constexpr bool PERM = true, AFTER_DRAIN = false;
    const bf16_t* Z; float* YF; bf16_t* Y;
    __device__ __forceinline__ void operator()(const f32x4 (&acc)[2][2][4][2], const Unit& u, int wr, int wc, int fr, int fq) const {
        const int br = u.pm / NTM, pm = u.pm - br * NTM, pn = u.pn - br * 16;
        const int row0 = pm * BM + wr * 64 + fr, col0 = pn * BM + wc * 32 + 8 * fq;
#pragma unroll
        for (int ai = 0; ai < 2; ++ai)
#pragma unroll
            for (int m = 0; m < 4; ++m) { const size_t row = (size_t)(row0 + ai * HALF + m * 16);
#pragma unroll
                for (int bj = 0; bj < 2; ++bj) { const int col = col0 + bj * HALF;
                    const u32x4 g = *(const u32x4*)(Z + row * IN_DIM + ZC_GATE + br * DM + col);
                    f32x4 v0 = acc[ai][bj][m][0], v1 = acc[ai][bj][m][1];
                    v0[0] *= bflo(g.x); v0[1] *= bfhi(g.x); v0[2] *= bflo(g.y); v0[3] *= bfhi(g.y);
                    v1[0] *= bflo(g.z); v1[1] *= bfhi(g.z); v1[2] *= bflo(g.w); v1[3] *= bfhi(g.w);
                    float* yp = YF + row * DM + col;
                    if (br > 0) { v0 += *(const f32x4*)yp; v1 += *(const f32x4*)(yp + 4); }
                    if (br < 2) { *(f32x4*)yp = v0; *(f32x4*)(yp + 4) = v1; }
                    else { u32x4 w; w.x = cvt_pk_bf16(v0[0], v0[1]); w.y = cvt_pk_bf16(v0[2], v0[3]); w.z = cvt_pk_bf16(v1[0], v1[1]); w.w = cvt_pk_bf16(v1[2], v1[3]);
                        *(u32x4*)(Y + row * DM + col) = w; } } }
    }
};

struct EpiRes {
    static constexpr bool PERM = false, AFTER_DRAIN = false;
    const float* src_lat; const float* src_ctx; float* dst_lat; float* dst_ctx; const float* gvec;
    __device__ __forceinline__ void operator()(const f32x4 (&acc)[2][2][4][2], const Unit& u, int wr, int wc, int fr, int fq) const {
        const int pm = u.pm, cls = pm < 32 ? 0 : (pm < 64 ? 1 : 2);
        const float* src = pm < 64 ? src_lat + (size_t)pm * BM * DM : src_ctx + (size_t)(pm - 64) * BM * DM;
        float* dst = pm < 64 ? dst_lat + (size_t)pm * BM * DM : dst_ctx + (size_t)(pm - 64) * BM * DM;
        const int col0 = u.pn * BM + wc * 32 + 4 * fq; const float* gv = gvec + (size_t)cls * NMOD + col0;
        f32x4 g[2][2];
#pragma unroll
        for (int bj = 0; bj < 2; ++bj)
#pragma unroll
            for (int n = 0; n < 2; ++n) g[bj][n] = *(const f32x4*)(gv + bj * HALF + n * 16);
#pragma unroll
        for (int ai = 0; ai < 2; ++ai)
#pragma unroll
            for (int m = 0; m < 4; ++m) { const size_t off = (size_t)(ai * HALF + wr * 64 + m * 16 + fr) * DM + col0;
#pragma unroll
                for (int bj = 0; bj < 2; ++bj)
#pragma unroll
                    for (int n = 0; n < 2; ++n) { const f32x4 s = *(const f32x4*)(src + off + bj * HALF + n * 16);
                        *(f32x4*)(dst + off + bj * HALF + n * 16) = s + g[bj][n] * acc[ai][bj][m][n]; } }
    }
};

struct EpiGU {
    static constexpr bool PERM = true, AFTER_DRAIN = false;
    bf16_t* H;
    __device__ __forceinline__ void operator()(const f32x4 (&acc)[2][2][4][2], const Unit& u, int wr, int wc, int fr, int fq) const {
        const int row0 = u.pm * BM + wr * 64 + fr, col0 = u.pn * HALF + wc * 32 + 8 * fq;
#pragma unroll
        for (int ai = 0; ai < 2; ++ai)
#pragma unroll
            for (int m = 0; m < 4; ++m) { f32x4 g0 = acc[ai][0][m][0], g1 = acc[ai][0][m][1]; const f32x4 u0 = acc[ai][1][m][0], u1 = acc[ai][1][m][1];
#pragma unroll
                for (int e = 0; e < 4; ++e) { g0[e] = g0[e] * fsigmoid(g0[e]) * u0[e]; g1[e] = g1[e] * fsigmoid(g1[e]) * u1[e]; }
                u32x4 w; w.x = cvt_pk_bf16(g0[0], g0[1]); w.y = cvt_pk_bf16(g0[2], g0[3]); w.z = cvt_pk_bf16(g1[0], g1[1]); w.w = cvt_pk_bf16(g1[2], g1[3]);
                *(u32x4*)(H + (size_t)(row0 + ai * HALF + m * 16) * FF + col0) = w; }
    }
};

struct BranchOrder {
    int G, c;
    __device__ bool next(int i, Unit& u) const {
        const int ti = i / 3, br = i - 3 * ti; const int L = ti * G + c; constexpr int nN = 16, nwg = NTM * nN;
        if (L >= nwg) return false;
        int wgid = L; { const int q = nwg / NXCD, r = nwg % NXCD, xcd = wgid % NXCD, off = wgid / NXCD; wgid = (xcd < r ? xcd * (q + 1) : r * (q + 1) + (xcd - r) * q) + off; }
        const int nig = WGM * nN, gid = wgid / nig, fm = gid * WGM, gsz = (NTM - fm) < WGM ? (NTM - fm) : WGM;
        u.pm = br * NTM + fm + ((wgid % nig) % gsz); u.pn = br * nN + (wgid % nig) / gsz; return true;
    }
    __device__ __forceinline__ void a_ready(const Unit&) const {}
    __device__ __forceinline__ void done(const Unit&) const {}
};

template <class Epi, class Sched, bool ALIGN_EPI = false, bool SP2 = false>
__device__ __forceinline__ void gemm_phase(PG8_LAS unsigned char* lds, const int tid, const Gemm g, const Sched& S, const Epi& E) {
    const int wid = __builtin_amdgcn_readfirstlane(tid >> 6), lane = tid & 63, wr = wid >> 2, wc = wid & 3, fr = lane & 15, fq = lane >> 4;
    const int K = g.K, nt = K / BK;
    unsigned voffA[2], voffB[2];
#pragma unroll
    for (int i = 0; i < 2; ++i) { int R, C; stage_rc(tid * 16 + i * 8192, R, C); const int Rb = Epi::PERM ? ((R & ~31) + perm32(R & 31)) : R;
        voffA[i] = (unsigned)(R * K + C) * 2u; voffB[i] = (unsigned)(Rb * K + C) * 2u; }
    const size_t kstep = (size_t)(BK * 2);
    const size_t hstep = (size_t)HALF * K * 2;
    const size_t tstep = 2 * hstep;
    const unsigned ldsw = (unsigned)wid * 1024u;
    const int aoff = lds_byte(wr * 64 + fr, fq * 8), boff = lds_byte(wc * 32 + fr, fq * 8);
#define PG8_SA(b, h) (((b) * 2 + (h)) * HTB)
#define PG8_SB(b, h) ((4 + (b) * 2 + (h)) * HTB)
#define PG8_STAGE(bufoff, gbase, voff) do { _Pragma("unroll") for (int _i = 0; _i < 2; ++_i) \
        __builtin_amdgcn_global_load_lds((const unsigned*)((const char*)(gbase) + (voff)[_i]), (PG8_LAS unsigned*)(lds + (bufoff) + ldsw + _i * 8192), 16, 0, 0); } while (0)
#define PG8_LDA(dst, b, h) do { _Pragma("unroll") for (int m = 0; m < 4; ++m) _Pragma("unroll") for (int k = 0; k < 2; ++k) dst[m][k] = *(const PG8_LAS bf16x8*)(lds + PG8_SA(b, h) + aoff + m * 2048 + k * 1024); } while (0)
#define PG8_LDB(dst, b, h) do { _Pragma("unroll") for (int n = 0; n < 2; ++n) _Pragma("unroll") for (int k = 0; k < 2; ++k) dst[n][k] = *(const PG8_LAS bf16x8*)(lds + PG8_SB(b, h) + boff + n * 2048 + k * 1024); } while (0)
#define PG8_MMA(ai, bj, At, Bt) do { __builtin_amdgcn_s_setprio(1); _Pragma("unroll") for (int m = 0; m < 4; ++m) _Pragma("unroll") for (int n = 0; n < 2; ++n) _Pragma("unroll") for (int k = 0; k < 2; ++k) \
        acc[ai][bj][m][n] = __builtin_amdgcn_mfma_f32_16x16x32_bf16(Bt[n][k], At[m][k], acc[ai][bj][m][n], 0, 0, 0); __builtin_amdgcn_s_setprio(0); } while (0)
#define PG8_WAIT_V(n) asm volatile("s_waitcnt vmcnt(" #n ")" ::: "memory")
#define PG8_WAIT_L(n) asm volatile("s_waitcnt lgkmcnt(" #n ")" ::: "memory")
#define PG8_BAR __builtin_amdgcn_s_barrier()
#define PG8_SCHED __builtin_amdgcn_sched_barrier(0)
    Unit cur, nxt; int ui = 0;
    if (!S.next(0, cur)) return;
    f32x4 acc[2][2][4][2];
#pragma unroll
    for (int a = 0; a < 2; ++a)
#pragma unroll
        for (int b = 0; b < 2; ++b)
#pragma unroll
            for (int m = 0; m < 4; ++m)
#pragma unroll
                for (int n = 0; n < 2; ++n) acc[a][b][m][n] = (f32x4){0.f, 0.f, 0.f, 0.f};
    bf16x8 At[4][2], B0[2][2], B1[2][2];
    const char* cA = (const char*)g.A + (size_t)cur.pm * tstep; const char* cB = (const char*)g.Bt + (size_t)cur.pn * tstep;
    S.a_ready(cur);
    if constexpr (SP2) {
        PG8_STAGE(PG8_SB(0, 0), cB, voffB); PG8_STAGE(PG8_SB(0, 1), cB + hstep, voffB); PG8_STAGE(PG8_SA(0, 0), cA, voffA); PG8_STAGE(PG8_SA(0, 1), cA + hstep, voffA);
        if (wr == 1) PG8_BAR;
        PG8_WAIT_V(2); PG8_BAR;
        PG8_STAGE(PG8_SB(1, 0), cB + kstep, voffB); PG8_STAGE(PG8_SA(1, 0), cA + kstep, voffA); PG8_STAGE(PG8_SB(1, 1), cB + hstep + kstep, voffB);
        PG8_WAIT_V(6); PG8_BAR;
    } else {
        PG8_STAGE(PG8_SB(0, 0), cB, voffB); PG8_STAGE(PG8_SA(0, 0), cA, voffA); PG8_STAGE(PG8_SB(0, 1), cB + hstep, voffB); PG8_STAGE(PG8_SA(0, 1), cA + hstep, voffA);
        if (wr == 1) PG8_BAR;
        PG8_WAIT_V(4); PG8_BAR;
        PG8_STAGE(PG8_SB(1, 0), cB + kstep, voffB); PG8_STAGE(PG8_SA(1, 0), cA + kstep, voffA); PG8_STAGE(PG8_SB(1, 1), cB + hstep + kstep, voffB);
        PG8_WAIT_V(6); PG8_BAR;
    }
    for (;;) {
        const bool has_next = S.next(ui + 1, nxt);
        const char* nA = has_next ? (const char*)g.A + (size_t)nxt.pm * tstep : cA; const char* nB = has_next ? (const char*)g.Bt + (size_t)nxt.pn * tstep : cB;
        for (int t = 0; t < nt; t += 2) {
            const bool last = (t == nt - 2);
            const char* a1 = cA + (size_t)(t + 1) * kstep;
            const char* a2 = last ? nA : cA + (size_t)(t + 2) * kstep; const char* b2 = last ? nB : cB + (size_t)(t + 2) * kstep;
            const char* a3 = a2 + kstep; const char* b3 = b2 + kstep;
            if (last && has_next) S.a_ready(nxt);
            if constexpr (SP2) {
            PG8_LDB(B0, 0, 0); PG8_LDB(B1, 0, 1); PG8_SCHED; PG8_LDA(At, 0, 0); PG8_STAGE(PG8_SA(1, 1), a1 + hstep, voffA);
            PG8_WAIT_V(8); PG8_WAIT_L(0); PG8_BAR; PG8_MMA(0, 0, At, B0); PG8_MMA(0, 1, At, B1); PG8_BAR; PG8_SCHED;
            PG8_LDA(At, 0, 1); PG8_STAGE(PG8_SB(0, 0), b2, voffB); PG8_STAGE(PG8_SB(0, 1), b2 + hstep, voffB); PG8_STAGE(PG8_SA(0, 0), a2, voffA);
            PG8_WAIT_V(8); PG8_WAIT_L(0); PG8_BAR; PG8_MMA(1, 0, At, B0); PG8_MMA(1, 1, At, B1); PG8_BAR; PG8_SCHED;
            PG8_LDB(B0, 1, 0); PG8_LDB(B1, 1, 1); PG8_SCHED; PG8_LDA(At, 1, 0); PG8_STAGE(PG8_SA(0, 1), a2 + hstep, voffA);
            PG8_WAIT_V(8); PG8_WAIT_L(0); PG8_BAR; PG8_MMA(0, 0, At, B0); PG8_MMA(0, 1, At, B1); PG8_BAR; PG8_SCHED;
            PG8_LDA(At, 1, 1); PG8_STAGE(PG8_SB(1, 0), b3, voffB); PG8_STAGE(PG8_SB(1, 1), b3 + hstep, voffB); PG8_STAGE(PG8_SA(1, 0), a3, voffA);
            PG8_WAIT_V(8); PG8_WAIT_L(0); PG8_BAR; PG8_MMA(1, 0, At, B0); PG8_MMA(1, 1, At, B1); PG8_BAR; PG8_SCHED;
            } else {
            PG8_LDB(B0, 0, 0); PG8_SCHED; PG8_LDA(At, 0, 0); PG8_STAGE(PG8_SA(1, 1), a1 + hstep, voffA);
            PG8_WAIT_L(8); PG8_BAR; PG8_WAIT_L(0); PG8_MMA(0, 0, At, B0); PG8_BAR; PG8_SCHED;
            PG8_LDB(B1, 0, 1); PG8_STAGE(PG8_SB(0, 0), b2, voffB);
            PG8_BAR; PG8_WAIT_L(0); PG8_MMA(0, 1, At, B1); PG8_BAR;
            PG8_LDA(At, 0, 1); PG8_STAGE(PG8_SA(0, 0), a2, voffA);
            PG8_BAR; PG8_WAIT_L(0); PG8_MMA(1, 0, At, B0); PG8_BAR; PG8_SCHED;
            PG8_STAGE(PG8_SB(0, 1), b2 + hstep, voffB);
            PG8_WAIT_V(6); PG8_BAR; PG8_MMA(1, 1, At, B1); PG8_BAR;
            PG8_LDB(B0, 1, 0); PG8_SCHED; PG8_LDA(At, 1, 0); PG8_STAGE(PG8_SA(0, 1), a2 + hstep, voffA);
            PG8_WAIT_L(8); PG8_BAR; PG8_WAIT_L(0); PG8_MMA(0, 0, At, B0); PG8_BAR; PG8_SCHED;
            PG8_LDB(B1, 1, 1); PG8_STAGE(PG8_SB(1, 0), b3, voffB);
            PG8_BAR; PG8_WAIT_L(0); PG8_MMA(0, 1, At, B1); PG8_BAR;
            PG8_LDA(At, 1, 1); PG8_STAGE(PG8_SA(1, 0), a3, voffA);
            PG8_BAR; PG8_WAIT_L(0); PG8_MMA(1, 0, At, B0); PG8_BAR; PG8_SCHED;
            PG8_STAGE(PG8_SB(1, 1), b3 + hstep, voffB);
            PG8_WAIT_V(6); PG8_BAR; PG8_MMA(1, 1, At, B1); PG8_BAR;
            }
        }
        if constexpr (ALIGN_EPI) { if (wr == 0) PG8_BAR; }
        if constexpr (!Epi::AFTER_DRAIN) { E(acc, cur, wr, wc, fr, fq); S.done(cur); }
        if (!has_next) break;
#pragma unroll
        for (int a = 0; a < 2; ++a)
#pragma unroll
            for (int b = 0; b < 2; ++b)
#pragma unroll
                for (int m = 0; m < 4; ++m)
#pragma unroll
                    for (int n = 0; n < 2; ++n) acc[a][b][m][n] = (f32x4){0.f, 0.f, 0.f, 0.f};
        cur = nxt; cA = nA; cB = nB; ++ui;
        if constexpr (ALIGN_EPI) { if (wr == 1) PG8_BAR; }
    }
    PG8_WAIT_V(0);
    if constexpr (!ALIGN_EPI) { if (wr == 0) PG8_BAR; }
    PG8_BAR;
    if constexpr (Epi::AFTER_DRAIN) { E.fused(acc, cur, wr, wc, fr, fq, lds, wid, lane); S.done(cur); }
#undef PG8_SA
#undef PG8_SB
#undef PG8_STAGE
#undef PG8_LDA
#undef PG8_LDB
#undef PG8_MMA
#undef PG8_WAIT_V
#undef PG8_WAIT_L
#undef PG8_BAR
#undef PG8_SCHED
}
}
namespace att {
using bf16x8 = __attribute__((ext_vector_type(8))) short;
using s16x4  = __attribute__((ext_vector_type(4))) short;
using f32x16 = __attribute__((ext_vector_type(16))) float;
using u32x4  = __attribute__((ext_vector_type(4))) unsigned;
typedef unsigned short bf16_t;
constexpr int NW = 8, QBLK = 32, KVBLK = 64;
constexpr float SCALE = 0.125f, THR = 8.f;
constexpr int LDZ = IN_DIM, LDO = DM;
constexpr int SHM_V = KVBLK * 128 * 2, SHM_K = KVBLK * 64 * 2, SHM_ATTN = 2 * SHM_V + 2 * SHM_K + NW * 64 * 4;
#define KSWZ(row, colB) ((row) * 128 + ((colB) ^ ((((row) >> 1) & 7) << 4)))
#define SBAR() __builtin_amdgcn_sched_barrier(0)
__device__ __forceinline__ int crow(int r, int hi) { return (r & 3) + 8 * (r >> 2) + 4 * hi; }
__device__ __forceinline__ unsigned cvtpk(float lo, float hi) { unsigned r; asm volatile("v_cvt_pk_bf16_f32 %0, %1, %2" : "=v"(r) : "v"(lo), "v"(hi)); return r; }

__device__ __forceinline__ void partialSM(f32x16& p0, f32x16& p1, float& m_reg, float& mn, float& alpha) {
  constexpr float C = SCALE * 1.4426950408889634f;
  float pmax = p0[0];
#pragma unroll
  for (int r = 1; r < 16; ++r) pmax = fmaxf(pmax, p0[r]);
#pragma unroll
  for (int r = 0; r < 16; ++r) pmax = fmaxf(pmax, p1[r]);
  { auto rr = __builtin_amdgcn_permlane32_swap(__float_as_uint(pmax), __float_as_uint(pmax), false, false);
    pmax = fmaxf(__uint_as_float(rr[0]), __uint_as_float(rr[1])); }
  if (__builtin_expect(__all(pmax - m_reg <= THR / SCALE), 1)) { mn = m_reg; alpha = 1.f; }
  else { mn = fmaxf(m_reg, pmax); alpha = __builtin_amdgcn_exp2f((m_reg - mn) * C); m_reg = mn; }
  float mnC = -mn * C;
#pragma unroll
  for (int r = 0; r < 16; ++r) p0[r] = fmaf(p0[r], C, mnC);
#pragma unroll
  for (int r = 0; r < 16; ++r) p1[r] = fmaf(p1[r], C, mnC);
#pragma unroll
  for (int r = 0; r < 16; ++r) p0[r] = __builtin_amdgcn_exp2f(p0[r]);
}
__device__ __forceinline__ void finishSM(f32x16& p0, f32x16& p1, float alpha, float& l_reg, bf16x8& pa0, bf16x8& pa1, bf16x8& pa2, bf16x8& pa3) {
#pragma unroll
  for (int r = 0; r < 16; ++r) p1[r] = __builtin_amdgcn_exp2f(p1[r]);
  float ps = 0;
#pragma unroll
  for (int r = 0; r < 16; ++r) ps += p0[r];
#pragma unroll
  for (int r = 0; r < 16; ++r) ps += p1[r];
  { auto rr = __builtin_amdgcn_permlane32_swap(__float_as_uint(ps), __float_as_uint(ps), false, false);
    ps = __uint_as_float(rr[0]) + __uint_as_float(rr[1]); }
  l_reg = l_reg * alpha + ps;
#define PK4(P, BASE, OUT) do { unsigned a0 = cvtpk(P[BASE + 0], P[BASE + 1]), a1 = cvtpk(P[BASE + 2], P[BASE + 3]);   \
    unsigned b0 = cvtpk(P[BASE + 4], P[BASE + 5]), b1 = cvtpk(P[BASE + 6], P[BASE + 7]);                              \
    auto r0 = __builtin_amdgcn_permlane32_swap(a0, b0, false, false); auto r1 = __builtin_amdgcn_permlane32_swap(a1, b1, false, false); \
    u32x4 w = {r0[0], r1[0], r0[1], r1[1]}; OUT = *reinterpret_cast<bf16x8*>(&w); } while (0)
  PK4(p0, 0, pa0); PK4(p0, 8, pa1); PK4(p1, 0, pa2); PK4(p1, 8, pa3);
#undef PK4
}
__device__ __forceinline__ void qkt(f32x16& p0, f32x16& p1, const char* Ks, const bf16x8* qr, int r32, int hi) {
  p0 = f32x16{}; p1 = f32x16{};
#pragma unroll
  for (int d0 = 0; d0 < 4; ++d0) { int cb = (d0 * 16 + hi * 8) * 2;
    bf16x8 b0 = *reinterpret_cast<const bf16x8*>(Ks + KSWZ(r32, cb));
    bf16x8 b1 = *reinterpret_cast<const bf16x8*>(Ks + KSWZ(32 + r32, cb));
    p0 = __builtin_amdgcn_mfma_f32_32x32x16_bf16(b0, qr[d0], p0, 0, 0, 0);
    p1 = __builtin_amdgcn_mfma_f32_32x32x16_bf16(b1, qr[d0], p1, 0, 0, 0); }
}
__device__ __forceinline__ int v_st(int k, int c) { const int kk = (k & ~0xC) | ((k & 4) << 1) | ((k & 8) >> 1); return ((kk >> 3) * 4 + (c >> 5)) * 512 + ((kk & 7) * 32 + (c & 31)) * 2; }
__device__ __forceinline__ int v_rd_base(int lane) { return ((lane & 3) << 3) | (((lane >> 2) & 3) << 6) | (((lane >> 4) & 1) << 5) | (((lane >> 5) & 1) << 8); }
constexpr int v_rd_off(int d0, int ks, int half) { return d0 * 512 + ks * 4096 + half * 2048; }
template <int OFF> __device__ __forceinline__ s16x4 tr_read(int vb) {
  s16x4 r; asm volatile("ds_read_b64_tr_b16 %0, %1 offset:%2" : "=&v"(r) : "v"(vb), "i"(OFF) : "memory"); return r;
}
template <int D0> __device__ __forceinline__ void pv_one(f32x16& od, int vb, bf16x8 pa0, bf16x8 pa1, bf16x8 pa2, bf16x8 pa3) {
  const s16x4 l0 = tr_read<v_rd_off(D0, 0, 0)>(vb), h0 = tr_read<v_rd_off(D0, 0, 1)>(vb), l1 = tr_read<v_rd_off(D0, 1, 0)>(vb), h1 = tr_read<v_rd_off(D0, 1, 1)>(vb);
  const s16x4 l2 = tr_read<v_rd_off(D0, 2, 0)>(vb), h2 = tr_read<v_rd_off(D0, 2, 1)>(vb), l3 = tr_read<v_rd_off(D0, 3, 0)>(vb), h3 = tr_read<v_rd_off(D0, 3, 1)>(vb);
  asm volatile("s_waitcnt lgkmcnt(0)" ::: "memory"); SBAR();
#define PK(L, H) (bf16x8){L[0], L[1], L[2], L[3], H[0], H[1], H[2], H[3]}
  od = __builtin_amdgcn_mfma_f32_32x32x16_bf16(pa0, PK(l0, h0), od, 0, 0, 0);
  od = __builtin_amdgcn_mfma_f32_32x32x16_bf16(pa1, PK(l1, h1), od, 0, 0, 0);
  od = __builtin_amdgcn_mfma_f32_32x32x16_bf16(pa2, PK(l2, h2), od, 0, 0, 0);
  od = __builtin_amdgcn_mfma_f32_32x32x16_bf16(pa3, PK(l3, h3), od, 0, 0, 0);
#undef PK
}
__device__ __forceinline__ void pv_d0(f32x16* o, int vb, bf16x8 pa0, bf16x8 pa1, bf16x8 pa2, bf16x8 pa3) {
  pv_one<0>(o[0], vb, pa0, pa1, pa2, pa3); pv_one<1>(o[1], vb, pa0, pa1, pa2, pa3); pv_one<2>(o[2], vb, pa0, pa1, pa2, pa3); pv_one<3>(o[3], vb, pa0, pa1, pa2, pa3);
}

__device__ __forceinline__ void attn_unit(const bf16_t* __restrict__ Qb, const bf16_t* __restrict__ Kh, const bf16_t* __restrict__ Vh, float* __restrict__ Ob,
                                          int rowa, int nt0, int rowb, int NT, char* lds, const int tid) {
  const int wid = tid >> 6, lane = tid & 63, r32 = lane & 31, hi = lane >> 5;
  char* V_lds = lds; char* K_lds = lds + 2 * SHM_V;
  float* ws = (float*)(lds + 2 * SHM_V + 2 * SHM_K) + wid * 64; float* li_l = ws; float* al_l = ws + 32;
  float m_reg = -1e30f, l_reg = 0; f32x16 o[4] = {}; bf16x8 qr[4];
  const bf16_t* Qw = Qb + (long)(wid * QBLK + r32) * LDZ + hi * 8;
#pragma unroll
  for (int d0 = 0; d0 < 4; ++d0) qr[d0] = *reinterpret_cast<const bf16x8*>(Qw + d0 * 16);
  const int sr = tid >> 4, sc = (tid & 15) * 8, vst0 = v_st(sr, sc), vst1 = v_st(32 + sr, sc);
  const int kr = tid >> 3, kc = (tid & 7) * 8, kst = KSWZ(kr, kc * 2);
  const int vb0 = (int)(uintptr_t)V_lds + v_rd_base(lane);
  struct { bf16x8 vs0, vs1, ks0; } sr_[2];
#define KROW(j) ((j) < nt0 ? rowa + (j) * KVBLK : rowb + ((j) - nt0) * KVBLK)
#define SLOAD(i, j) do { const long k0_ = KROW(j); sr_[i].vs0 = *reinterpret_cast<const bf16x8*>(&Vh[(k0_ + sr) * LDZ + sc]); sr_[i].vs1 = *reinterpret_cast<const bf16x8*>(&Vh[(k0_ + 32 + sr) * LDZ + sc]); \
    sr_[i].ks0 = *reinterpret_cast<const bf16x8*>(&Kh[(k0_ + kr) * LDZ + kc]); } while (0)
#define SWRITE(b, i) do { *(bf16x8*)(V_lds + (b) * SHM_V + vst0) = sr_[i].vs0; *(bf16x8*)(V_lds + (b) * SHM_V + vst1) = sr_[i].vs1; \
    *(bf16x8*)(K_lds + (b) * SHM_K + kst) = sr_[i].ks0; } while (0)
#define SWAIT() asm volatile("s_waitcnt vmcnt(3)" ::: "memory")
#define RESC(a) do { if (__any((a) < 1.f)) { if (hi == 0) al_l[r32] = (a); asm volatile("s_waitcnt lgkmcnt(0)" ::: "memory"); \
    _Pragma("unroll") for (int d = 0; d < 4; ++d) _Pragma("unroll") for (int r = 0; r < 16; ++r) o[d][r] *= al_l[crow(r, hi)]; } } while (0)
  f32x16 pA0, pA1, pB0, pB1; float mnA, mnB, alA, alB; bf16x8 pa0, pa1, pa2, pa3;
  constexpr int SE = 0, SO = 1;
  SLOAD(SE, 0); asm volatile("s_waitcnt vmcnt(0)" ::: "memory"); SWRITE(0, SE); __syncthreads();
  qkt(pA0, pA1, K_lds, qr, r32, hi); partialSM(pA0, pA1, m_reg, mnA, alA);
  SLOAD(SO, 1); if (2 < NT) SLOAD(SE, 2);
  SWAIT(); SWRITE(1, SO); __syncthreads();
  for (int j = 1; j + 1 < NT; j += 2) {
    SBAR(); qkt(pB0, pB1, K_lds + SHM_K, qr, r32, hi);
    finishSM(pA0, pA1, alA, l_reg, pa0, pa1, pa2, pa3); SBAR();
    SLOAD(SO, j + 2); SBAR();
    pv_d0(o, vb0, pa0, pa1, pa2, pa3); partialSM(pB0, pB1, m_reg, mnB, alB);
    __syncthreads(); SWAIT(); SWRITE(0, SE);
    RESC(alB); __syncthreads();
    SBAR(); qkt(pA0, pA1, K_lds, qr, r32, hi);
    finishSM(pB0, pB1, alB, l_reg, pa0, pa1, pa2, pa3); SBAR();
    if (j + 3 < NT) SLOAD(SE, j + 3); SBAR();
    pv_d0(o, vb0 + SHM_V, pa0, pa1, pa2, pa3); partialSM(pA0, pA1, m_reg, mnA, alA);
    __syncthreads(); SWAIT(); SWRITE(1, SO);
    RESC(alA); __syncthreads();
  }
  SBAR(); qkt(pB0, pB1, K_lds + SHM_K, qr, r32, hi);
  finishSM(pA0, pA1, alA, l_reg, pa0, pa1, pa2, pa3); SBAR();
  pv_d0(o, vb0, pa0, pa1, pa2, pa3); partialSM(pB0, pB1, m_reg, mnB, alB);
  __syncthreads(); RESC(alB);
  finishSM(pB0, pB1, alB, l_reg, pa0, pa1, pa2, pa3); SBAR();
  pv_d0(o, vb0 + SHM_V, pa0, pa1, pa2, pa3);
  if (hi == 0) li_l[r32] = l_reg; asm volatile("s_waitcnt lgkmcnt(0)" ::: "memory");
  float rli[16];
#pragma unroll
  for (int r = 0; r < 16; ++r) rli[r] = __builtin_amdgcn_rcpf(li_l[crow(r, hi)]);
  float* Ow = Ob + (long)(wid * QBLK) * LDO;
#pragma unroll
  for (int r = 0; r < 16; ++r) { int orow = crow(r, hi);
#pragma unroll
    for (int d0 = 0; d0 < 4; ++d0) Ow[(long)orow * LDO + d0 * 32 + r32] = o[d0][r] * rli[r]; }
  __syncthreads();
#undef KROW
#undef SLOAD
#undef SWRITE
#undef SWAIT
#undef RESC
}
}

#define GAS __attribute__((address_space(1)))
#define LAS __attribute__((address_space(3)))
typedef unsigned short bf16;
typedef unsigned v4u __attribute__((ext_vector_type(4)));
typedef float f32x4 __attribute__((ext_vector_type(4)));
typedef short bf16x8 __attribute__((ext_vector_type(8)));
typedef GAS unsigned gu32;
typedef GAS unsigned long long gu64;
#define RLX_AGENT __ATOMIC_RELAXED, __HIP_MEMORY_SCOPE_AGENT
#define LDS_WAIT() asm volatile("s_waitcnt lgkmcnt(0)" ::: "memory")
#define VM_WAIT() asm volatile("s_waitcnt vmcnt(0)" ::: "memory")
__device__ __forceinline__ unsigned long long rt() { return __builtin_amdgcn_s_memrealtime(); }
__device__ __forceinline__ unsigned f2bf(float f) { unsigned u = __builtin_bit_cast(unsigned, f); return (u + 0x7fffu + ((u >> 16) & 1u)) >> 16; }
__device__ __forceinline__ unsigned pk2(float lo, float hi) { return f2bf(lo) | (f2bf(hi) << 16); }

#define XB_TMO      128
#define XB_XCNT(j)  (256  + 64 * (j))
#define XB_XSUB(j)  (1280 + 64 * (j))
#define XB_XGEN(j)  (2304 + 64 * (j))
#define XB_TOP      3328
#define XB_TOPGEN   3392
#define XCD_BAR_WORDS 3456
#define XB_SPIN_CAP (1u << 18)

__device__ __forceinline__ unsigned xb_ld(unsigned* p)              { return __hip_atomic_load(p, __ATOMIC_RELAXED, __HIP_MEMORY_SCOPE_AGENT); }
__device__ __forceinline__ unsigned xb_add(unsigned* p, unsigned v) { return __hip_atomic_fetch_add(p, v, __ATOMIC_RELAXED, __HIP_MEMORY_SCOPE_AGENT); }
__device__ __forceinline__ unsigned xb_xcc_id() { return (unsigned)__builtin_amdgcn_s_getreg((3 << 11) | 20) & 0xFu; }
#define XB_SPIN(cond, bar) do { unsigned _sp = 0; while (cond) { __builtin_amdgcn_s_sleep(1); \
    if ((++_sp & 255u) == 0u) { if (xb_ld(&(bar)[XB_TMO])) break; if (_sp > XB_SPIN_CAP) { atomicAdd(&(bar)[XB_TMO], 1u); break; } } } } while (0)

struct XcdBarrier {
    unsigned* bar; unsigned x;
    volatile LAS unsigned* st;
};

__device__ __forceinline__ XcdBarrier xcd_barrier_post(unsigned* bar, volatile LAS unsigned* st) {
    XcdBarrier b; b.bar = bar; b.x = xb_xcc_id(); b.st = st;
    if (threadIdx.x == 0) (void)xb_add(&bar[XB_XCNT(b.x)], 1u);
    return b;
}
__device__ __forceinline__ void xcd_barrier_complete(unsigned* bar, unsigned x, unsigned& nloc, unsigned& nx) {
    const unsigned G = gridDim.x * gridDim.y * gridDim.z;
    unsigned sum, cnt, mine, sp = 0u;
    for (;;) {
        sum = 0u; cnt = 0u; mine = 0u;
#pragma unroll
        for (unsigned j = 0; j < 16; ++j) { const unsigned c = xb_ld(&bar[XB_XCNT(j)]); sum += c; cnt += (c > 0u) ? 1u : 0u; mine = (j == x) ? c : mine; }
        if (sum == G) break;
        __builtin_amdgcn_s_sleep(1);
        if ((++sp & 255u) == 0u) { if (xb_ld(&bar[XB_TMO])) break; if (sp > XB_SPIN_CAP) { atomicAdd(&bar[XB_TMO], 1u); break; } }
    }
    nloc = mine > 0u ? mine : 1u; nx = cnt > 0u ? cnt : 1u;
}

__device__ __forceinline__ void xcd_barrier(const XcdBarrier& b) {
    asm volatile("s_waitcnt vmcnt(0)" ::: "memory");
    __syncthreads();
    if (threadIdx.x == 0) {
        unsigned* bar = b.bar;
        __builtin_amdgcn_s_waitcnt(0);
        unsigned nloc = b.st[0], nx = b.st[1];
        if (nloc == 0u) { xcd_barrier_complete(bar, b.x, nloc, nx); b.st[0] = nloc; b.st[1] = nx; }
        const unsigned old = xb_add(&bar[XB_XSUB(b.x)], 1u);
        const unsigned gen = old / nloc;
        if (old + 1u == (gen + 1u) * nloc) {
            __builtin_amdgcn_fence(__ATOMIC_RELEASE, "agent");
            asm volatile("s_waitcnt vmcnt(0)" ::: "memory");
            const unsigned og = xb_add(&bar[XB_TOP], 1u);
            const unsigned tg = og / nx;
            if (og + 1u == (tg + 1u) * nx) xb_add(&bar[XB_TOPGEN], 1u);
            else XB_SPIN(xb_ld(&bar[XB_TOPGEN]) == tg, bar);
            __builtin_amdgcn_fence(__ATOMIC_ACQUIRE, "agent");
            xb_add(&bar[XB_XGEN(b.x)], 1u);
            asm volatile("s_waitcnt vmcnt(0)" ::: "memory");
        } else {
            XB_SPIN(xb_ld(&bar[XB_XGEN(b.x)]) == gen, bar);
            __builtin_amdgcn_fence(__ATOMIC_ACQUIRE, "agent");
            asm volatile("s_waitcnt vmcnt(0)" ::: "memory");
        }
    }
    __syncthreads();
}
constexpr size_t MiB = 1u << 20;
constexpr size_t WS_CTL = 0, CTL_ZERO_BYTES = 1 * MiB;
constexpr size_t WS_MOD = 1 * MiB;
constexpr size_t WS_ROPE = 2 * MiB;
constexpr size_t WS_WSP = 4 * MiB;
constexpr size_t WS_HC = 5 * MiB;
constexpr size_t WS_W = 16 * MiB;
constexpr size_t W_IN = 0, W_BR = W_IN + (size_t)IN_DIM * DM * 2, W_O = W_BR + (size_t)3 * DM * 2048 * 2, W_GU = W_O + (size_t)DM * DM * 2, W_D = W_GU + (size_t)2 * FF * DM * 2,
                 W_LAYER = W_D + (size_t)DM * FF * 2;
constexpr size_t WS_Z = WS_W + 2 * W_LAYER;
constexpr size_t WS_ACT = WS_Z + (size_t)MT * IN_DIM * 2;
constexpr size_t WS_XB = WS_ACT + (size_t)MT * DM * 2;
constexpr size_t WS_O12 = WS_XB + (size_t)3 * MT * 2048 * 2;
constexpr size_t WS_END = WS_O12 + (size_t)MT * DM * 4;
static_assert(W_LAYER % 256 == 0 && WS_Z % 256 == 0 && WS_ACT % 256 == 0 && WS_XB % 256 == 0 && WS_O12 % 256 == 0, "alignment");
constexpr int CW_BAR = 4096;

constexpr int NWAVES = 8;
constexpr int RING_BYTES = 131072, MISC_OFF = RING_BYTES + 320, LDS_BYTES = 147456;
constexpr int N_PHASES = 1 + 10 * DEPTH;

__device__ __forceinline__ float wave_sum(float v) {
#pragma unroll
    for (int o = 1; o < 64; o <<= 1) v += __shfl_xor(v, o);
    return v;
}
__device__ __forceinline__ unsigned pkbf(float lo, float hi) { unsigned r; asm volatile("v_cvt_pk_bf16_f32 %0, %1, %2" : "=v"(r) : "v"(lo), "v"(hi)); return r; }
__device__ __forceinline__ float blo(unsigned w) { return __uint_as_float(w << 16); }
__device__ __forceinline__ float bhi(unsigned w) { return __uint_as_float(w & 0xffff0000u); }
__device__ __forceinline__ void unpack8(const v4u w, float (&x)[8]) { x[0] = blo(w.x); x[1] = bhi(w.x); x[2] = blo(w.y); x[3] = bhi(w.y); x[4] = blo(w.z); x[5] = bhi(w.z); x[6] = blo(w.w); x[7] = bhi(w.w); }
__device__ __forceinline__ v4u pack8(const float (&x)[8]) { v4u w; w.x = pkbf(x[0], x[1]); w.y = pkbf(x[2], x[3]); w.z = pkbf(x[4], x[5]); w.w = pkbf(x[6], x[7]); return w; }

struct Args { const float* in[25]; float* out; unsigned char* ws; int ph_lo, ph_hi, bar_region, pad; };
struct Ctx {
    LAS unsigned char* lds; int tid, lane, wave, vcu, G;
    float* out; unsigned char* ws; int bx;
};
__device__ __forceinline__ Ctx launder(const Ctx& F) {
    Ctx P = F; int t = F.tid; asm volatile("" : "+v"(t)); P.tid = t; P.lane = t & 63; P.wave = __builtin_amdgcn_readfirstlane(t >> 6);
    asm volatile("" : "+s"(P.vcu), "+s"(P.G), "+s"(P.bx)); unsigned long long z = 0; asm volatile("" : "+s"(z)); P.ws = F.ws + z; P.out = F.out + z;
    return P;
}


__device__ __forceinline__ void transpose_item(const float* W, int K, int N, bf16* WT, int k0, int n0, int drow0, LAS float* scr, int lane) {
#pragma unroll 8
    for (int i = 0; i < 32; ++i) { const int kk = 2 * i + (lane >> 5); scr[kk * 33 + (lane & 31)] = W[(size_t)(k0 + kk) * N + n0 + (lane & 31)]; }
    LDS_WAIT(); asm volatile("" ::: "memory");
    const int c = lane & 7;
#pragma unroll
    for (int j = 0; j < 4; ++j) { const int n = (lane >> 3) + 8 * j; const LAS float* s = scr + (8 * c) * 33 + n;
        v4u o; o.x = pkbf(s[0 * 33], s[1 * 33]); o.y = pkbf(s[2 * 33], s[3 * 33]); o.z = pkbf(s[4 * 33], s[5 * 33]); o.w = pkbf(s[6 * 33], s[7 * 33]);
        *(GAS v4u*)(WT + (size_t)(drow0 + n) * K + k0 + 8 * c) = o; }
    LDS_WAIT(); asm volatile("" ::: "memory");
}
template <int MODE> __device__ __forceinline__ void transpose_mat(const float* W, int K, int N, bf16* WT, LAS float* scr, int item, int lane) {
    const int nblk = N / 32, kb = item / nblk, nb = item % nblk, n0 = 32 * nb;
    const int drow0 = MODE == 0 ? n0 : ((n0 >> 7) * 256 + (n0 & 127) + (MODE == 2 ? 128 : 0));
    transpose_item(W, K, N, WT, 64 * kb, n0, drow0, scr, lane);
}

__device__ __forceinline__ void sincos_f(float a, float& s, float& c) {
    const double ad = (double)a; const double kq = __builtin_rint(ad * 0.63661977236758134308); const double r = ad - kq * 1.57079632679489661923; const double r2 = r * r;
    const double sp = r * (1.0 + r2 * (-1.0 / 6 + r2 * (1.0 / 120 + r2 * (-1.0 / 5040 + r2 * (1.0 / 362880 + r2 * (-1.0 / 39916800))))));
    const double cp = 1.0 + r2 * (-0.5 + r2 * (1.0 / 24 + r2 * (-1.0 / 720 + r2 * (1.0 / 40320 + r2 * (-1.0 / 3628800 + r2 * (1.0 / 479001600))))));
    const int q = ((int)kq) & 3;
    const double ss = (q == 0) ? sp : (q == 1) ? cp : (q == 2) ? -sp : -cp;
    const double cc = (q == 0) ? cp : (q == 1) ? -sp : (q == 2) ? -cp : sp;
    s = (float)ss; c = (float)cc;
}

__device__ __forceinline__ void p0_prologue(const Args& A, const Ctx& F) {
    const float* c = A.in[1]; const float* c_ctx = A.in[3]; const float* ada_w = A.in[4]; const float* ada_b = A.in[5];
    const float* norm_mix_g = A.in[6]; const float* norm_ffn_g = A.in[7];
    float* MOD = (float*)(F.ws + WS_MOD);
    LAS float* sv = (LAS float*)F.lds; LAS float* red = (LAS float*)(F.lds + 49152);
    for (int i = F.tid; i < 3 * DM; i += NWAVES * 64) { const int v = i >> 12, k = i & (DM - 1); const float x = v < 2 ? c[v * DM + k] : c_ctx[k]; sv[i] = x / (1.f + __expf(-x)); }
    __syncthreads();
    for (int ch = F.vcu; ch < 256; ch += F.G) {
        const int gcol = ch * 192, l = gcol / NMOD, j0 = gcol % NMOD;
        f32x4 a0 = {0.f, 0.f, 0.f, 0.f}, a1 = a0, a2 = a0;
        if (F.lane < 48) {
            const float* wp = ada_w + (size_t)l * DM * NMOD + (size_t)(F.wave * 512) * NMOD + j0 + F.lane * 4;
            const LAS float* s0 = sv + F.wave * 512;
#pragma unroll 8
            for (int k = 0; k < 512; ++k) { const f32x4 w = *(const f32x4*)(wp + (size_t)k * NMOD); a0 += w * s0[k]; a1 += w * s0[DM + k]; a2 += w * s0[2 * DM + k]; }
            *(LAS f32x4*)(red + (F.wave * 3 + 0) * 192 + F.lane * 4) = a0; *(LAS f32x4*)(red + (F.wave * 3 + 1) * 192 + F.lane * 4) = a1; *(LAS f32x4*)(red + (F.wave * 3 + 2) * 192 + F.lane * 4) = a2;
        }
        __syncthreads();
        for (int o = F.tid; o < 3 * 192; o += NWAVES * 64) { const int v = o / 192, jj = o % 192; float s = 0.f;
#pragma unroll
            for (int w = 0; w < 8; ++w) s += red[(w * 3 + v) * 192 + jj];
            const int j = j0 + jj, q = j >> 12, col = j & (DM - 1); float val = s + ada_b[l * NMOD + j];
            if (q == 1) val = norm_mix_g[l * DM + col] * (1.f + val); else if (q == 4) val = norm_ffn_g[l * DM + col] * (1.f + val);
            MOD[(size_t)(l * 3 + v) * NMOD + j] = val; }
        __syncthreads();
    }
    const int gtid = F.vcu * (NWAVES * 64) + F.tid, NTH = F.G * NWAVES * 64;
    { float* ROPE = (float*)(F.ws + WS_ROPE);
      for (int e = gtid; e < SEQ * 32; e += NTH) { const int t = e >> 5, j = e & 31; const int pos = j < 16 ? (t >> 6) : (t & 63);
          const float inv = exp2f(-(float)(j & 15) * (13.287712379549449f / 16.f)); float s, cs; sincos_f((float)pos * inv, s, cs); ROPE[2 * e] = cs; ROPE[2 * e + 1] = s; } }
    { const float* wsp = A.in[18]; bf16* o = (bf16*)(F.ws + WS_WSP);
      for (int e = gtid; e < DEPTH * 16 * 128 * 128 / 2; e += NTH) ((unsigned*)o)[e] = pkbf(wsp[2 * e], wsp[2 * e + 1]); }
    LAS float* scr = (LAS float*)(F.lds + F.wave * 16384);
    const int gw = F.vcu * NWAVES + F.wave, NGW = F.G * NWAVES;
    constexpr int I_IN = (DM / 64) * (IN_DIM / 32), I_BR = (2048 / 64) * (DM / 32), I_O = (DM / 64) * (DM / 32), I_GU = (DM / 64) * (FF / 32), I_D = (FF / 64) * (DM / 32);
    constexpr int I_LAYER = I_IN + 3 * I_BR + I_O + 2 * I_GU + I_D;
    for (int it = gw; it < DEPTH * I_LAYER; it += NGW) {
        const int l = it / I_LAYER; int r = it - l * I_LAYER; unsigned char* wl = F.ws + WS_W + (size_t)l * W_LAYER;
        if (r < I_IN) { transpose_mat<0>(A.in[8] + (size_t)l * DM * IN_DIM, DM, IN_DIM, (bf16*)(wl + W_IN), scr, r, F.lane); continue; } r -= I_IN;
        if (r < I_BR) { transpose_mat<0>(A.in[11] + (size_t)l * 2048 * DM, 2048, DM, (bf16*)(wl + W_BR), scr, r, F.lane); continue; } r -= I_BR;
        if (r < I_BR) { transpose_mat<0>(A.in[16] + (size_t)l * 2048 * DM, 2048, DM, (bf16*)(wl + W_BR) + (size_t)DM * 2048, scr, r, F.lane); continue; } r -= I_BR;
        if (r < I_BR) { transpose_mat<0>(A.in[20] + (size_t)l * 2048 * DM, 2048, DM, (bf16*)(wl + W_BR) + (size_t)2 * DM * 2048, scr, r, F.lane); continue; } r -= I_BR;
        if (r < I_O) { transpose_mat<0>(A.in[21] + (size_t)l * DM * DM, DM, DM, (bf16*)(wl + W_O), scr, r, F.lane); continue; } r -= I_O;
        if (r < I_GU) { transpose_mat<1>(A.in[22] + (size_t)l * DM * FF, DM, FF, (bf16*)(wl + W_GU), scr, r, F.lane); continue; } r -= I_GU;
        if (r < I_GU) { transpose_mat<2>(A.in[23] + (size_t)l * DM * FF, DM, FF, (bf16*)(wl + W_GU), scr, r, F.lane); continue; } r -= I_GU;
        transpose_mat<0>(A.in[24] + (size_t)l * FF * DM, FF, DM, (bf16*)(wl + W_D), scr, r, F.lane);
    }
}

__device__ __forceinline__ void norm_phase(const Ctx& F, int l, int which, const float* src_lat, const float* src_ctx) {
    const float* MOD = (const float*)(F.ws + WS_MOD); bf16* XN = (bf16*)(F.ws + WS_ACT);
    const int gw = F.vcu * NWAVES + F.wave, NGW = F.G * NWAVES;
    for (int m = gw; m < MT; m += NGW) {
        const float* xr = m < ML ? src_lat + (size_t)m * DM : src_ctx + (size_t)(m - ML) * DM;
        const int cls = m < SEQ ? 0 : (m < ML ? 1 : 2);
        const float* sh = MOD + (size_t)(l * 3 + cls) * NMOD + (which ? 3 : 0) * DM; const float* gs = sh + DM;
        f32x4 v[16]; float ss = 0.f;
#pragma unroll
        for (int j = 0; j < 16; ++j) { v[j] = *(const f32x4*)(xr + 4 * F.lane + 256 * j); ss += (v[j].x * v[j].x + v[j].y * v[j].y) + (v[j].z * v[j].z + v[j].w * v[j].w); }
        const float rstd = __builtin_amdgcn_rsqf(wave_sum(ss) * (1.f / DM) + EPS);
        unsigned long long* o8 = (unsigned long long*)(XN + (size_t)m * DM) + F.lane;
#pragma unroll
        for (int j = 0; j < 16; ++j) { const f32x4 g = *(const f32x4*)(gs + 4 * F.lane + 256 * j), s = *(const f32x4*)(sh + 4 * F.lane + 256 * j);
            const f32x4 y = v[j] * rstd * g + s;
            o8[64 * j] = (unsigned long long)pkbf(y.x, y.y) | ((unsigned long long)pkbf(y.z, y.w) << 32); }
    }
}

__device__ __forceinline__ void qk_phase(const Args& A, const Ctx& F, int l) {
    bf16* Z = (bf16*)(F.ws + WS_Z); const float* ROPE = (const float*)(F.ws + WS_ROPE);
    const int gw = F.vcu * NWAVES + F.wave, NGW = F.G * NWAVES, p = F.lane & 7;
    float gq[8], gk[8];
#pragma unroll
    for (int e = 0; e < 8; ++e) { gq[e] = A.in[12][l * 64 + 8 * p + e]; gk[e] = A.in[13][l * 64 + 8 * p + e]; }
    for (int m = gw; m < MT; m += NGW) {
        bf16* zr = Z + (size_t)m * IN_DIM + ZC_Q; const bool lat = m < ML; const int t = m & (SEQ - 1);
        float cs[8], sn[8];
        if (lat) { const float* rp = ROPE + ((size_t)t * 32 + 8 * (p & 3)) * 2;
#pragma unroll
            for (int e = 0; e < 4; ++e) { const f32x4 w = *(const f32x4*)(rp + 4 * e); cs[2 * e] = w.x; sn[2 * e] = w.y; cs[2 * e + 1] = w.z; sn[2 * e + 1] = w.w; } }
        else {
#pragma unroll
            for (int e = 0; e < 8; ++e) { cs[e] = 1.f; sn[e] = 0.f; } }
#pragma unroll
        for (int i = 0; i < 8; ++i) {
            v4u w = *(const v4u*)(zr + i * 512 + F.lane * 8); float x[8]; unpack8(w, x);
            float ss = 0.f;
#pragma unroll
            for (int e = 0; e < 8; ++e) ss += x[e] * x[e];
            ss += __shfl_xor(ss, 1); ss += __shfl_xor(ss, 2); ss += __shfl_xor(ss, 4);
            const float r = __builtin_amdgcn_rsqf(ss * (1.f / 64.f) + EPS);
#pragma unroll
            for (int e = 0; e < 8; ++e) x[e] = x[e] * r * (i < 4 ? gq[e] : gk[e]);
            float y[8];
#pragma unroll
            for (int e = 0; e < 8; ++e) { const float xp = __shfl_xor(x[e], 4); y[e] = (p < 4) ? x[e] * cs[e] - xp * sn[e] : x[e] * cs[e] + xp * sn[e]; }
            *(v4u*)(zr + i * 512 + F.lane * 8) = pack8(y);
        }
    }
}

__device__ __forceinline__ void conv_phase(const Args& A, const Ctx& F, int l) {
    const bf16* Z = (const bf16*)(F.ws + WS_Z); bf16* CV = (bf16*)(F.ws + WS_XB);
    const float* cw = A.in[9] + (size_t)l * 3 * 2048; const float* cb = A.in[10] + (size_t)l * 2048;
    const int gtid = F.vcu * (NWAVES * 64) + F.tid, NTH = F.G * NWAVES * 64;
    for (int it = gtid; it < MT * 256; it += NTH) {
        const int m = it >> 8, c = (it & 255) * 8;
        const int t = m < ML ? (m & (SEQ - 1)) : ((m - ML) & (CTXL - 1)), T = m < ML ? SEQ : CTXL;
        const bf16* zr = Z + (size_t)m * IN_DIM + c;
        float bg[8], a[8], b[8], z0[8], zp[8], zn[8];
        unpack8(*(const v4u*)(zr + ZC_BG), bg);
        unpack8(*(const v4u*)(zr + ZC_CG), a); unpack8(*(const v4u*)(zr + ZC_XIN), b);
#pragma unroll
        for (int e = 0; e < 8; ++e) z0[e] = a[e] * b[e];
        if (t > 0) { unpack8(*(const v4u*)(zr - IN_DIM + ZC_CG), a); unpack8(*(const v4u*)(zr - IN_DIM + ZC_XIN), b);
#pragma unroll
            for (int e = 0; e < 8; ++e) zp[e] = a[e] * b[e]; }
        else {
#pragma unroll
            for (int e = 0; e < 8; ++e) zp[e] = 0.f; }
        if (t < T - 1) { unpack8(*(const v4u*)(zr + IN_DIM + ZC_CG), a); unpack8(*(const v4u*)(zr + IN_DIM + ZC_XIN), b);
#pragma unroll
            for (int e = 0; e < 8; ++e) zn[e] = a[e] * b[e]; }
        else {
#pragma unroll
            for (int e = 0; e < 8; ++e) zn[e] = 0.f; }
        float y[8];
#pragma unroll
        for (int e = 0; e < 8; ++e) y[e] = bg[e] * (zp[e] * cw[c + e] + z0[e] * cw[2048 + c + e] + zn[e] * cw[4096 + c + e] + cb[c + e]);
        *(v4u*)(CV + (size_t)m * 2048 + c) = pack8(y);
    }
}

__device__ __forceinline__ void mlp_phase(const Args& A, const Ctx& F, int l) {
    const bf16* Z = (const bf16*)(F.ws + WS_Z); bf16* MO = (bf16*)(F.ws + WS_XB) + (size_t)2 * MT * 2048;
    const bf16* WSP = (const bf16*)(F.ws + WS_WSP) + (size_t)l * 16 * 128 * 128;
    const float* gnorm = A.in[17] + (size_t)l * 2048; const float* bsp = A.in[19] + (size_t)l * 16 * 128;
    LAS unsigned char* Vl = F.lds; LAS float* rst = (LAS float*)(F.lds + 32768);
    const int r32 = F.lane & 31, hi = F.lane >> 5, rb = F.wave & 3, ch = F.wave >> 2;
    const int sr = F.tid >> 4, sc = (F.tid & 15) * 8;
    for (int unit = F.vcu; unit < (MT / 128) * 2; unit += F.G) {
        const int chunk = unit >> 1, gh = unit & 1, row0 = chunk * 128;
        for (int rr = F.wave; rr < 128; rr += NWAVES) { const bf16* vr = Z + (size_t)(row0 + rr) * IN_DIM + ZC_VM; float ss = 0.f;
#pragma unroll
            for (int i = 0; i < 4; ++i) { float x[8]; unpack8(*(const v4u*)(vr + i * 512 + F.lane * 8), x);
#pragma unroll
                for (int e = 0; e < 8; ++e) ss += x[e] * x[e]; }
            ss = wave_sum(ss); if (F.lane == 0) rst[rr] = __builtin_amdgcn_rsqf(ss * (1.f / 2048.f) + EPS); }
        __syncthreads();
        for (int gi = 0; gi < 8; ++gi) { const int g = gh * 8 + gi;
            float gn[8];
#pragma unroll
            for (int e = 0; e < 8; ++e) gn[e] = gnorm[g * 128 + sc + e];
#pragma unroll
            for (int i = 0; i < 4; ++i) { const int q = sr + 32 * i; float x[8]; unpack8(*(const v4u*)(Z + (size_t)(row0 + q) * IN_DIM + ZC_VM + g * 128 + sc), x);
                const float r = rst[q];
#pragma unroll
                for (int e = 0; e < 8; ++e) x[e] = x[e] * r * gn[e];
                *(LAS v4u*)(Vl + (q >> 6) * 16384 + att::v_st(q & 63, sc)) = pack8(x); }
            __syncthreads();
            att::f32x16 acc0 = {}, acc1 = {};
#pragma unroll
            for (int kt = 0; kt < 2; ++kt) { att::bf16x8 pa[4];
#pragma unroll
                for (int s = 0; s < 4; ++s) pa[s] = *(const att::bf16x8*)(WSP + ((size_t)g * 128 + 32 * rb + r32) * 128 + 64 * kt + 16 * s + 8 * hi);
                const int vb = (int)(uintptr_t)Vl + kt * 16384 + ch * 1024 + att::v_rd_base(F.lane);
                att::pv_one<0>(acc0, vb, pa[0], pa[1], pa[2], pa[3]); att::pv_one<1>(acc1, vb, pa[0], pa[1], pa[2], pa[3]); }
#pragma unroll
            for (int r = 0; r < 16; ++r) { const int pr = 32 * rb + att::crow(r, hi); const float bias = bsp[g * 128 + pr]; const size_t row = (size_t)(row0 + pr);
                const int col = g * 128 + ch * 64 + r32;
                const float u0 = __uint_as_float((unsigned)Z[row * IN_DIM + ZC_U + col] << 16), u1 = __uint_as_float((unsigned)Z[row * IN_DIM + ZC_U + col + 32] << 16);
                MO[row * 2048 + col] = (bf16)(pkbf(u0 * (acc0[r] + bias), 0.f) & 0xffffu); MO[row * 2048 + col + 32] = (bf16)(pkbf(u1 * (acc1[r] + bias), 0.f) & 0xffffu); }
            __syncthreads();
        }
    }
}

__device__ __forceinline__ void attn_phase(const Ctx& F, bool with_ctx) {
    const bf16* Z = (const bf16*)(F.ws + WS_Z); float* O12 = (float*)(F.ws + WS_O12);
    for (int u = F.vcu; u < 2048; u += F.G) { const int combo = u >> 5, qb = u & 31, b = combo >> 5, h = (combo >> 1) & 15, mp = combo & 1;
        const int qrow = b * SEQ + qb * 256;
        att::attn_unit(Z + (size_t)qrow * IN_DIM + ZC_Q + h * 128 + mp * 64, Z + ZC_K + h * 128 + mp * 64, Z + ZC_V + h * 128,
                       O12 + (size_t)qrow * DM + mp * 2048 + h * 128, b * SEQ, SEQ / 64, ML + b * CTXL, SEQ / 64 + CTXL / 64, (char*)F.lds, F.tid); }
    if (with_ctx) for (int u = F.vcu; u < 64; u += F.G) { const int combo = u, b = combo >> 5, h = (combo >> 1) & 15, mp = combo & 1;
        const int qrow = ML + b * CTXL;
        att::attn_unit(Z + (size_t)qrow * IN_DIM + ZC_Q + h * 128 + mp * 64, Z + ZC_K + h * 128 + mp * 64, Z + ZC_V + h * 128,
                       O12 + (size_t)qrow * DM + mp * 2048 + h * 128, qrow, CTXL / 64, qrow, CTXL / 64, (char*)F.lds, F.tid); }
}

__device__ __forceinline__ void comb_phase(const Args& A, const Ctx& F, int l, float lam_init) {
    const float* O12 = (const float*)(F.ws + WS_O12); bf16* AO = (bf16*)(F.ws + WS_XB) + (size_t)MT * 2048;
    const float* lq = A.in[14] + (size_t)l * 256;
    const float s01 = wave_sum(lq[F.lane] * lq[64 + F.lane]), s23 = wave_sum(lq[128 + F.lane] * lq[192 + F.lane]);
    const float lam = expf(s01) - expf(s23) + lam_init, osc = 1.f - lam_init;
    const int li = F.lane & 31; const f32x4 sg = *(const f32x4*)(A.in[15] + (size_t)l * 128 + li * 4);
    const int gw = F.vcu * NWAVES + F.wave, NGW = F.G * NWAVES;
    for (int it = gw * 2 + (F.lane >> 5); it < MT * 16; it += NGW * 2) { const int m = it >> 4, h = it & 15;
        const float* op = O12 + (size_t)m * DM + h * 128 + li * 4;
        const f32x4 d = *(const f32x4*)op - lam * *(const f32x4*)(op + 2048);
        float ss = (d.x * d.x + d.y * d.y) + (d.z * d.z + d.w * d.w);
        ss += __shfl_xor(ss, 1); ss += __shfl_xor(ss, 2); ss += __shfl_xor(ss, 4); ss += __shfl_xor(ss, 8); ss += __shfl_xor(ss, 16);
        const float r = __builtin_amdgcn_rsqf(ss * (1.f / 128.f) + EPS) * osc; const f32x4 y = d * r * sg;
        *(unsigned long long*)(AO + (size_t)m * 2048 + h * 128 + li * 4) = (unsigned long long)pkbf(y.x, y.y) | ((unsigned long long)pkbf(y.z, y.w) << 32); }
}

__global__ void __launch_bounds__(NWAVES * 64, 2) fwd_kernel(Args args) {
    extern __shared__ __attribute__((aligned(16))) unsigned char lds[];
    Ctx F;
    F.lds = (LAS unsigned char*)lds; F.tid = threadIdx.x; F.lane = F.tid & 63; F.wave = __builtin_amdgcn_readfirstlane(F.tid >> 6);
    F.G = gridDim.x; F.bx = blockIdx.x; { const int bx = blockIdx.x; F.vcu = (F.G % 8 == 0) ? (bx % 8) * (F.G / 8) + bx / 8 : bx; }
    F.out = args.out; F.ws = args.ws;
    volatile LAS unsigned* MISC = (volatile LAS unsigned*)(F.lds + MISC_OFF);
    for (int u = F.tid; u < (LDS_BYTES - RING_BYTES) / 4; u += NWAVES * 64) ((LAS unsigned*)(F.lds + RING_BYTES))[u] = 0u;
    __syncthreads();
    const int lo = args.ph_lo, hi = args.ph_hi;
    unsigned* barw = (unsigned*)(F.ws + WS_CTL) + CW_BAR + args.bar_region * XCD_BAR_WORDS;
    XcdBarrier bar; bar.bar = barw; bar.x = 0; bar.st = nullptr;
    if (hi - lo > 1) bar = xcd_barrier_post(barw, MISC + 8);
#ifndef PHM
#define PHM 0xfff
#endif
#define IN(k) (lo <= (k) && (k) < hi)
#define SEAM(k) do { if (IN(k) && IN((k) + 1)) xcd_barrier(bar); } while (0)

    if ((PHM & 1) && IN(0)) { const Ctx P = launder(F); p0_prologue(args, P); SEAM(0); }

    for (int l = 0; l < DEPTH; ++l) {
        const int pb = 1 + 10 * l;
#define PTRS() bf16* Zb = (bf16*)(P.ws + WS_Z); bf16* ACT = (bf16*)(P.ws + WS_ACT); bf16* XB = (bf16*)(P.ws + WS_XB); float* YF = (float*)(P.ws + WS_O12); float* HC = (float*)(P.ws + WS_HC); \
        bf16* HID = (bf16*)(P.ws + WS_Z); const unsigned char* wl = P.ws + WS_W + (size_t)l * W_LAYER; const float* MODl = (const float*)(P.ws + WS_MOD) + (size_t)l * 3 * NMOD; \
        const float* h_lat = l == 0 ? args.in[0] : P.out; const float* h_ctx = l == 0 ? args.in[2] : HC; \
        (void)Zb; (void)ACT; (void)XB; (void)YF; (void)HC; (void)HID; (void)wl; (void)MODl; (void)h_lat; (void)h_ctx;
        if ((PHM & 2) && IN(pb + 0)) { const Ctx P = launder(F); PTRS(); norm_phase(P, l, 0, h_lat, h_ctx); SEAM(pb + 0); }
        if ((PHM & 4) && IN(pb + 1)) { const Ctx P = launder(F); PTRS();
            pg8::Gemm g{ACT, (const bf16*)(wl + W_IN), MT, IN_DIM, DM}; pg8::StaticOrder S; S.init(MT, IN_DIM, P.G, P.bx);
            pg8::EpiZ E{Zb};
            pg8::gemm_phase<pg8::EpiZ, pg8::StaticOrder, true, true>(P.lds, P.tid, g, S, E);
            SEAM(pb + 1);
        }
        if ((PHM & 8) && IN(pb + 2)) { { const Ctx P = launder(F); qk_phase(args, P, l); } { const Ctx P = launder(F); conv_phase(args, P, l); } { const Ctx P = launder(F); mlp_phase(args, P, l); } SEAM(pb + 2); }
        if ((PHM & 16) && IN(pb + 3)) { const Ctx P = launder(F); attn_phase(P, l + 1 < DEPTH); SEAM(pb + 3); }
        if ((PHM & 32) && IN(pb + 4)) { const Ctx P = launder(F); comb_phase(args, P, l, l == 0 ? 0.2f : 0.35550906759096924f); SEAM(pb + 4); }
        if ((PHM & 64) && IN(pb + 5)) { const Ctx P = launder(F); PTRS();
            pg8::Gemm g{XB, (const bf16*)(wl + W_BR), 3 * MT, 3 * DM, 2048}; pg8::BranchOrder S{P.G, P.bx};
            pg8::EpiBr E{Zb, YF, ACT};
            pg8::gemm_phase<pg8::EpiBr, pg8::BranchOrder, true, true>(P.lds, P.tid, g, S, E);
            SEAM(pb + 5);
        }
        if ((PHM & 128) && IN(pb + 6)) { const Ctx P = launder(F); PTRS();
            pg8::Gemm g{ACT, (const bf16*)(wl + W_O), MT, DM, DM}; pg8::StaticOrder S; S.init(MT, DM, P.G, P.bx);
            pg8::EpiRes E{h_lat, h_ctx, P.out, HC, MODl + 2 * DM};
            pg8::gemm_phase<pg8::EpiRes, pg8::StaticOrder, true, true>(P.lds, P.tid, g, S, E);
            SEAM(pb + 6);
        }
        if ((PHM & 256) && IN(pb + 7)) { const Ctx P = launder(F); PTRS(); norm_phase(P, l, 1, P.out, HC); SEAM(pb + 7); }
        if ((PHM & 512) && IN(pb + 8)) { const Ctx P = launder(F); PTRS();
            pg8::Gemm g{ACT, (const bf16*)(wl + W_GU), MT, 2 * FF, DM}; pg8::StaticOrder S; S.init(MT, 2 * FF, P.G, P.bx);
            pg8::EpiGU E{HID};
            pg8::gemm_phase<pg8::EpiGU, pg8::StaticOrder, true, true>(P.lds, P.tid, g, S, E);
            SEAM(pb + 8);
        }
        if ((PHM & 1024) && IN(pb + 9)) { const Ctx P = launder(F); PTRS();
            pg8::Gemm g{HID, (const bf16*)(wl + W_D), MT, DM, FF}; pg8::StaticOrder S; S.init(MT, DM, P.G, P.bx);
            pg8::EpiRes E{P.out, HC, P.out, HC, MODl + 5 * DM};
            pg8::gemm_phase<pg8::EpiRes, pg8::StaticOrder, true, true>(P.lds, P.tid, g, S, E);
            SEAM(pb + 9);
        }
    }
#undef IN
#undef SEAM
}

#ifndef MK_PER_PHASE
#define MK_PER_PHASE 1
#endif
extern "C" void kernel_launch(void* const* d_in, const int* in_sizes, int n_in, void* d_out, int out_size, void* d_ws, size_t ws_size, hipStream_t stream) {
    static int grid = 0;
    if (grid == 0) {
        if (n_in != 25 || in_sizes[0] != ML * DM || out_size != ML * DM || ws_size < WS_END) {
            fprintf(stderr, "kernel_launch: shape mismatch: n_in %d in0 %d out %d ws %zu (need %zu); nothing launched\n", n_in, n_in > 0 ? in_sizes[0] : -1, out_size, ws_size, (size_t)WS_END); grid = -1; return; }
        int dev = 0, cus = 0, per_cu = 0;
        if (hipGetDevice(&dev) != hipSuccess || hipDeviceGetAttribute(&cus, hipDeviceAttributeMultiprocessorCount, dev) != hipSuccess) { grid = -1; return; }
        if (hipFuncSetAttribute((const void*)fwd_kernel, hipFuncAttributeMaxDynamicSharedMemorySize, LDS_BYTES) != hipSuccess) { fprintf(stderr, "kernel_launch: hipFuncSetAttribute failed\n"); grid = -1; return; }
        if (hipOccupancyMaxActiveBlocksPerMultiprocessor(&per_cu, (const void*)fwd_kernel, NWAVES * 64, LDS_BYTES) != hipSuccess || per_cu < 1)
            fprintf(stderr, "kernel_launch: note: occupancy query reports %d workgroups per CU\n", per_cu);
        (void)hipGetLastError();
        grid = cus;
    }
    if (grid < 0) return;
    if (hipMemsetAsync((char*)d_ws + WS_CTL, 0, CTL_ZERO_BYTES, stream) != hipSuccess) return;
    Args a{};
    for (int i = 0; i < 25; ++i) a.in[i] = (const float*)d_in[i];
    a.out = (float*)d_out; a.ws = (unsigned char*)d_ws; a.pad = 0;
#if MK_PER_PHASE
    for (int p = 0; p < N_PHASES; ++p) { a.ph_lo = p; a.ph_hi = p + 1; a.bar_region = 0;
        hipLaunchKernelGGL(fwd_kernel, dim3(grid), dim3(NWAVES * 64), LDS_BYTES, stream, a); }
#else
    a.ph_lo = 0; a.ph_hi = N_PHASES; a.bar_region = 0;
    hipLaunchKernelGGL(fwd_kernel, dim3(grid), dim3(NWAVES * 64), LDS_BYTES, stream, a);
#endif
    const hipError_t le = hipPeekAtLastError();
    if (le != hipSuccess) fprintf(stderr, "kernel_launch: launch failed: %s\n", hipGetErrorName(le));
}
```

```cpp
#include <hip/hip_runtime.h>
#include <hip/hip_bf16.h>
#include <cstdio>
#include <cstdint>

constexpr int DM = 4096, NBATCH = 2, SEQ = 8192, CTXL = 256, DEPTH = 2;
constexpr int ML = NBATCH * SEQ, MC = NBATCH * CTXL, MT = ML + MC;
constexpr int IN_DIM = 28672, FF = 11008, NMOD = 6 * DM;
constexpr int ZC_BG = 0, ZC_CG = 2048, ZC_XIN = 4096, ZC_Q = 6144, ZC_K = 8192, ZC_V = 10240, ZC_U = 12288, ZC_VM = 14336, ZC_GATE = 16384;
constexpr float EPS = 1e-6f;
constexpr int NTM = MT / 256;

namespace pg8 {
#define PG8_LAS __attribute__((address_space(3)))
typedef unsigned short bf16_t;
typedef short bf16x8 __attribute__((ext_vector_type(8)));
typedef float f32x4 __attribute__((ext_vector_type(4)));
typedef unsigned u32x4 __attribute__((ext_vector_type(4)));
constexpr int BM = 256, BK = 64, HALF = 128, HTB = HALF * BK * 2  , STAGE_BYTES = 8 * HTB, NXCD = 8, WGM = 4;

__host__ __device__ __forceinline__ int lds_byte(int r, int c) { const int st = (r >> 4) * 2 + (c >> 5), rr = r & 15, cc = c & 31, ob = rr * 64 + cc * 2; return st * 1024 + (ob ^ (((ob >> 9) & 1) << 5)); }
__host__ __device__ __forceinline__ void stage_rc(int b, int& R, int& C) { const int st = b / 1024, sb = b % 1024, swz = sb ^ (((sb >> 9) & 1) << 5); R = (st >> 1) * 16 + swz / 64; C = (st & 1) * 32 + (swz % 64) / 2; }
__host__ __device__ __forceinline__ int perm32(int rho) { const int n = rho >> 4, i = rho & 15; return 8 * (i >> 2) + 4 * n + (i & 3); }

struct Unit { int pm, pn, k0, nk, ks; };
struct Gemm { const bf16_t* A; const bf16_t* Bt; int M, N, K; };

#ifndef XROT
#define XROT 0
#endif
struct StaticOrder {
    int nM, nN, nwg, G, c, nkf;
    __host__ __device__ void init(int M, int N, int G_, int c_, int K_) { nM = M / BM; nN = N / BM; nwg = nM * nN; G = G_; c = c_; nkf = K_ / BK; }
    __host__ __device__ long lin(int i) const { return (G & 7) ? (long)i * G + c : (long)i * G + (long)((c + XROT) & 7) * (G >> 3) + (c >> 3); }
    __host__ __device__ void tile_of(int U, int& pm, int& pn) const {
        constexpr int CW = 8, R = WGM; const int cc = U / (nM * CW); int cw = nN - cc * CW; cw = cw > CW ? CW : cw;
        const int up = U - cc * nM * CW, g = up / (R * cw); int rg = nM - R * g; rg = rg > R ? R : rg;
        const int upp = up - g * R * cw; pn = cc * CW + upp / rg; pm = R * g + upp % rg;
    }
    __host__ __device__ bool next(int i, Unit& u) const {
        const long L = lin(i); if (L >= nwg) return false;
        tile_of((int)L, u.pm, u.pn); u.k0 = 0; u.nk = nkf; u.ks = -1; return true;
    }
    __device__ __forceinline__ void a_ready(const Unit&) const {}
    __device__ __forceinline__ void done(const Unit&) const {}
};

__device__ __forceinline__ unsigned cvt_pk_bf16(float lo, float hi) { unsigned r; asm volatile("v_cvt_pk_bf16_f32 %0, %1, %2" : "=v"(r) : "v"(lo), "v"(hi)); return r; }
typedef float f32x2 __attribute__((ext_vector_type(2)));
__device__ __forceinline__ float fsigmoid(float x) { return __builtin_amdgcn_rcpf(1.f + __builtin_amdgcn_exp2f(-1.4426950408889634f * x)); }
__device__ __forceinline__ float fgelu(float x) { const float t = x * (1.f + 0.044715f * x * x); return x * __builtin_amdgcn_rcpf(1.f + __builtin_amdgcn_exp2f(-2.3022081981f * t)); }
__device__ __forceinline__ float bflo(unsigned w) { return __uint_as_float(w << 16); }
__device__ __forceinline__ float bfhi(unsigned w) { return __uint_as_float(w & 0xffff0000u); }

struct EpiZ {
    static constexpr bool PERM = true, AFTER_DRAIN = false, DRAIN_AFTER = false;
    __device__ static __forceinline__ bool reset_after(const Unit&) { return true; }
    bf16_t* Z; float* KVF;
    __device__ __forceinline__ void operator()(const f32x4 (&acc)[2][2][4][2], const Unit& u, int wr, int wc, int fr, int fq) const {
        const int row0 = u.pm * BM + wr * 64 + fr, col0 = u.pn * BM + wc * 32 + 8 * fq;
        if (u.ks >= 0) {
            float* slab = KVF + (size_t)u.ks * MC * 4096;
#pragma unroll
            for (int ai = 0; ai < 2; ++ai)
#pragma unroll
                for (int m = 0; m < 4; ++m) { float* rowp = slab + (size_t)(row0 - ML + ai * HALF + m * 16) * 4096 + (col0 - ZC_K);
#pragma unroll
                    for (int bj = 0; bj < 2; ++bj) { *(f32x4*)(rowp + bj * HALF) = acc[ai][bj][m][0]; *(f32x4*)(rowp + bj * HALF + 4) = acc[ai][bj][m][1]; } }
            return;
        }
        const int mode = u.pn < 48 ? 0 : (u.pn < 64 ? 1 : 2);
#pragma unroll
        for (int ai = 0; ai < 2; ++ai)
#pragma unroll
            for (int m = 0; m < 4; ++m) { bf16_t* rowp = Z + (size_t)(row0 + ai * HALF + m * 16) * IN_DIM + col0;
#pragma unroll
                for (int bj = 0; bj < 2; ++bj) { f32x4 v0 = acc[ai][bj][m][0], v1 = acc[ai][bj][m][1];
                    if (mode == 1) {
#pragma unroll
                        for (int e = 0; e < 4; ++e) { v0[e] = fgelu(v0[e]); v1[e] = fgelu(v1[e]); } }
                    else if (mode == 2) {
#pragma unroll
                        for (int e = 0; e < 4; ++e) { v0[e] = fmaxf(fsigmoid(v0[e]), 1e-7f); v1[e] = fmaxf(fsigmoid(v1[e]), 1e-7f); } }
                    u32x4 w; w.x = cvt_pk_bf16(v0[0], v0[1]); w.y = cvt_pk_bf16(v0[2], v0[3]); w.z = cvt_pk_bf16(v1[0], v1[1]); w.w = cvt_pk_bf16(v1[2], v1[3]);
                    *(u32x4*)(rowp + bj * HALF) = w; } }
    }
};

struct EpiBr {
    static constexpr bool PERM = true, AFTER_DRAIN = false, DRAIN_AFTER = true;
    const bf16_t* Z; bf16_t* Y;
    __device__ static __forceinline__ bool reset_after(const Unit& u) { return u.pm >= 2 * NTM; }
    __device__ __forceinline__ void operator()(f32x4 (&acc)[2][2][4][2], const Unit& u, int wr, int wc, int fr, int fq) const {
        const int br = u.pm / NTM, pm = u.pm - br * NTM, pn = u.pn - br * 16;
        const int row0 = pm * BM + wr * 64 + fr, col0 = pn * BM + wc * 32 + 8 * fq;
        if (br < 2) {
#pragma unroll
            for (int ai = 0; ai < 2; ++ai)
#pragma unroll
                for (int mh = 0; mh < 2; ++mh) {
                    u32x4 g[2][2], h[2][2];
#pragma unroll
                    for (int mm = 0; mm < 2; ++mm)
#pragma unroll
                        for (int bj = 0; bj < 2; ++bj) { const bf16_t* gp = Z + (size_t)(row0 + ai * HALF + (2 * mh + mm) * 16) * IN_DIM + ZC_GATE + br * DM + col0 + bj * HALF;
                            g[mm][bj] = *(const u32x4*)gp; h[mm][bj] = *(const u32x4*)(gp + DM); }
                    __builtin_amdgcn_sched_barrier(0);
#pragma unroll
                    for (int mm = 0; mm < 2; ++mm)
#pragma unroll
                        for (int bj = 0; bj < 2; ++bj) { const u32x4 gg = g[mm][bj], hh = h[mm][bj]; f32x4& v0 = acc[ai][bj][2 * mh + mm][0]; f32x4& v1 = acc[ai][bj][2 * mh + mm][1];
                            v0[0] *= bflo(gg.x) * __builtin_amdgcn_rcpf(bflo(hh.x)); v0[1] *= bfhi(gg.x) * __builtin_amdgcn_rcpf(bfhi(hh.x)); v0[2] *= bflo(gg.y) * __builtin_amdgcn_rcpf(bflo(hh.y)); v0[3] *= bfhi(gg.y) * __builtin_amdgcn_rcpf(bfhi(hh.y));
                            v1[0] *= bflo(gg.z) * __builtin_amdgcn_rcpf(bflo(hh.z)); v1[1] *= bfhi(gg.z) * __builtin_amdgcn_rcpf(bfhi(hh.z)); v1[2] *= bflo(gg.w) * __builtin_amdgcn_rcpf(bflo(hh.w)); v1[3] *= bfhi(gg.w) * __builtin_amdgcn_rcpf(bfhi(hh.w)); }
                    __builtin_amdgcn_sched_barrier(0);
                }
        } else {
#pragma unroll
            for (int ai = 0; ai < 2; ++ai) {
                u32x4 g[4][2];
#pragma unroll
                for (int m = 0; m < 4; ++m)
#pragma unroll
                    for (int bj = 0; bj < 2; ++bj) g[m][bj] = *(const u32x4*)(Z + (size_t)(row0 + ai * HALF + m * 16) * IN_DIM + ZC_GATE + 2 * DM + col0 + bj * HALF);
                __builtin_amdgcn_sched_barrier(0);
#pragma unroll
                for (int m = 0; m < 4; ++m)
#pragma unroll
                    for (int bj = 0; bj < 2; ++bj) { const u32x4 gg = g[m][bj]; const f32x4 a0 = acc[ai][bj][m][0], a1 = acc[ai][bj][m][1];
                        u32x4 w; w.x = cvt_pk_bf16(a0[0] * bflo(gg.x), a0[1] * bfhi(gg.x)); w.y = cvt_pk_bf16(a0[2] * bflo(gg.y), a0[3] * bfhi(gg.y));
                        w.z = cvt_pk_bf16(a1[0] * bflo(gg.z), a1[1] * bfhi(gg.z)); w.w = cvt_pk_bf16(a1[2] * bflo(gg.w), a1[3] * bfhi(gg.w));
                        *(u32x4*)(Y + (size_t)(row0 + ai * HALF + m * 16) * DM + col0 + bj * HALF) = w; }
                __builtin_amdgcn_sched_barrier(0);
            }
        }
    }
};

struct EpiRes {
    static constexpr bool PERM = false, AFTER_DRAIN = false, DRAIN_AFTER = true;
    __device__ static __forceinline__ bool reset_after(const Unit&) { return true; }
    const float* src_lat; const float* src_ctx; float* dst_lat; float* dst_ctx; const float* gvec; float* slabs;
    __device__ __forceinline__ void operator()(const f32x4 (&acc)[2][2][4][2], const Unit& u, int wr, int wc, int fr, int fq) const {
        const int pm = u.pm, cls = pm < 32 ? 0 : (pm < 64 ? 1 : 2);
        const float* src = pm < 64 ? src_lat + (size_t)pm * BM * DM : src_ctx + (size_t)(pm - 64) * BM * DM;
        float* dst = pm < 64 ? dst_lat + (size_t)pm * BM * DM : dst_ctx + (size_t)(pm - 64) * BM * DM;
        const int col0 = u.pn * BM + wc * 32 + 4 * fq; const float* gv = gvec + (size_t)cls * NMOD + col0;
        f32x4 g[2][2];
#pragma unroll
        for (int bj = 0; bj < 2; ++bj)
#pragma unroll
            for (int n = 0; n < 2; ++n) g[bj][n] = *(const f32x4*)(gv + bj * HALF + n * 16);
        if (u.ks >= 0) {
            float* slab = slabs + (size_t)u.ks * MC * DM + (size_t)(pm - 64) * BM * DM;
#pragma unroll
            for (int ai = 0; ai < 2; ++ai)
#pragma unroll
                for (int m = 0; m < 4; ++m) { float* rowp = slab + (size_t)(ai * HALF + wr * 64 + m * 16 + fr) * DM + col0;
#pragma unroll
                    for (int bj = 0; bj < 2; ++bj)
#pragma unroll
                        for (int n = 0; n < 2; ++n) *(f32x4*)(rowp + bj * HALF + n * 16) = g[bj][n] * acc[ai][bj][m][n]; }
            return;
        }
#pragma unroll
        for (int am = 0; am < 4; ++am) { const int ai = am >> 1, m0 = (am & 1) * 2;
            f32x4 s[2][2][2];
#pragma unroll
            for (int mm = 0; mm < 2; ++mm) { const size_t off = (size_t)(ai * HALF + wr * 64 + (m0 + mm) * 16 + fr) * DM + col0;
#pragma unroll
                for (int bj = 0; bj < 2; ++bj)
#pragma unroll
                    for (int n = 0; n < 2; ++n) s[mm][bj][n] = *(const f32x4*)(src + off + bj * HALF + n * 16); }
            __builtin_amdgcn_sched_barrier(0);
#pragma unroll
            for (int mm = 0; mm < 2; ++mm) { const size_t off = (size_t)(ai * HALF + wr * 64 + (m0 + mm) * 16 + fr) * DM + col0;
#pragma unroll
                for (int bj = 0; bj < 2; ++bj)
#pragma unroll
                    for (int n = 0; n < 2; ++n) *(f32x4*)(dst + off + bj * HALF + n * 16) = s[mm][bj][n] + g[bj][n] * acc[ai][bj][m0 + mm][n]; }
            __builtin_amdgcn_sched_barrier(0);
        }
    }
};

struct EpiGU {
    static constexpr bool PERM = true, AFTER_DRAIN = false, DRAIN_AFTER = false;
    __device__ static __forceinline__ bool reset_after(const Unit&) { return true; }
    bf16_t* H;
    __device__ __forceinline__ void operator()(const f32x4 (&acc)[2][2][4][2], const Unit& u, int wr, int wc, int fr, int fq) const {
        const int row0 = u.pm * BM + wr * 64 + fr, col0 = u.pn * HALF + wc * 32 + 8 * fq;
#pragma unroll
        for (int ai = 0; ai < 2; ++ai)
#pragma unroll
            for (int m = 0; m < 4; ++m) { f32x4 g0 = acc[ai][0][m][0], g1 = acc[ai][0][m][1]; const f32x4 u0 = acc[ai][1][m][0], u1 = acc[ai][1][m][1];
#pragma unroll
                for (int e = 0; e < 4; ++e) { g0[e] = g0[e] * fsigmoid(g0[e]) * u0[e]; g1[e] = g1[e] * fsigmoid(g1[e]) * u1[e]; }
                u32x4 w; w.x = cvt_pk_bf16(g0[0], g0[1]); w.y = cvt_pk_bf16(g0[2], g0[3]); w.z = cvt_pk_bf16(g1[0], g1[1]); w.w = cvt_pk_bf16(g1[2], g1[3]);
                *(u32x4*)(H + (size_t)(row0 + ai * HALF + m * 16) * FF + col0) = w; }
    }
};

struct BranchOrder {
    int G, c, nM;
    __device__ bool next(int i, Unit& u) const {
        const int ti = i / 3, br = i - 3 * ti; StaticOrder T; T.nM = nM; T.nN = 16; T.nwg = nM * 16; T.G = G; T.c = c; T.nkf = 2048 / BK;
        const long L = T.lin(ti); if (L >= T.nwg) return false;
        int pm, pn; T.tile_of((int)L, pm, pn);
        u.pm = br * NTM + pm; u.pn = br * 16 + pn; u.k0 = 0; u.nk = 2048 / BK; u.ks = -1; return true;
    }
    __device__ __forceinline__ void a_ready(const Unit&) const {}
    __device__ __forceinline__ void done(const Unit&) const {}
};
__device__ __forceinline__ void ksplit8(int nkf, int s, int& k0, int& nk) { const int e = (nkf / 8) & ~1, half = (nkf - 8 * e) / 2; k0 = s * e + 2 * (s < half ? s : half); nk = e + (s < half ? 2 : 0); }
struct InOrder {
    StaticOrder S; int nmain, kv_only;
    __device__ void init(int G, int c, bool last) { kv_only = last; S.init(last ? ML : MT, IN_DIM, G, c, DM); nmain = S.nwg; }
    __device__ bool next(int i, Unit& u) const {
        if (S.next(i, u)) return true;
        if (!kv_only) return false;
        const long L = S.lin(i) - nmain; if (L < 0 || L >= 256) return false;
        const int tile = (int)(L >> 3); u.pm = 64 + (tile >> 4); u.pn = 32 + (tile & 15); u.ks = (int)(L & 7); ksplit8(DM / BK, u.ks, u.k0, u.nk); return true;
    }
    __device__ __forceinline__ void a_ready(const Unit&) const {}
    __device__ __forceinline__ void done(const Unit&) const {}
};
struct ResOrder {
    StaticOrder S; int nmain, with_ctx;
    __device__ void init(int G, int c, int K, bool ctx) { with_ctx = ctx; S.init(ML, DM, G, c, K); nmain = S.nwg; }
    __device__ bool next(int i, Unit& u) const {
        if (S.next(i, u)) return true;
        if (!with_ctx) return false;
        const long L = S.lin(i) - nmain; if (L < 0 || L >= 256) return false;
        const int tile = (int)(L >> 3); u.pm = 64 + (tile >> 4); u.pn = tile & 15; u.ks = (int)(L & 7); ksplit8(S.nkf, u.ks, u.k0, u.nk); return true;
    }
    __device__ __forceinline__ void a_ready(const Unit&) const {}
    __device__ __forceinline__ void done(const Unit&) const {}
};

template <class Epi, class Sched, bool ALIGN_EPI = false, bool SP2 = false>
__device__ __forceinline__ void gemm_phase(PG8_LAS unsigned char* lds, const int tid, const Gemm g, const Sched& S, const Epi& E) {
    const int wid = __builtin_amdgcn_readfirstlane(tid >> 6), lane = tid & 63, wr = wid >> 2, wc = wid & 3, fr = lane & 15, fq = lane >> 4;
    const int K = g.K;
    unsigned voffA[2], voffB[2];
#pragma unroll
    for (int i = 0; i < 2; ++i) { int R, C; stage_rc(tid * 16 + i * 8192, R, C); const int Rb = Epi::PERM ? ((R & ~31) + perm32(R & 31)) : R;
        voffA[i] = (unsigned)(R * K + C) * 2u; voffB[i] = (unsigned)(Rb * K + C) * 2u; }
    const size_t kstep = (size_t)(BK * 2);
    const size_t hstep = (size_t)HALF * K * 2;
    const size_t tstep = 2 * hstep;
    const unsigned ldsw = (unsigned)wid * 1024u;
    const int aoff = lds_byte(wr * 64 + fr, fq * 8), boff = lds_byte(wc * 32 + fr, fq * 8);
#define PG8_SA(b, h) (((b) * 2 + (h)) * HTB)
#define PG8_SB(b, h) ((4 + (b) * 2 + (h)) * HTB)
#define PG8_STAGE(bufoff, gbase, voff) do { _Pragma("unroll") for (int _i = 0; _i < 2; ++_i) \
        __builtin_amdgcn_global_load_lds((const unsigned*)((const char*)(gbase) + (voff)[_i]), (PG8_LAS unsigned*)(lds + (bufoff) + ldsw + _i * 8192), 16, 0, 0); } while (0)
#define PG8_LDA(dst, b, h) do { _Pragma("unroll") for (int m = 0; m < 4; ++m) _Pragma("unroll") for (int k = 0; k < 2; ++k) dst[m][k] = *(const PG8_LAS bf16x8*)(lds + PG8_SA(b, h) + aoff + m * 2048 + k * 1024); } while (0)
#define PG8_LDB(dst, b, h) do { _Pragma("unroll") for (int n = 0; n < 2; ++n) _Pragma("unroll") for (int k = 0; k < 2; ++k) dst[n][k] = *(const PG8_LAS bf16x8*)(lds + PG8_SB(b, h) + boff + n * 2048 + k * 1024); } while (0)
#define PG8_MMA(ai, bj, At, Bt) do { __builtin_amdgcn_s_setprio(1); _Pragma("unroll") for (int m = 0; m < 4; ++m) _Pragma("unroll") for (int n = 0; n < 2; ++n) _Pragma("unroll") for (int k = 0; k < 2; ++k) \
        acc[ai][bj][m][n] = __builtin_amdgcn_mfma_f32_16x16x32_bf16(Bt[n][k], At[m][k], acc[ai][bj][m][n], 0, 0, 0); __builtin_amdgcn_s_setprio(0); } while (0)
#define PG8_WAIT_V(n) asm volatile("s_waitcnt vmcnt(" #n ")" ::: "memory")
#define PG8_WAIT_L(n) asm volatile("s_waitcnt lgkmcnt(" #n ")" ::: "memory")
#define PG8_BAR __builtin_amdgcn_s_barrier()
#define PG8_SCHED __builtin_amdgcn_sched_barrier(0)
    Unit cur, nxt; int ui = 0;
    if (!S.next(0, cur)) return;
    f32x4 acc[2][2][4][2];
#pragma unroll
    for (int a = 0; a < 2; ++a)
#pragma unroll
        for (int b = 0; b < 2; ++b)
#pragma unroll
            for (int m = 0; m < 4; ++m)
#pragma unroll
                for (int n = 0; n < 2; ++n) acc[a][b][m][n] = (f32x4){0.f, 0.f, 0.f, 0.f};
    bf16x8 At[4][2], B0[2][2], B1[2][2];
#ifdef GEMM_FIXED
#define PG8_PM(u) (((GEMM_FIXED) & 1) ? 0 : (u).pm)
#define PG8_PN(u) (((GEMM_FIXED) & 2) ? 0 : (u).pn)
#else
#define PG8_PM(u) ((u).pm)
#define PG8_PN(u) ((u).pn)
#endif
    const char* cA = (const char*)g.A + (size_t)PG8_PM(cur) * tstep + (size_t)cur.k0 * kstep; const char* cB = (const char*)g.Bt + (size_t)PG8_PN(cur) * tstep + (size_t)cur.k0 * kstep;
    int nt = cur.nk;
    S.a_ready(cur);
    if constexpr (SP2) {
        PG8_STAGE(PG8_SB(0, 0), cB, voffB); PG8_STAGE(PG8_SB(0, 1), cB + hstep, voffB); PG8_STAGE(PG8_SA(0, 0), cA, voffA); PG8_STAGE(PG8_SA(0, 1), cA + hstep, voffA);
        if (wr == 1) PG8_BAR;
        PG8_WAIT_V(2); PG8_BAR;
        PG8_STAGE(PG8_SB(1, 0), cB + kstep, voffB); PG8_STAGE(PG8_SA(1, 0), cA + kstep, voffA); PG8_STAGE(PG8_SB(1, 1), cB + hstep + kstep, voffB);
        PG8_WAIT_V(6); PG8_BAR;
    } else {
        PG8_STAGE(PG8_SB(0, 0), cB, voffB); PG8_STAGE(PG8_SA(0, 0), cA, voffA); PG8_STAGE(PG8_SB(0, 1), cB + hstep, voffB); PG8_STAGE(PG8_SA(0, 1), cA + hstep, voffA);
        if (wr == 1) PG8_BAR;
        PG8_WAIT_V(4); PG8_BAR;
        PG8_STAGE(PG8_SB(1, 0), cB + kstep, voffB); PG8_STAGE(PG8_SA(1, 0), cA + kstep, voffA); PG8_STAGE(PG8_SB(1, 1), cB + hstep + kstep, voffB);
        PG8_WAIT_V(6); PG8_BAR;
    }
    for (;;) {
        const bool has_next = S.next(ui + 1, nxt);
        const char* nA = has_next ? (const char*)g.A + (size_t)PG8_PM(nxt) * tstep + (size_t)nxt.k0 * kstep : cA; const char* nB = has_next ? (const char*)g.Bt + (size_t)PG8_PN(nxt) * tstep + (size_t)nxt.k0 * kstep : cB;
        for (int t = 0; t < nt; t += 2) {
            const bool last = (t == nt - 2);
            const char* a1 = cA + (size_t)(t + 1) * kstep;
            const char* a2 = last ? nA : cA + (size_t)(t + 2) * kstep; const char* b2 = last ? nB : cB + (size_t)(t + 2) * kstep;
            const char* a3 = a2 + kstep; const char* b3 = b2 + kstep;
            if (last && has_next) S.a_ready(nxt);
            if constexpr (SP2) {
            PG8_LDB(B0, 0, 0); PG8_LDB(B1, 0, 1); PG8_SCHED; PG8_LDA(At, 0, 0); PG8_STAGE(PG8_SA(1, 1), a1 + hstep, voffA);
            PG8_WAIT_V(8); PG8_WAIT_L(0); PG8_BAR; PG8_MMA(0, 0, At, B0); PG8_MMA(0, 1, At, B1); PG8_BAR; PG8_SCHED;
            PG8_LDA(At, 0, 1); PG8_STAGE(PG8_SB(0, 0), b2, voffB); PG8_STAGE(PG8_SB(0, 1), b2 + hstep, voffB); PG8_STAGE(PG8_SA(0, 0), a2, voffA);
            PG8_WAIT_V(8); PG8_WAIT_L(0); PG8_BAR; PG8_MMA(1, 0, At, B0); PG8_MMA(1, 1, At, B1); PG8_BAR; PG8_SCHED;
            PG8_LDB(B0, 1, 0); PG8_LDB(B1, 1, 1); PG8_SCHED; PG8_LDA(At, 1, 0); PG8_STAGE(PG8_SA(0, 1), a2 + hstep, voffA);
            PG8_WAIT_V(8); PG8_WAIT_L(0); PG8_BAR; PG8_MMA(0, 0, At, B0); PG8_MMA(0, 1, At, B1); PG8_BAR; PG8_SCHED;
            PG8_LDA(At, 1, 1); PG8_STAGE(PG8_SB(1, 0), b3, voffB); PG8_STAGE(PG8_SB(1, 1), b3 + hstep, voffB); PG8_STAGE(PG8_SA(1, 0), a3, voffA);
            PG8_WAIT_V(8); PG8_WAIT_L(0); PG8_BAR; PG8_MMA(1, 0, At, B0); PG8_MMA(1, 1, At, B1); PG8_BAR; PG8_SCHED;
            } else {
            PG8_LDB(B0, 0, 0); PG8_SCHED; PG8_LDA(At, 0, 0); PG8_STAGE(PG8_SA(1, 1), a1 + hstep, voffA);
            PG8_WAIT_L(8); PG8_BAR; PG8_WAIT_L(0); PG8_MMA(0, 0, At, B0); PG8_BAR; PG8_SCHED;
            PG8_LDB(B1, 0, 1); PG8_STAGE(PG8_SB(0, 0), b2, voffB);
            PG8_BAR; PG8_WAIT_L(0); PG8_MMA(0, 1, At, B1); PG8_BAR;
            PG8_LDA(At, 0, 1); PG8_STAGE(PG8_SA(0, 0), a2, voffA);
            PG8_BAR; PG8_WAIT_L(0); PG8_MMA(1, 0, At, B0); PG8_BAR; PG8_SCHED;
            PG8_STAGE(PG8_SB(0, 1), b2 + hstep, voffB);
            PG8_WAIT_V(6); PG8_BAR; PG8_MMA(1, 1, At, B1); PG8_BAR;
            PG8_LDB(B0, 1, 0); PG8_SCHED; PG8_LDA(At, 1, 0); PG8_STAGE(PG8_SA(0, 1), a2 + hstep, voffA);
            PG8_WAIT_L(8); PG8_BAR; PG8_WAIT_L(0); PG8_MMA(0, 0, At, B0); PG8_BAR; PG8_SCHED;
            PG8_LDB(B1, 1, 1); PG8_STAGE(PG8_SB(1, 0), b3, voffB);
            PG8_BAR; PG8_WAIT_L(0); PG8_MMA(0, 1, At, B1); PG8_BAR;
            PG8_LDA(At, 1, 1); PG8_STAGE(PG8_SA(1, 0), a3, voffA);
            PG8_BAR; PG8_WAIT_L(0); PG8_MMA(1, 0, At, B0); PG8_BAR; PG8_SCHED;
            PG8_STAGE(PG8_SB(1, 1), b3 + hstep, voffB);
            PG8_WAIT_V(6); PG8_BAR; PG8_MMA(1, 1, At, B1); PG8_BAR;
            }
        }
        if constexpr (ALIGN_EPI) { if (wr == 0) PG8_BAR; }
        if constexpr (!Epi::AFTER_DRAIN) { E(acc, cur, wr, wc, fr, fq); S.done(cur);
            if constexpr (Epi::DRAIN_AFTER) __builtin_amdgcn_s_waitcnt(0x0F70); }
        if (!has_next) break;
        if (Epi::reset_after(cur)) {
#pragma unroll
        for (int a = 0; a < 2; ++a)
#pragma unroll
            for (int b = 0; b < 2; ++b)
#pragma unroll
                for (int m = 0; m < 4; ++m)
#pragma unroll
                    for (int n = 0; n < 2; ++n) acc[a][b][m][n] = (f32x4){0.f, 0.f, 0.f, 0.f};
        }
        cur = nxt; cA = nA; cB = nB; nt = cur.nk; ++ui;
        if constexpr (ALIGN_EPI) { if (wr == 1) PG8_BAR; }
    }
    PG8_WAIT_V(0);
    if constexpr (!ALIGN_EPI) { if (wr == 0) PG8_BAR; }
    PG8_BAR;
    if constexpr (Epi::AFTER_DRAIN) { E.fused(acc, cur, wr, wc, fr, fq, lds, wid, lane); S.done(cur); }
#undef PG8_SA
#undef PG8_SB
#undef PG8_STAGE
#undef PG8_LDA
#undef PG8_LDB
#undef PG8_MMA
#undef PG8_WAIT_V
#undef PG8_WAIT_L
#undef PG8_BAR
#undef PG8_SCHED
}
}
namespace att {
using bf16x8 = __attribute__((ext_vector_type(8))) short;
using s16x4  = __attribute__((ext_vector_type(4))) short;
using f32x16 = __attribute__((ext_vector_type(16))) float;
using u32x4  = __attribute__((ext_vector_type(4))) unsigned;
typedef unsigned short bf16_t;
constexpr int NW = 8, QBLK = 32, KVBLK = 64;
constexpr float SCALE = 0.125f, THR = 8.f;
constexpr int LDQK = DM, LDV = IN_DIM;
constexpr int NSLOT = 4;
constexpr int SHM_V = KVBLK * 128 * 2, SHM_K = KVBLK * 64 * 2, SHM_ATTN = NSLOT * SHM_V + NSLOT * SHM_K + NW * 64 * 4;
#define KSWZ(row, colB) ((row) * 128 + ((colB) ^ ((((row) >> 1) & 7) << 4)))
#define SBAR() __builtin_amdgcn_sched_barrier(0)
__device__ __forceinline__ int crow(int r, int hi) { return (r & 3) + 8 * (r >> 2) + 4 * hi; }
__device__ __forceinline__ unsigned cvtpk(float lo, float hi) { unsigned r; asm volatile("v_cvt_pk_bf16_f32 %0, %1, %2" : "=v"(r) : "v"(lo), "v"(hi)); return r; }

__device__ __forceinline__ int v_st(int k, int c) { const int kk = (k & ~0xC) | ((k & 4) << 1) | ((k & 8) >> 1); return ((kk >> 3) * 4 + (c >> 5)) * 512 + ((kk & 7) * 32 + (c & 31)) * 2; }
__device__ __forceinline__ int v_rd_base(int lane) { return ((lane & 3) << 3) | (((lane >> 2) & 3) << 6) | (((lane >> 4) & 1) << 5) | (((lane >> 5) & 1) << 8); }
constexpr int v_rd_off(int d0, int ks, int half) { return d0 * 512 + ks * 4096 + half * 2048; }
template <int OFF> __device__ __forceinline__ s16x4 tr_read(int vb) {
  s16x4 r; asm volatile("ds_read_b64_tr_b16 %0, %1 offset:%2" : "=&v"(r) : "v"(vb), "i"(OFF) : "memory"); return r;
}
template <int D0> __device__ __forceinline__ void pv_one(f32x16& od, int vb, bf16x8 pa0, bf16x8 pa1, bf16x8 pa2, bf16x8 pa3) {
  const s16x4 l0 = tr_read<v_rd_off(D0, 0, 0)>(vb), h0 = tr_read<v_rd_off(D0, 0, 1)>(vb), l1 = tr_read<v_rd_off(D0, 1, 0)>(vb), h1 = tr_read<v_rd_off(D0, 1, 1)>(vb);
  const s16x4 l2 = tr_read<v_rd_off(D0, 2, 0)>(vb), h2 = tr_read<v_rd_off(D0, 2, 1)>(vb), l3 = tr_read<v_rd_off(D0, 3, 0)>(vb), h3 = tr_read<v_rd_off(D0, 3, 1)>(vb);
  asm volatile("s_waitcnt lgkmcnt(0)" ::: "memory"); SBAR();
#define PK(L, H) (bf16x8){L[0], L[1], L[2], L[3], H[0], H[1], H[2], H[3]}
  od = __builtin_amdgcn_mfma_f32_32x32x16_bf16(pa0, PK(l0, h0), od, 0, 0, 0);
  od = __builtin_amdgcn_mfma_f32_32x32x16_bf16(pa1, PK(l1, h1), od, 0, 0, 0);
  od = __builtin_amdgcn_mfma_f32_32x32x16_bf16(pa2, PK(l2, h2), od, 0, 0, 0);
  od = __builtin_amdgcn_mfma_f32_32x32x16_bf16(pa3, PK(l3, h3), od, 0, 0, 0);
#undef PK
}

typedef float f32x2 __attribute__((ext_vector_type(2)));
template <int OFF> __device__ __forceinline__ bf16x8 k_read(int ka) {
  bf16x8 r; asm volatile("ds_read_b128 %0, %1 offset:%2" : "=&v"(r) : "v"(ka), "i"(OFF) : "memory"); return r;
}
struct VFr { s16x4 l0, h0, l1, h1, l2, h2, l3, h3; };
template <int D0, int VS> __device__ __forceinline__ void v_issue(VFr& f, int vb) {
#ifdef ATT_NOVREAD
  f.l0 = f.h0 = f.l1 = f.h1 = f.l2 = f.h2 = f.l3 = f.h3 = (s16x4){1, 1, 1, 1}; return;
#endif
  f.l0 = tr_read<VS * SHM_V + v_rd_off(D0, 0, 0)>(vb); f.h0 = tr_read<VS * SHM_V + v_rd_off(D0, 0, 1)>(vb); f.l1 = tr_read<VS * SHM_V + v_rd_off(D0, 1, 0)>(vb); f.h1 = tr_read<VS * SHM_V + v_rd_off(D0, 1, 1)>(vb);
  f.l2 = tr_read<VS * SHM_V + v_rd_off(D0, 2, 0)>(vb); f.h2 = tr_read<VS * SHM_V + v_rd_off(D0, 2, 1)>(vb); f.l3 = tr_read<VS * SHM_V + v_rd_off(D0, 3, 0)>(vb); f.h3 = tr_read<VS * SHM_V + v_rd_off(D0, 3, 1)>(vb);
}
#define ATT_PK(L, H) (bf16x8){L[0], L[1], L[2], L[3], H[0], H[1], H[2], H[3]}
#define ATT_LGKM(n) asm volatile("s_waitcnt lgkmcnt(" #n ")" ::: "memory")
__device__ __forceinline__ void sm_pair(f32x16& c, const int e, const float) {
#ifdef ATT_NOEXP
  c[e] = c[e] * 0.5f; c[e + 1] = c[e + 1] * 0.5f;
#else
  c[e] = __builtin_amdgcn_exp2f(c[e]); c[e + 1] = __builtin_amdgcn_exp2f(c[e + 1]);
#endif
}
__device__ __forceinline__ void acc_pair(f32x2& lsum, const float a, const float b) {
#ifdef ATT_NOSUM
  return;
#endif
  asm volatile("v_add_f32 %0, %0, %1" : "+v"(lsum.x) : "v"(a)); asm volatile("v_add_f32 %0, %0, %1" : "+v"(lsum.y) : "v"(b));
}
template <int G>
__device__ __forceinline__ void gapv(f32x16& c0, f32x16& c1, bf16x8 (&pn)[4], f32x2& lsum, unsigned (&cv)[4], const float m0c) {
  if constexpr (G < 16) {
    if constexpr (G < 14) { constexpr int e = 4 + 2 * G; if constexpr (e < 16) sm_pair(c0, e, m0c); else sm_pair(c1, e - 16, m0c); }
    constexpr int a = 2 * G;
    if constexpr (a < 16) acc_pair(lsum, c0[a], c0[a + 1]); else acc_pair(lsum, c1[a - 16], c1[a - 15]);
  } else {
    constexpr int k = G - 16, q = k >> 1, B = (q & 1) * 8;
    f32x16& P = (q < 2) ? c0 : c1;
    if constexpr ((k & 1) == 0) { cv[0] = cvtpk(P[B + 0], P[B + 1]); cv[1] = cvtpk(P[B + 2], P[B + 3]); cv[2] = cvtpk(P[B + 4], P[B + 5]); cv[3] = cvtpk(P[B + 6], P[B + 7]); }
    else {
      auto r0 = __builtin_amdgcn_permlane32_swap(cv[0], cv[2], false, false); auto r1 = __builtin_amdgcn_permlane32_swap(cv[1], cv[3], false, false);
      u32x4 w = {r0[0], r1[0], r0[1], r1[1]}; pn[q] = *reinterpret_cast<bf16x8*>(&w);
    }
  }
}
#define ATT_GAP(G) do { SBAR(); gapv<G>(c0, c1, pn, lsum, cv, m0c); SBAR(); } while (0)
#define ATT_PVBLK(OD, F, G0) do { \
    OD = __builtin_amdgcn_mfma_f32_32x32x16_bf16(pp[0], ATT_PK(F.l0, F.h0), OD, 0, 0, 0); ATT_GAP(G0); \
    OD = __builtin_amdgcn_mfma_f32_32x32x16_bf16(pp[1], ATT_PK(F.l1, F.h1), OD, 0, 0, 0); ATT_GAP(G0 + 1); \
    OD = __builtin_amdgcn_mfma_f32_32x32x16_bf16(pp[2], ATT_PK(F.l2, F.h2), OD, 0, 0, 0); ATT_GAP(G0 + 2); \
    OD = __builtin_amdgcn_mfma_f32_32x32x16_bf16(pp[3], ATT_PK(F.l3, F.h3), OD, 0, 0, 0); ATT_GAP(G0 + 3); } while (0)
template <bool HAS_QK, bool HAS_PV, int KS, int VS, class Mid>
__device__ __forceinline__ void att_seg(const Mid& mid, f32x16& c0, f32x16& c1, f32x16& n0, f32x16& n1, const bf16x8 (&pp)[4], bf16x8 (&pn)[4], f32x16 (&o)[4], f32x2& lsum,
                                        const int (&ka)[4], const int vb, const bf16x8 (&qf)[4], const float m0c) {
  unsigned cv[4]; VFr va, vq; bf16x8 kf[8];
  if constexpr (HAS_PV) { v_issue<0, VS>(va, vb); v_issue<1, VS>(vq, vb); }
  SBAR(); sm_pair(c0, 0, m0c); sm_pair(c0, 2, m0c); SBAR();
#define ATT_KQ_ISSUE() do { _Pragma("unroll") for (int d0 = 0; d0 < 4; ++d0) { kf[2 * d0] = k_read<KS * SHM_K>(ka[d0]); kf[2 * d0 + 1] = k_read<KS * SHM_K + 4096>(ka[d0]); } } while (0)
  if constexpr (HAS_PV) {
    ATT_LGKM(8); SBAR();
    ATT_PVBLK(o[0], va, 0);
#ifndef ATT_NOMID
    mid();
#endif
    SBAR();
    v_issue<2, VS>(va, vb); ATT_LGKM(8); SBAR();
    ATT_PVBLK(o[1], vq, 4);
    v_issue<3, VS>(vq, vb); ATT_LGKM(8); SBAR();
    ATT_PVBLK(o[2], va, 8);
    if constexpr (HAS_QK) { ATT_KQ_ISSUE(); ATT_LGKM(8); } else { ATT_LGKM(0); }
    SBAR();
    ATT_PVBLK(o[3], vq, 12);
  } else {
    mid(); SBAR();
    if constexpr (HAS_QK) ATT_KQ_ISSUE();
    ATT_GAP(0); ATT_GAP(1); ATT_GAP(2); ATT_GAP(3); ATT_GAP(4); ATT_GAP(5); ATT_GAP(6); ATT_GAP(7);
    ATT_GAP(8); ATT_GAP(9); ATT_GAP(10); ATT_GAP(11); ATT_GAP(12); ATT_GAP(13); ATT_GAP(14); ATT_GAP(15);
  }
  if constexpr (HAS_QK) {
    n0 = f32x16{}; n1 = f32x16{};
    ATT_LGKM(0); SBAR();
    n0 = __builtin_amdgcn_mfma_f32_32x32x16_bf16(kf[0], qf[0], n0, 0, 0, 0); ATT_GAP(16);
    n1 = __builtin_amdgcn_mfma_f32_32x32x16_bf16(kf[1], qf[0], n1, 0, 0, 0); ATT_GAP(17);
    n0 = __builtin_amdgcn_mfma_f32_32x32x16_bf16(kf[2], qf[1], n0, 0, 0, 0); ATT_GAP(18);
    n1 = __builtin_amdgcn_mfma_f32_32x32x16_bf16(kf[3], qf[1], n1, 0, 0, 0); ATT_GAP(19);
    n0 = __builtin_amdgcn_mfma_f32_32x32x16_bf16(kf[4], qf[2], n0, 0, 0, 0); ATT_GAP(20);
    n1 = __builtin_amdgcn_mfma_f32_32x32x16_bf16(kf[5], qf[2], n1, 0, 0, 0); ATT_GAP(21);
    n0 = __builtin_amdgcn_mfma_f32_32x32x16_bf16(kf[6], qf[3], n0, 0, 0, 0); ATT_GAP(22);
    n1 = __builtin_amdgcn_mfma_f32_32x32x16_bf16(kf[7], qf[3], n1, 0, 0, 0); ATT_GAP(23);
  } else { ATT_GAP(16); ATT_GAP(17); ATT_GAP(18); ATT_GAP(19); ATT_GAP(20); ATT_GAP(21); ATT_GAP(22); ATT_GAP(23); }
#undef ATT_KQ_ISSUE
}

__device__ __forceinline__ void attn_unit(const int MODE, const bf16_t* __restrict__ Qb, const bf16_t* __restrict__ Kh, const bf16_t* __restrict__ Vh, float* __restrict__ OS, bf16_t* __restrict__ AOb,
                                          const float* __restrict__ subg, float lam, float osc, const float m0c, int rowa, int nt0, int rowb, int NT, char* lds, int tid) {
  asm volatile("" : "+v"(tid));
  const int wid = tid >> 6, lane = tid & 63, r32 = lane & 31, hi = lane >> 5;
  char* V_lds = lds; char* K_lds = lds + NSLOT * SHM_V;
  float* ws = (float*)(lds + NSLOT * SHM_V + NSLOT * SHM_K) + wid * 64; float* li_l = ws;
  f32x16 o[4] = {}; bf16x8 qr[4];
  const bf16_t* Qw = Qb + (long)(wid * QBLK + r32) * LDQK + hi * 8;
#pragma unroll
  for (int d0 = 0; d0 < 4; ++d0) qr[d0] = *reinterpret_cast<const bf16x8*>(Qw + d0 * 16);
  unsigned koffd, voffd0, voffd1;
  { const int b = wid * 1024 + lane * 16, row = b >> 7, colB = (b & 127) ^ (((row >> 1) & 7) << 4); koffd = (unsigned)(row * LDQK * 2 + colB); }
  { const int b = wid * 1024 + lane * 16, sub = b >> 9, e = (b & 511) >> 1, kk = (sub >> 2) * 8 + (e >> 5), k = (kk & ~0xC) | ((kk & 4) << 1) | ((kk & 8) >> 1), col = (sub & 3) * 32 + (e & 31);
    voffd0 = (unsigned)(k * LDV * 2 + col * 2); }
  { const int b = 8192 + wid * 1024 + lane * 16, sub = b >> 9, e = (b & 511) >> 1, kk = (sub >> 2) * 8 + (e >> 5), k = (kk & ~0xC) | ((kk & 4) << 1) | ((kk & 8) >> 1), col = (sub & 3) * 32 + (e & 31);
    voffd1 = (unsigned)(k * LDV * 2 + col * 2); }
  const unsigned wid_s = (unsigned)__builtin_amdgcn_readfirstlane(wid);
  const unsigned ldsK = (unsigned)(uintptr_t)(lds + NSLOT * SHM_V) + wid_s * 1024u, ldsV = (unsigned)(uintptr_t)lds + wid_s * 1024u;
  const int vb = (int)(uintptr_t)V_lds + v_rd_base(lane);
  int ka[4];
#pragma unroll
  for (int d0 = 0; d0 < 4; ++d0) ka[d0] = (int)(uintptr_t)K_lds + KSWZ(r32, (d0 * 16 + hi * 8) * 2);
#define KROW(j) ((j) < nt0 ? rowa + (j) * KVBLK : rowb + ((j) - nt0) * KVBLK)
#define GLDS(src, dst) do { unsigned keep_; asm volatile("s_mov_b32 %0, m0\n\ts_mov_b32 m0, %2\n\ts_nop 0\n\tglobal_load_lds_dwordx4 %1, off\n\ts_mov_b32 m0, %0" : "=&s"(keep_) : "v"(src), "s"(dst) : "memory"); } while (0)
#define KDMA(j, slot) do { const int jc_ = (j) < NT ? (j) : NT - 1; GLDS((const char*)Kh + (size_t)KROW(jc_) * (LDQK * 2) + koffd, ldsK + (unsigned)(slot) * SHM_K); } while (0)
#define VDMA(j, slot) do { const int jc_ = (j) < NT ? (j) : NT - 1; const char* vb_ = (const char*)Vh + (size_t)KROW(jc_) * (LDV * 2); \
    GLDS(vb_ + voffd0, ldsV + (unsigned)(slot) * SHM_V); GLDS(vb_ + voffd1, ldsV + (unsigned)(slot) * SHM_V + 8192u); } while (0)
#define SEGEND() do { asm volatile("s_waitcnt vmcnt(0) lgkmcnt(0)" ::: "memory"); __builtin_amdgcn_s_barrier(); asm volatile("" ::: "memory"); } while (0)
  f32x16 sA0, sA1, sB0, sB1; bf16x8 paA[4], paB[4]; f32x2 lsum = {0.f, 0.f};
  const auto nomid = [&]() {};
  KDMA(0, 0); KDMA(1, 1); KDMA(2, 2); VDMA(0, 0);
  SEGEND();
  { bf16x8 kf[8];
#pragma unroll
    for (int d0 = 0; d0 < 4; ++d0) { kf[2 * d0] = k_read<0>(ka[d0]); kf[2 * d0 + 1] = k_read<4096>(ka[d0]); }
    sA0 = f32x16{}; sA1 = f32x16{}; ATT_LGKM(0); SBAR();
#pragma unroll
    for (int d0 = 0; d0 < 4; ++d0) { sA0 = __builtin_amdgcn_mfma_f32_32x32x16_bf16(kf[2 * d0], qr[d0], sA0, 0, 0, 0); sA1 = __builtin_amdgcn_mfma_f32_32x32x16_bf16(kf[2 * d0 + 1], qr[d0], sA1, 0, 0, 0); } }
  SEGEND();
  att_seg<true, false, 1, 0>([&]() { KDMA(3, 3); KDMA(4, 0); VDMA(1, 1); VDMA(2, 2); }, sA0, sA1, sB0, sB1, paB  , paA, o, lsum, ka, vb, qr, m0c);
  att_seg<true, true, 2, 0>(nomid, sB0, sB1, sA0, sA1, paA, paB, o, lsum, ka, vb, qr, m0c);
  SEGEND();
  for (int j = 2; j + 2 < NT; j += 4) {
    att_seg<true, true, 3, 1>([&]() { KDMA(j + 3, 1); KDMA(j + 4, 2); VDMA(j + 1, 3); VDMA(j + 2, 0); }, sA0, sA1, sB0, sB1, paB, paA, o, lsum, ka, vb, qr, m0c);
    att_seg<true, true, 0, 2>(nomid, sB0, sB1, sA0, sA1, paA, paB, o, lsum, ka, vb, qr, m0c);
    SEGEND();
    att_seg<true, true, 1, 3>([&]() { KDMA(j + 5, 3); KDMA(j + 6, 0); VDMA(j + 3, 1); VDMA(j + 4, 2); }, sA0, sA1, sB0, sB1, paB, paA, o, lsum, ka, vb, qr, m0c);
    att_seg<true, true, 2, 0>(nomid, sB0, sB1, sA0, sA1, paA, paB, o, lsum, ka, vb, qr, m0c);
    SEGEND();
  }
  att_seg<true, true, 3, 1>([&]() { VDMA(NT - 1, 3); }, sA0, sA1, sB0, sB1, paB, paA, o, lsum, ka, vb, qr, m0c);
  att_seg<false, true, 0, 2>(nomid, sB0, sB1, sA0, sA1, paA, paB, o, lsum, ka, vb, qr, m0c);
  SEGEND();
  { VFr va, vq;
    v_issue<0, 3>(va, vb); v_issue<1, 3>(vq, vb); ATT_LGKM(8); SBAR();
#define ATT_PV4(OD, F, PP) do { OD = __builtin_amdgcn_mfma_f32_32x32x16_bf16(PP[0], ATT_PK(F.l0, F.h0), OD, 0, 0, 0); OD = __builtin_amdgcn_mfma_f32_32x32x16_bf16(PP[1], ATT_PK(F.l1, F.h1), OD, 0, 0, 0); \
    OD = __builtin_amdgcn_mfma_f32_32x32x16_bf16(PP[2], ATT_PK(F.l2, F.h2), OD, 0, 0, 0); OD = __builtin_amdgcn_mfma_f32_32x32x16_bf16(PP[3], ATT_PK(F.l3, F.h3), OD, 0, 0, 0); } while (0)
    ATT_PV4(o[0], va, paB); SBAR();
    v_issue<2, 3>(va, vb); ATT_LGKM(8); SBAR();
    ATT_PV4(o[1], vq, paB); SBAR();
    v_issue<3, 3>(vq, vb); ATT_LGKM(8); SBAR();
    ATT_PV4(o[2], va, paB); SBAR();
    ATT_LGKM(0); SBAR();
    ATT_PV4(o[3], vq, paB); }
  float l_reg = lsum.x + lsum.y;
  { auto rr = __builtin_amdgcn_permlane32_swap(__float_as_uint(l_reg), __float_as_uint(l_reg), false, false); l_reg = __uint_as_float(rr[0]) + __uint_as_float(rr[1]); }
  if (hi == 0) li_l[r32] = l_reg; asm volatile("s_waitcnt lgkmcnt(0)" ::: "memory");
  float rli[16];
#pragma unroll
  for (int r = 0; r < 16; ++r) rli[r] = __builtin_amdgcn_rcpf(li_l[crow(r, hi)]);
  int zo = 0; asm volatile("" : "+v"(zo));
  float* Ow = OS + (wid * QBLK) * 128 + zo;
  if (MODE == 0) {
#pragma unroll
    for (int r = 0; r < 16; ++r) { const int orow = crow(r, hi);
#pragma unroll
      for (int d0 = 0; d0 < 4; ++d0) Ow[orow * 128 + d0 * 32 + r32] = o[d0][r] * rli[r]; }
  } else {
    float sg[4];
#pragma unroll
    for (int d0 = 0; d0 < 4; ++d0) sg[d0] = subg[d0 * 32 + r32] * osc;
    bf16_t* Aw = AOb + (long)(wid * QBLK) * 2048 + zo;
#pragma unroll
    for (int r = 0; r < 16; ++r) { const int orow = crow(r, hi); float d[4]; float ss = 0.f;
#pragma unroll
      for (int d0 = 0; d0 < 4; ++d0) { d[d0] = __hip_atomic_load(&Ow[orow * 128 + d0 * 32 + r32], __ATOMIC_RELAXED, __HIP_MEMORY_SCOPE_AGENT) - lam * (o[d0][r] * rli[r]); ss += d[d0] * d[d0]; }
      { const int l4 = lane << 2;
#pragma unroll
        for (int k = 1; k < 32; k <<= 1) ss += __uint_as_float((unsigned)__builtin_amdgcn_ds_bpermute(l4 ^ (k << 2), (int)__float_as_uint(ss))); }
      const float rs = __builtin_amdgcn_rsqf(ss * (1.f / 128.f) + EPS);
#pragma unroll
      for (int d0 = 0; d0 < 4; ++d0) Aw[(long)orow * 2048 + d0 * 32 + r32] = (bf16_t)(cvtpk(d[d0] * rs * sg[d0], 0.f) & 0xffffu); }
  }
  asm volatile("s_waitcnt vmcnt(0)" ::: "memory");
  __syncthreads();
#undef KROW
#undef GLDS
#undef KDMA
#undef VDMA
#undef SEGEND
}
}

#define GAS __attribute__((address_space(1)))
#define LAS __attribute__((address_space(3)))
typedef unsigned short bf16;
typedef unsigned v4u __attribute__((ext_vector_type(4)));
typedef float f32x4 __attribute__((ext_vector_type(4)));
typedef short bf16x8 __attribute__((ext_vector_type(8)));
typedef GAS unsigned gu32;
typedef GAS unsigned long long gu64;
#define RLX_AGENT __ATOMIC_RELAXED, __HIP_MEMORY_SCOPE_AGENT
#define LDS_WAIT() asm volatile("s_waitcnt lgkmcnt(0)" ::: "memory")
#define VM_WAIT() asm volatile("s_waitcnt vmcnt(0)" ::: "memory")
__device__ __forceinline__ unsigned long long rt() { return __builtin_amdgcn_s_memrealtime(); }
__device__ __forceinline__ unsigned f2bf(float f) { unsigned u = __builtin_bit_cast(unsigned, f); return (u + 0x7fffu + ((u >> 16) & 1u)) >> 16; }
__device__ __forceinline__ unsigned pk2(float lo, float hi) { return f2bf(lo) | (f2bf(hi) << 16); }

#define XB_TMO      128
#define XB_XCNT(j)  (256  + 64 * (j))
#define XB_XSUB(j)  (1280 + 64 * (j))
#define XB_XGEN(j)  (2304 + 64 * (j))
#define XB_TOP      3328
#define XB_TOPGEN   3392
#define XCD_BAR_WORDS 3456
#define XB_SPIN_CAP (1u << 18)

__device__ __forceinline__ unsigned xb_ld(unsigned* p)              { return __hip_atomic_load(p, __ATOMIC_RELAXED, __HIP_MEMORY_SCOPE_AGENT); }
__device__ __forceinline__ unsigned xb_add(unsigned* p, unsigned v) { return __hip_atomic_fetch_add(p, v, __ATOMIC_RELAXED, __HIP_MEMORY_SCOPE_AGENT); }
__device__ __forceinline__ unsigned xb_xcc_id() { return (unsigned)__builtin_amdgcn_s_getreg((3 << 11) | 20) & 0xFu; }
#define XB_SPIN(cond, bar) do { unsigned _sp = 0; while (cond) { __builtin_amdgcn_s_sleep(1); \
    if ((++_sp & 255u) == 0u) { if (xb_ld(&(bar)[XB_TMO])) break; if (_sp > XB_SPIN_CAP) { atomicAdd(&(bar)[XB_TMO], 1u); break; } } } } while (0)

struct XcdBarrier {
    unsigned* bar; unsigned x;
    volatile LAS unsigned* st;
};

__device__ __forceinline__ XcdBarrier xcd_barrier_post(unsigned* bar, volatile LAS unsigned* st) {
    XcdBarrier b; b.bar = bar; b.x = xb_xcc_id(); b.st = st;
    if (threadIdx.x == 0) (void)xb_add(&bar[XB_XCNT(b.x)], 1u);
    return b;
}
__device__ __forceinline__ void xcd_barrier_complete(unsigned* bar, unsigned x, unsigned& nloc, unsigned& nx) {
    const unsigned G = gridDim.x * gridDim.y * gridDim.z;
    unsigned sum, cnt, mine, sp = 0u;
    for (;;) {
        sum = 0u; cnt = 0u; mine = 0u;
#pragma unroll
        for (unsigned j = 0; j < 16; ++j) { const unsigned c = xb_ld(&bar[XB_XCNT(j)]); sum += c; cnt += (c > 0u) ? 1u : 0u; mine = (j == x) ? c : mine; }
        if (sum == G) break;
        __builtin_amdgcn_s_sleep(1);
        if ((++sp & 255u) == 0u) { if (xb_ld(&bar[XB_TMO])) break; if (sp > XB_SPIN_CAP) { atomicAdd(&bar[XB_TMO], 1u); break; } }
    }
    nloc = mine > 0u ? mine : 1u; nx = cnt > 0u ? cnt : 1u;
}

__device__ __forceinline__ void xcd_barrier(const XcdBarrier& b) {
    asm volatile("s_waitcnt vmcnt(0)" ::: "memory");
    __syncthreads();
    if (threadIdx.x == 0) {
        unsigned* bar = b.bar;
        __builtin_amdgcn_s_waitcnt(0);
        unsigned nloc = b.st[0], nx = b.st[1];
        if (nloc == 0u) { xcd_barrier_complete(bar, b.x, nloc, nx); b.st[0] = nloc; b.st[1] = nx; }
        const unsigned old = xb_add(&bar[XB_XSUB(b.x)], 1u);
        const unsigned gen = old / nloc;
        if (old + 1u == (gen + 1u) * nloc) {
            __builtin_amdgcn_fence(__ATOMIC_RELEASE, "agent");
            asm volatile("s_waitcnt vmcnt(0)" ::: "memory");
            const unsigned og = xb_add(&bar[XB_TOP], 1u);
            const unsigned tg = og / nx;
            if (og + 1u == (tg + 1u) * nx) xb_add(&bar[XB_TOPGEN], 1u);
            else XB_SPIN(xb_ld(&bar[XB_TOPGEN]) == tg, bar);
            __builtin_amdgcn_fence(__ATOMIC_ACQUIRE, "agent");
            xb_add(&bar[XB_XGEN(b.x)], 1u);
            asm volatile("s_waitcnt vmcnt(0)" ::: "memory");
        } else {
            XB_SPIN(xb_ld(&bar[XB_XGEN(b.x)]) == gen, bar);
            __builtin_amdgcn_fence(__ATOMIC_ACQUIRE, "agent");
            asm volatile("s_waitcnt vmcnt(0)" ::: "memory");
        }
    }
    __syncthreads();
}
constexpr size_t MiB = 1u << 20;
constexpr size_t WS_CTL = 0, CTL_ZERO_BYTES = 1 * MiB;
constexpr size_t WS_MOD = 1 * MiB;
constexpr size_t WS_ROPE = 2 * MiB;
constexpr size_t WS_WSP = 4 * MiB;
constexpr size_t WS_HC = 5 * MiB;
constexpr size_t WS_RST = 13 * MiB;
constexpr size_t WS_W = 16 * MiB;
constexpr size_t W_IN = 0, W_BR = W_IN + (size_t)IN_DIM * DM * 2, W_O = W_BR + (size_t)3 * DM * 2048 * 2, W_GU = W_O + (size_t)DM * DM * 2, W_D = W_GU + (size_t)2 * FF * DM * 2,
                 W_LAYER = W_D + (size_t)DM * FF * 2;
constexpr size_t WS_Z = WS_W + 2 * W_LAYER;
constexpr size_t WS_ACT = WS_Z + (size_t)MT * IN_DIM * 2;
constexpr size_t WS_XB = WS_ACT + (size_t)MT * DM * 2;
constexpr size_t WS_O12 = WS_XB + (size_t)3 * MT * 2048 * 2;
constexpr size_t WS_QK = WS_O12 + (size_t)MT * DM * 4;
constexpr size_t WS_OS = WS_QK + (size_t)MT * DM * 2;
constexpr int MAX_GRID = 320;
constexpr size_t WS_KVF = WS_OS + (size_t)MAX_GRID * 256 * 128 * 4;
constexpr size_t WS_SLAB = WS_KVF + (size_t)8 * MC * 4096 * 4;
constexpr size_t WS_END = WS_SLAB + (size_t)8 * MC * DM * 4;
static_assert(W_LAYER % 256 == 0 && WS_Z % 256 == 0 && WS_ACT % 256 == 0 && WS_XB % 256 == 0 && WS_O12 % 256 == 0 && WS_QK % 256 == 0 && WS_OS % 256 == 0, "alignment");
constexpr int CW_BAR = 4096;

constexpr int NWAVES = 8;
constexpr int RING_BYTES = 131072, MISC_OFF = RING_BYTES + 320, LDS_BYTES = 147456;
static_assert(true, "");
constexpr int PPL = 9, N_PHASES = 1 + PPL * DEPTH;

__device__ __forceinline__ float sx(float v, int k, int lane) { return __uint_as_float((unsigned)__builtin_amdgcn_ds_bpermute((lane ^ k) << 2, (int)__float_as_uint(v))); }
__device__ __forceinline__ float wave_sum(float v, int lane) {
#pragma unroll
    for (int o = 1; o < 64; o <<= 1) v += sx(v, o, lane);
    return v;
}
__device__ __forceinline__ unsigned pkbf(float lo, float hi) { unsigned r; asm volatile("v_cvt_pk_bf16_f32 %0, %1, %2" : "=v"(r) : "v"(lo), "v"(hi)); return r; }
__device__ __forceinline__ float blo(unsigned w) { return __uint_as_float(w << 16); }
__device__ __forceinline__ float bhi(unsigned w) { return __uint_as_float(w & 0xffff0000u); }
__device__ __forceinline__ void unpack8(const v4u w, float (&x)[8]) { x[0] = blo(w.x); x[1] = bhi(w.x); x[2] = blo(w.y); x[3] = bhi(w.y); x[4] = blo(w.z); x[5] = bhi(w.z); x[6] = blo(w.w); x[7] = bhi(w.w); }
__device__ __forceinline__ v4u pack8(const float (&x)[8]) { v4u w; w.x = pkbf(x[0], x[1]); w.y = pkbf(x[2], x[3]); w.z = pkbf(x[4], x[5]); w.w = pkbf(x[6], x[7]); return w; }

struct Args { const float* in[25]; float* out; unsigned char* ws; int ph_lo, ph_hi, bar_region, pad; };
struct Ctx {
    LAS unsigned char* lds; int tid, lane, wave, vcu, G;
    float* out; unsigned char* ws; int bx;
};
__device__ __forceinline__ Ctx launder(const Ctx& F) {
    Ctx P = F; int t = F.tid; asm volatile("" : "+v"(t)); P.tid = t; P.lane = t & 63; P.wave = __builtin_amdgcn_readfirstlane(t >> 6);
    asm volatile("" : "+s"(P.vcu), "+s"(P.G), "+s"(P.bx)); unsigned long long z = 0; asm volatile("" : "+s"(z)); P.ws = F.ws + z; P.out = F.out + z;
    return P;
}


__device__ __forceinline__ void transpose_item(const float* W, int K, int N, bf16* WT, int k0, int n0, int drow0, LAS float* scr, int lane) {
    float tv[32];
#pragma unroll
    for (int i = 0; i < 32; ++i) { const int kk = 2 * i + (lane >> 5); tv[i] = W[(size_t)(k0 + kk) * N + n0 + (lane & 31)]; }
#pragma unroll
    for (int i = 0; i < 32; ++i) { const int kk = 2 * i + (lane >> 5); scr[kk * 33 + (lane & 31)] = tv[i]; }
    LDS_WAIT(); asm volatile("" ::: "memory");
    const int c = lane & 7;
#pragma unroll
    for (int j = 0; j < 4; ++j) { const int n = (lane >> 3) + 8 * j; const LAS float* s = scr + (8 * c) * 33 + n;
        v4u o; o.x = pkbf(s[0 * 33], s[1 * 33]); o.y = pkbf(s[2 * 33], s[3 * 33]); o.z = pkbf(s[4 * 33], s[5 * 33]); o.w = pkbf(s[6 * 33], s[7 * 33]);
        *(GAS v4u*)(WT + (size_t)(drow0 + n) * K + k0 + 8 * c) = o; }
    LDS_WAIT(); asm volatile("" ::: "memory");
}
template <int MODE> __device__ __forceinline__ void transpose_mat(const float* W, int K, int N, bf16* WT, LAS float* scr, int item, int lane) {
    const int nblk = N / 32, kb = item / nblk, nb = item % nblk, n0 = 32 * nb;
    const int drow0 = MODE == 0 ? n0 : ((n0 >> 7) * 256 + (n0 & 127) + (MODE == 2 ? 128 : 0));
    transpose_item(W, K, N, WT, 64 * kb, n0, drow0, scr, lane);
}

__device__ __forceinline__ void sincos_f(float a, float& s, float& c) {
    const double ad = (double)a; const double kq = __builtin_rint(ad * 0.63661977236758134308); const double r = ad - kq * 1.57079632679489661923; const double r2 = r * r;
    const double sp = r * (1.0 + r2 * (-1.0 / 6 + r2 * (1.0 / 120 + r2 * (-1.0 / 5040 + r2 * (1.0 / 362880 + r2 * (-1.0 / 39916800))))));
    const double cp = 1.0 + r2 * (-0.5 + r2 * (1.0 / 24 + r2 * (-1.0 / 720 + r2 * (1.0 / 40320 + r2 * (-1.0 / 3628800 + r2 * (1.0 / 479001600))))));
    const int q = ((int)kq) & 3;
    const double ss = (q == 0) ? sp : (q == 1) ? cp : (q == 2) ? -sp : -cp;
    const double cc = (q == 0) ? cp : (q == 1) ? -sp : (q == 2) ? -cp : sp;
    s = (float)ss; c = (float)cc;
}

__device__ __forceinline__ void p0_prologue(const Args& A, const Ctx& F) {
    const float* c = A.in[1]; const float* c_ctx = A.in[3]; const float* ada_w = A.in[4]; const float* ada_b = A.in[5];
    const float* norm_mix_g = A.in[6]; const float* norm_ffn_g = A.in[7];
    float* MOD = (float*)(F.ws + WS_MOD);
    LAS float* sv = (LAS float*)F.lds; LAS float* red = (LAS float*)(F.lds + 49152);
    for (int i = F.tid; i < 3 * DM; i += NWAVES * 64) { const int v = i >> 12, k = i & (DM - 1); const float x = v < 2 ? c[v * DM + k] : c_ctx[k]; sv[i] = x / (1.f + __expf(-x)); }
    __syncthreads();
    for (int ch = F.vcu; ch < 256; ch += F.G) {
        const int gcol = ch * 192, l = gcol / NMOD, j0 = gcol % NMOD;
        f32x4 a0 = {0.f, 0.f, 0.f, 0.f}, a1 = a0, a2 = a0;
        if (F.lane < 48) {
            const float* wp = ada_w + (size_t)l * DM * NMOD + (size_t)(F.wave * 512) * NMOD + j0 + F.lane * 4;
            const LAS float* s0 = sv + F.wave * 512;
#pragma unroll 8
            for (int k = 0; k < 512; ++k) { const f32x4 w = *(const f32x4*)(wp + (size_t)k * NMOD); a0 += w * s0[k]; a1 += w * s0[DM + k]; a2 += w * s0[2 * DM + k]; }
            *(LAS f32x4*)(red + (F.wave * 3 + 0) * 192 + F.lane * 4) = a0; *(LAS f32x4*)(red + (F.wave * 3 + 1) * 192 + F.lane * 4) = a1; *(LAS f32x4*)(red + (F.wave * 3 + 2) * 192 + F.lane * 4) = a2;
        }
        __syncthreads();
        for (int o = F.tid; o < 3 * 192; o += NWAVES * 64) { const int v = o / 192, jj = o % 192; float s = 0.f;
#pragma unroll
            for (int w = 0; w < 8; ++w) s += red[(w * 3 + v) * 192 + jj];
            const int j = j0 + jj, q = j >> 12, col = j & (DM - 1); float val = s + ada_b[l * NMOD + j];
            if (q == 1) val = norm_mix_g[l * DM + col] * (1.f + val); else if (q == 4) val = norm_ffn_g[l * DM + col] * (1.f + val);
            MOD[(size_t)(l * 3 + v) * NMOD + j] = val; }
        __syncthreads();
    }
    const int gtid = F.vcu * (NWAVES * 64) + F.tid, NTH = F.G * NWAVES * 64;
    { float* ROPE = (float*)(F.ws + WS_ROPE);
      for (int e = gtid; e < SEQ * 32; e += NTH) { const int t = e >> 5, j = e & 31; const int pos = j < 16 ? (t >> 6) : (t & 63);
          const float inv = exp2f(-(float)(j & 15) * (13.287712379549449f / 16.f)); float s, cs; sincos_f((float)pos * inv, s, cs); ROPE[2 * e] = cs; ROPE[2 * e + 1] = s; } }
    { const float* wsp = A.in[18]; bf16* o = (bf16*)(F.ws + WS_WSP);
      for (int e = gtid; e < DEPTH * 16 * 128 * 128 / 2; e += NTH) ((unsigned*)o)[e] = pkbf(wsp[2 * e], wsp[2 * e + 1]); }
    LAS float* scr = (LAS float*)(F.lds + F.wave * 16384);
    const int gw = F.vcu * NWAVES + F.wave, NGW = F.G * NWAVES;
    constexpr int I_IN = (DM / 64) * (IN_DIM / 32), I_BR = (2048 / 64) * (DM / 32), I_O = (DM / 64) * (DM / 32), I_GU = (DM / 64) * (FF / 32), I_D = (FF / 64) * (DM / 32);
    constexpr int I_LAYER = I_IN + 3 * I_BR + I_O + 2 * I_GU + I_D;
    for (int it = gw; it < DEPTH * I_LAYER; it += NGW) {
        const int l = it / I_LAYER; int r = it - l * I_LAYER; unsigned char* wl = F.ws + WS_W + (size_t)l * W_LAYER;
        if (r < I_IN) { transpose_mat<0>(A.in[8] + (size_t)l * DM * IN_DIM, DM, IN_DIM, (bf16*)(wl + W_IN), scr, r, F.lane); continue; } r -= I_IN;
        if (r < I_BR) { transpose_mat<0>(A.in[11] + (size_t)l * 2048 * DM, 2048, DM, (bf16*)(wl + W_BR), scr, r, F.lane); continue; } r -= I_BR;
        if (r < I_BR) { transpose_mat<0>(A.in[16] + (size_t)l * 2048 * DM, 2048, DM, (bf16*)(wl + W_BR) + (size_t)DM * 2048, scr, r, F.lane); continue; } r -= I_BR;
        if (r < I_BR) { transpose_mat<0>(A.in[20] + (size_t)l * 2048 * DM, 2048, DM, (bf16*)(wl + W_BR) + (size_t)2 * DM * 2048, scr, r, F.lane); continue; } r -= I_BR;
        if (r < I_O) { transpose_mat<0>(A.in[21] + (size_t)l * DM * DM, DM, DM, (bf16*)(wl + W_O), scr, r, F.lane); continue; } r -= I_O;
        if (r < I_GU) { transpose_mat<1>(A.in[22] + (size_t)l * DM * FF, DM, FF, (bf16*)(wl + W_GU), scr, r, F.lane); continue; } r -= I_GU;
        if (r < I_GU) { transpose_mat<2>(A.in[23] + (size_t)l * DM * FF, DM, FF, (bf16*)(wl + W_GU), scr, r, F.lane); continue; } r -= I_GU;
        transpose_mat<0>(A.in[24] + (size_t)l * FF * DM, FF, DM, (bf16*)(wl + W_D), scr, r, F.lane);
    }
}

__device__ __forceinline__ void norm_phase(const Ctx& F, int l, int which, const float* src_lat, const float* src_ctx, int nrows, bool slab_add, bool write_hc) {
    const float* MOD = (const float*)(F.ws + WS_MOD); bf16* XN = (bf16*)(F.ws + WS_ACT);
    const int gw = F.vcu * NWAVES + F.wave, NGW = F.G * NWAVES;
    for (int m = gw; m < nrows; m += NGW) {
        const float* xr = m < ML ? src_lat + (size_t)m * DM : src_ctx + (size_t)(m - ML) * DM;
        const int cls = m < SEQ ? 0 : (m < ML ? 1 : 2);
        const float* sh = MOD + (size_t)(l * 3 + cls) * NMOD + (which ? 3 : 0) * DM; const float* gs = sh + DM;
        f32x4 v[16], gg[16], sg[16]; float ss = 0.f;
#pragma unroll
        for (int j = 0; j < 16; ++j) v[j] = *(const f32x4*)(xr + 4 * F.lane + 256 * j);

        if (slab_add && m >= ML) {
            const float* sl = (const float*)(F.ws + WS_SLAB) + (size_t)(m - ML) * DM + 4 * F.lane;
#pragma clang loop unroll(disable)
            for (int s = 0; s < 8; s += 2) {
                f32x4 ta[16], tb[16];
#pragma unroll
                for (int j = 0; j < 16; ++j) { ta[j] = *(const f32x4*)(sl + (size_t)s * MC * DM + 256 * j); tb[j] = *(const f32x4*)(sl + (size_t)(s + 1) * MC * DM + 256 * j); }
                __builtin_amdgcn_sched_barrier(0);
#pragma unroll
                for (int j = 0; j < 16; ++j) v[j] += ta[j] + tb[j];
                __builtin_amdgcn_sched_barrier(0);
            }
            if (write_hc) { float* hc = (float*)(F.ws + WS_HC) + (size_t)(m - ML) * DM + 4 * F.lane;
#pragma unroll
                for (int j = 0; j < 16; ++j) *(f32x4*)(hc + 256 * j) = v[j]; }
        }
#pragma unroll
        for (int j = 0; j < 16; ++j) { gg[j] = *(const f32x4*)(gs + 4 * F.lane + 256 * j); sg[j] = *(const f32x4*)(sh + 4 * F.lane + 256 * j); }
#pragma unroll
        for (int j = 0; j < 16; ++j) ss += (v[j].x * v[j].x + v[j].y * v[j].y) + (v[j].z * v[j].z + v[j].w * v[j].w);
        const float rstd = __builtin_amdgcn_rsqf(wave_sum(ss, F.lane) * (1.f / DM) + EPS);
        unsigned long long* o8 = (unsigned long long*)(XN + (size_t)m * DM) + F.lane;
#pragma unroll
        for (int j = 0; j < 16; ++j) { const f32x4 g = gg[j], s = sg[j];
            const f32x4 y = v[j] * rstd * g + s;
            o8[64 * j] = (unsigned long long)pkbf(y.x, y.y) | ((unsigned long long)pkbf(y.z, y.w) << 32); }
    }
}

__device__ __forceinline__ void qk_phase(const Args& A, const Ctx& F, int l, int nrows_stat, bool kvf_ctx) {
    typedef unsigned u32x2 __attribute__((ext_vector_type(2)));
    const bf16* Z = (const bf16*)(F.ws + WS_Z); bf16* QK = (bf16*)(F.ws + WS_QK); const float* ROPE = (const float*)(F.ws + WS_ROPE); float* RST = (float*)(F.ws + WS_RST);
    const float* KVF = (const float*)(F.ws + WS_KVF); bf16* Zw = (bf16*)(F.ws + WS_Z);
    const int gw = F.vcu * NWAVES + F.wave, NGW = F.G * NWAVES, p = F.lane & 7, go = (F.lane >> 3) * 64 + 4 * p;
    constexpr float QC = 0.125f * 1.4426950408889634f;
    const f32x4 gq0 = *(const f32x4*)(A.in[12] + l * 64 + 4 * p) * QC, gq1 = *(const f32x4*)(A.in[12] + l * 64 + 32 + 4 * p) * QC;
    const f32x4 gk0 = *(const f32x4*)(A.in[13] + l * 64 + 4 * p), gk1 = *(const f32x4*)(A.in[13] + l * 64 + 32 + 4 * p);
    for (int m = gw; m < MT; m += NGW) {
        const bf16* zr = Z + (size_t)m * IN_DIM + ZC_Q + go; bf16* qr = QK + (size_t)m * DM + go; const bool lat = m < ML; const int t = m & (SEQ - 1);
        f32x4 cs = {1.f, 1.f, 1.f, 1.f}, sn = {0.f, 0.f, 0.f, 0.f};
        if (lat) { const float* rp = ROPE + ((size_t)t * 32 + 4 * p) * 2; const f32x4 w0 = *(const f32x4*)rp, w1 = *(const f32x4*)(rp + 4); cs = (f32x4){w0.x, w0.z, w1.x, w1.z}; sn = (f32x4){w0.y, w0.w, w1.y, w1.w}; }
        if (m < nrows_stat) {
            const bf16* vr = Z + (size_t)m * IN_DIM + ZC_VM; float ss = 0.f;
#pragma unroll
            for (int i = 0; i < 4; ++i) { float x[8]; unpack8(*(const v4u*)(vr + i * 512 + F.lane * 8), x);
#pragma unroll
                for (int e = 0; e < 8; ++e) ss += x[e] * x[e]; }
            ss = wave_sum(ss, F.lane); if (F.lane == 0) RST[m] = __builtin_amdgcn_rsqf(ss * (1.f / 2048.f) + EPS); }
        const bool fromf = kvf_ctx && !lat;
        if (fromf) {
            const float* vr = KVF + (size_t)(m - ML) * 4096 + 2048; bf16* vo = Zw + (size_t)m * IN_DIM + ZC_V;
#pragma unroll
            for (int i = 0; i < 4; ++i) { f32x4 ta[8], tb[8];
#pragma unroll
                for (int s = 0; s < 8; ++s) { ta[s] = *(const f32x4*)(vr + (size_t)s * MC * 4096 + i * 512 + F.lane * 8); tb[s] = *(const f32x4*)(vr + (size_t)s * MC * 4096 + i * 512 + F.lane * 8 + 4); }
                __builtin_amdgcn_sched_barrier(0);
                const f32x4 a = ((ta[0] + ta[1]) + (ta[2] + ta[3])) + ((ta[4] + ta[5]) + (ta[6] + ta[7])), b = ((tb[0] + tb[1]) + (tb[2] + tb[3])) + ((tb[4] + tb[5]) + (tb[6] + tb[7]));
                v4u w; w.x = pkbf(a.x, a.y); w.y = pkbf(a.z, a.w); w.z = pkbf(b.x, b.y); w.w = pkbf(b.z, b.w); *(v4u*)(vo + i * 512 + F.lane * 8) = w; }
        }
        u32x2 wa[8], wb[8];
        if (!fromf) {
#pragma unroll
            for (int i = 0; i < 8; ++i) { wa[i] = *(const u32x2*)(zr + i * 512); wb[i] = *(const u32x2*)(zr + i * 512 + 32); }
        }
        __builtin_amdgcn_sched_barrier(0);
#pragma unroll
        for (int i = 0; i < 8; ++i) {
            f32x4 x1, x2;
            if (fromf) { if (i < 4) continue; const float* kr = KVF + (size_t)(m - ML) * 4096 + (i - 4) * 512 + go; f32x4 ta[8], tb[8];
#pragma unroll
                for (int s = 0; s < 8; ++s) { ta[s] = *(const f32x4*)(kr + (size_t)s * MC * 4096); tb[s] = *(const f32x4*)(kr + (size_t)s * MC * 4096 + 32); }
                __builtin_amdgcn_sched_barrier(0);
                x1 = ((ta[0] + ta[1]) + (ta[2] + ta[3])) + ((ta[4] + ta[5]) + (ta[6] + ta[7])); x2 = ((tb[0] + tb[1]) + (tb[2] + tb[3])) + ((tb[4] + tb[5]) + (tb[6] + tb[7])); }
            else { const u32x2 w0 = wa[i], w1 = wb[i];
                x1 = (f32x4){blo(w0.x), bhi(w0.x), blo(w0.y), bhi(w0.y)}; x2 = (f32x4){blo(w1.x), bhi(w1.x), blo(w1.y), bhi(w1.y)}; }
            float ss = (x1.x * x1.x + x1.y * x1.y) + (x1.z * x1.z + x1.w * x1.w) + (x2.x * x2.x + x2.y * x2.y) + (x2.z * x2.z + x2.w * x2.w);
            ss += sx(ss, 1, F.lane); ss += sx(ss, 2, F.lane); ss += sx(ss, 4, F.lane);
            const float r = __builtin_amdgcn_rsqf(ss * (1.f / 64.f) + EPS);
            x1 = x1 * r * (i < 4 ? gq0 : gk0); x2 = x2 * r * (i < 4 ? gq1 : gk1);
            const f32x4 y1 = x1 * cs - x2 * sn, y2 = x2 * cs + x1 * sn;
            u32x2 o0, o1; o0.x = pkbf(y1.x, y1.y); o0.y = pkbf(y1.z, y1.w); o1.x = pkbf(y2.x, y2.y); o1.y = pkbf(y2.z, y2.w);
            *(u32x2*)(qr + i * 512) = o0; *(u32x2*)(qr + i * 512 + 32) = o1;
        }
    }
}

__device__ __forceinline__ void conv_phase(const Args& A, const Ctx& F, int l, int nrows) {
    const bf16* Z = (const bf16*)(F.ws + WS_Z); bf16* CV = (bf16*)(F.ws + WS_XB);
    const float* cw = A.in[9] + (size_t)l * 3 * 2048; const float* cb = A.in[10] + (size_t)l * 2048;
    const int gtid = F.vcu * (NWAVES * 64) + F.tid, NTH = F.G * NWAVES * 64;
    for (int it = gtid; it < (nrows / 2) * 256; it += NTH) {
        const int m = 2 * (it >> 8), c = (it & 255) * 8;
        const int t = m < ML ? (m & (SEQ - 1)) : ((m - ML) & (CTXL - 1)), T = m < ML ? SEQ : CTXL;
        const bf16* zr = Z + (size_t)m * IN_DIM + c;
        const bool hp = t > 0, hn = t + 2 < T;
        const v4u zero = {0u, 0u, 0u, 0u};
        const v4u bgA = *(const v4u*)(zr + ZC_BG), bgB = *(const v4u*)(zr + IN_DIM + ZC_BG);
        const v4u c0 = *(const v4u*)(zr + ZC_CG), x0 = *(const v4u*)(zr + ZC_XIN), c1 = *(const v4u*)(zr + IN_DIM + ZC_CG), x1 = *(const v4u*)(zr + IN_DIM + ZC_XIN);
        const v4u cp = hp ? *(const v4u*)(zr - IN_DIM + ZC_CG) : zero, xp = hp ? *(const v4u*)(zr - IN_DIM + ZC_XIN) : zero;
        const v4u cn = hn ? *(const v4u*)(zr + 2 * IN_DIM + ZC_CG) : zero, xn = hn ? *(const v4u*)(zr + 2 * IN_DIM + ZC_XIN) : zero;
        const f32x4 w00 = *(const f32x4*)(cw + c), w01 = *(const f32x4*)(cw + c + 4), w10 = *(const f32x4*)(cw + 2048 + c), w11 = *(const f32x4*)(cw + 2048 + c + 4);
        const f32x4 w20 = *(const f32x4*)(cw + 4096 + c), w21 = *(const f32x4*)(cw + 4096 + c + 4), b0 = *(const f32x4*)(cb + c), b1 = *(const f32x4*)(cb + c + 4);
        float a[8], b[8], zp[8], z0[8], z1[8], zn[8], gA[8], gB[8];
        unpack8(cp, a); unpack8(xp, b);
#pragma unroll
        for (int e = 0; e < 8; ++e) zp[e] = a[e] * b[e];
        unpack8(c0, a); unpack8(x0, b);
#pragma unroll
        for (int e = 0; e < 8; ++e) z0[e] = a[e] * b[e];
        unpack8(c1, a); unpack8(x1, b);
#pragma unroll
        for (int e = 0; e < 8; ++e) z1[e] = a[e] * b[e];
        unpack8(cn, a); unpack8(xn, b);
#pragma unroll
        for (int e = 0; e < 8; ++e) zn[e] = a[e] * b[e];
        unpack8(bgA, gA); unpack8(bgB, gB);
        float yA[8], yB[8];
#pragma unroll
        for (int e = 0; e < 4; ++e) {
            yA[e] = gA[e] * (zp[e] * w00[e] + z0[e] * w10[e] + z1[e] * w20[e] + b0[e]); yA[4 + e] = gA[4 + e] * (zp[4 + e] * w01[e] + z0[4 + e] * w11[e] + z1[4 + e] * w21[e] + b1[e]);
            yB[e] = gB[e] * (z0[e] * w00[e] + z1[e] * w10[e] + zn[e] * w20[e] + b0[e]); yB[4 + e] = gB[4 + e] * (z0[4 + e] * w01[e] + z1[4 + e] * w11[e] + zn[4 + e] * w21[e] + b1[e]); }
        *(v4u*)(CV + (size_t)m * 2048 + c) = pack8(yA); *(v4u*)(CV + (size_t)(m + 1) * 2048 + c) = pack8(yB);
    }
}

__device__ __forceinline__ void mlp_unit(const Args& A, const Ctx& F, int l, int chunk, int g) {
    const bf16* Z = (const bf16*)(F.ws + WS_Z); bf16* MO = (bf16*)(F.ws + WS_XB) + (size_t)2 * MT * 2048; const float* RST = (const float*)(F.ws + WS_RST);
    const bf16* WSP = (const bf16*)(F.ws + WS_WSP) + ((size_t)l * 16 + g) * 128 * 128;
    const float* gnorm = A.in[17] + (size_t)l * 2048 + g * 128; const float* bsp = A.in[19] + ((size_t)l * 16 + g) * 128;
    LAS unsigned char* Vl = F.lds;
    const int r32 = F.lane & 31, hi = F.lane >> 5, rb = F.wave & 3, ch = F.wave >> 2, sr = F.tid >> 4, sc = (F.tid & 15) * 8, row0 = chunk * 128;
    att::bf16x8 pa[2][4];
#pragma unroll
    for (int kt = 0; kt < 2; ++kt)
#pragma unroll
        for (int s = 0; s < 4; ++s) pa[kt][s] = *(const att::bf16x8*)(WSP + (size_t)(32 * rb + r32) * 128 + 64 * kt + 16 * s + 8 * hi);
    const f32x4 gn0 = *(const f32x4*)(gnorm + sc), gn1 = *(const f32x4*)(gnorm + sc + 4);
#pragma unroll
    for (int i = 0; i < 4; ++i) { const int q = sr + 32 * i; float x[8]; unpack8(*(const v4u*)(Z + (size_t)(row0 + q) * IN_DIM + ZC_VM + g * 128 + sc), x);
        const float r = RST[row0 + q];
#pragma unroll
        for (int e = 0; e < 4; ++e) { x[e] = x[e] * r * gn0[e]; x[4 + e] = x[4 + e] * r * gn1[e]; }
        *(LAS v4u*)(Vl + (q >> 6) * 16384 + att::v_st(q & 63, sc)) = pack8(x); }
    __syncthreads();
    att::f32x16 acc0 = {}, acc1 = {};
#pragma unroll
    for (int kt = 0; kt < 2; ++kt) { const int vb = (int)(uintptr_t)Vl + kt * 16384 + ch * 1024 + att::v_rd_base(F.lane);
        att::pv_one<0>(acc0, vb, pa[kt][0], pa[kt][1], pa[kt][2], pa[kt][3]); att::pv_one<1>(acc1, vb, pa[kt][0], pa[kt][1], pa[kt][2], pa[kt][3]); }
    float bias[16]; bf16 u0[16], u1[16];
    const int col = g * 128 + ch * 64 + r32;
#pragma unroll
    for (int r = 0; r < 16; ++r) { const int pr = 32 * rb + att::crow(r, hi); const size_t row = (size_t)(row0 + pr);
        bias[r] = bsp[pr]; u0[r] = Z[row * IN_DIM + ZC_U + col]; u1[r] = Z[row * IN_DIM + ZC_U + col + 32]; }
    __builtin_amdgcn_sched_barrier(0);
#pragma unroll
    for (int r = 0; r < 16; ++r) { const int pr = 32 * rb + att::crow(r, hi); const size_t row = (size_t)(row0 + pr);
        const float a0 = __uint_as_float((unsigned)u0[r] << 16), a1 = __uint_as_float((unsigned)u1[r] << 16);
        MO[row * 2048 + col] = (bf16)(pkbf(a0 * (acc0[r] + bias[r]), 0.f) & 0xffffu); MO[row * 2048 + col + 32] = (bf16)(pkbf(a1 * (acc1[r] + bias[r]), 0.f) & 0xffffu); }
    __syncthreads();
}

__device__ __forceinline__ void attn_phase(const Args& A, const Ctx& F, int l, bool with_ctx, float lam_init) {
    static_assert(att::SHM_ATTN <= RING_BYTES, "attention LDS vs frame");
    const int nchunk = (with_ctx ? MT : ML) / 128;
    for (int u = F.vcu; u < nchunk * 16; u += F.G) mlp_unit(A, F, l, u >> 4, u & 15);
    const bf16* Z = (const bf16*)(F.ws + WS_Z); const bf16* QK = (const bf16*)(F.ws + WS_QK); bf16* AO = (bf16*)(F.ws + WS_XB) + (size_t)MT * 2048;
    float* OS = (float*)(F.ws + WS_OS) + (size_t)F.vcu * 256 * 128;
    const float* lq = A.in[14] + (size_t)l * 256;
    const float s01 = wave_sum(lq[F.lane] * lq[64 + F.lane], F.lane), s23 = wave_sum(lq[128 + F.lane] * lq[192 + F.lane], F.lane);
    const float lam = __uint_as_float(__builtin_amdgcn_readfirstlane(__float_as_uint(expf(s01) - expf(s23) + lam_init))), osc = 1.f - lam_init;
    const float* subg = A.in[15] + (size_t)l * 128;
    float gqm = fabsf(A.in[12][l * 64 + F.lane]), gkm = fabsf(A.in[13][l * 64 + F.lane]);
#pragma unroll
    for (int o = 1; o < 64; o <<= 1) { gqm = fmaxf(gqm, sx(gqm, o, F.lane)); gkm = fmaxf(gkm, sx(gkm, o, F.lane)); }
    const float m0c = __uint_as_float(__builtin_amdgcn_readfirstlane(__float_as_uint(0.125f * 64.f * 1.02f * gqm * gkm * 1.4426950408889634f)));
    const int npair = 1024 + (with_ctx ? 32 : 0);
    for (int u = F.vcu; u < npair; u += F.G) {
        const bool isl = u < 1024; const int bh = isl ? (u >> 5) : (u - 1024), b = bh >> 4, h = bh & 15;
        const int qrow = isl ? b * SEQ + (u & 31) * 256 : ML + b * CTXL;
        const int rowa = isl ? b * SEQ : qrow, nt0 = isl ? SEQ / 64 : CTXL / 64, rowb = ML + b * CTXL, NT = isl ? SEQ / 64 + CTXL / 64 : CTXL / 64;
#pragma clang loop unroll(disable)
        for (int mp = 0; mp < 2; ++mp)
            att::attn_unit(mp, QK + (size_t)qrow * DM + h * 128 + mp * 64, QK + 2048 + h * 128 + mp * 64, Z + ZC_V + h * 128, OS, AO + (size_t)qrow * 2048 + h * 128, subg, lam, osc, m0c,
                           rowa, nt0, rowb, NT, (char*)F.lds, F.tid);
    }
}

__global__ void __launch_bounds__(NWAVES * 64, 2) fwd_kernel(Args args) {
    extern __shared__ __attribute__((aligned(16))) unsigned char lds[];
    Ctx F;
    F.lds = (LAS unsigned char*)lds; F.tid = threadIdx.x; F.lane = F.tid & 63; F.wave = __builtin_amdgcn_readfirstlane(F.tid >> 6);
    F.G = gridDim.x; F.bx = blockIdx.x; { const int bx = blockIdx.x; F.vcu = (F.G % 8 == 0) ? (bx % 8) * (F.G / 8) + bx / 8 : bx; }
    F.out = args.out; F.ws = args.ws;
    volatile LAS unsigned* MISC = (volatile LAS unsigned*)(F.lds + MISC_OFF);
    for (int u = F.tid; u < (LDS_BYTES - RING_BYTES) / 4; u += NWAVES * 64) ((LAS unsigned*)(F.lds + RING_BYTES))[u] = 0u;
    __syncthreads();
    const int lo = args.ph_lo, hi = args.ph_hi;
    unsigned* barw = (unsigned*)(F.ws + WS_CTL) + CW_BAR + args.bar_region * XCD_BAR_WORDS;
    XcdBarrier bar; bar.bar = barw; bar.x = 0; bar.st = nullptr;
    if (hi - lo > 1) bar = xcd_barrier_post(barw, MISC + 8);
#ifndef PHM
#define PHM 0xfff
#endif
#define IN(k) (lo <= (k) && (k) < hi)
#ifndef PROBE_BASE
#define PROBE_BASE 0
#endif
#ifdef PROBE_PHASE
#define PT0(k) do { if ((k) == PROBE_PHASE) { pc0 = __builtin_readcyclecounter(); pt0 = __builtin_amdgcn_s_memrealtime(); } } while (0)
#define PT1(k) do { if ((k) == PROBE_PHASE) { pc1 = __builtin_readcyclecounter(); pt1 = __builtin_amdgcn_s_memrealtime(); } } while (0)
#else
#define PT0(k) do {} while (0)
#define PT1(k) do {} while (0)
#endif
#if defined(CLOCK_PROBE) && CLOCK_PROBE == 9
#define SEAM(k) do { if (IN(k) && IN((k) + 1)) { const unsigned long long ta_ = __builtin_amdgcn_s_memrealtime(); xcd_barrier(bar); pwait += __builtin_amdgcn_s_memrealtime() - ta_; } } while (0)
#else
#define SEAM(k) do { if (IN(k) && IN((k) + 1)) xcd_barrier(bar); } while (0)
#endif

#if defined(CLOCK_PROBE) || defined(PROBE_PHASE)
    unsigned long long pc0 = 0, pc1 = 0, pt0 = 0, pt1 = 1, pwait = 0; (void)pwait; (void)pc0; (void)pc1;
#endif
    if ((PHM & 1) && IN(0)) { PT0(0); const Ctx P = launder(F); p0_prologue(args, P); PT1(0); SEAM(0); }

    for (int l = 0; l < DEPTH; ++l) {
        const int pb = 1 + PPL * l; const bool last = l + 1 == DEPTH; const int MR = last ? ML : MT;
#define PTRS() bf16* Zb = (bf16*)(P.ws + WS_Z); bf16* ACT = (bf16*)(P.ws + WS_ACT); bf16* XB = (bf16*)(P.ws + WS_XB); float* YF = (float*)(P.ws + WS_O12); float* HC = (float*)(P.ws + WS_HC); \
        bf16* HID = (bf16*)(P.ws + WS_Z); const unsigned char* wl = P.ws + WS_W + (size_t)l * W_LAYER; const float* MODl = (const float*)(P.ws + WS_MOD) + (size_t)l * 3 * NMOD; \
        const float* h_lat = l == 0 ? args.in[0] : P.out; const float* h_ctx = l == 0 ? args.in[2] : HC; \
        (void)Zb; (void)ACT; (void)XB; (void)YF; (void)HC; (void)HID; (void)wl; (void)MODl; (void)h_lat; (void)h_ctx;
        if ((PHM & 2) && IN(pb + 0)) { PT0(pb + 0); const Ctx P = launder(F); PTRS(); norm_phase(P, l, 0, h_lat, h_ctx, MT, l > 0, false); PT1(pb + 0); SEAM(pb + 0); }
        if ((PHM & 4) && IN(pb + 1)) { PT0(pb + 1); const Ctx P = launder(F); PTRS();
            pg8::Gemm g{ACT, (const bf16*)(wl + W_IN), MT, IN_DIM, DM}; pg8::InOrder S; S.init(P.G, P.bx, last);
            pg8::EpiZ E{Zb, (float*)(P.ws + WS_KVF)};
            pg8::gemm_phase<pg8::EpiZ, pg8::InOrder, true, true>(P.lds, P.tid, g, S, E);
            PT1(pb + 1); SEAM(pb + 1);
        }
        if ((PHM & 8) && IN(pb + 2)) { PT0(pb + 2); { const Ctx P = launder(F); qk_phase(args, P, l, MR, last); } { const Ctx P = launder(F); conv_phase(args, P, l, MR); } PT1(pb + 2); SEAM(pb + 2); }
        if ((PHM & 16) && IN(pb + 3)) { PT0(pb + 3); const Ctx P = launder(F); attn_phase(args, P, l, !last, l == 0 ? 0.2f : 0.35550906759096924f); PT1(pb + 3); SEAM(pb + 3); }
        if ((PHM & 64) && IN(pb + 4)) { PT0(pb + 4); const Ctx P = launder(F); PTRS();
            pg8::Gemm g{XB, (const bf16*)(wl + W_BR), 3 * MT, 3 * DM, 2048}; pg8::BranchOrder S{P.G, P.bx, MR / 256};
            pg8::EpiBr E{Zb, ACT};
            pg8::gemm_phase<pg8::EpiBr, pg8::BranchOrder, true, true>(P.lds, P.tid, g, S, E);
            PT1(pb + 4); SEAM(pb + 4);
        }
        if ((PHM & 128) && IN(pb + 5)) { PT0(pb + 5); const Ctx P = launder(F); PTRS();
            pg8::Gemm g{ACT, (const bf16*)(wl + W_O), MR, DM, DM}; pg8::ResOrder S; S.init(P.G, P.bx, DM, !last);
            pg8::EpiRes E{h_lat, h_ctx, P.out, HC, MODl + 2 * DM, (float*)(P.ws + WS_SLAB)};
            pg8::gemm_phase<pg8::EpiRes, pg8::ResOrder, true, true>(P.lds, P.tid, g, S, E);
            PT1(pb + 5); SEAM(pb + 5);
        }
        if ((PHM & 256) && IN(pb + 6)) { PT0(pb + 6); const Ctx P = launder(F); PTRS(); norm_phase(P, l, 1, P.out, l == 0 ? args.in[2] : HC, MR, !last, !last); PT1(pb + 6); SEAM(pb + 6); }
        if ((PHM & 512) && IN(pb + 7)) { PT0(pb + 7); const Ctx P = launder(F); PTRS();
            pg8::Gemm g{ACT, (const bf16*)(wl + W_GU), MR, 2 * FF, DM}; pg8::StaticOrder S; S.init(MR, 2 * FF, P.G, P.bx, DM);
            pg8::EpiGU E{HID};
            pg8::gemm_phase<pg8::EpiGU, pg8::StaticOrder, true, true>(P.lds, P.tid, g, S, E);
            PT1(pb + 7); SEAM(pb + 7);
        }
        if ((PHM & 1024) && IN(pb + 8)) { PT0(pb + 8); const Ctx P = launder(F); PTRS();
            pg8::Gemm g{HID, (const bf16*)(wl + W_D), MR, DM, FF}; pg8::ResOrder S; S.init(P.G, P.bx, FF, !last);
            pg8::EpiRes E{P.out, HC, P.out, HC, MODl + 5 * DM, (float*)(P.ws + WS_SLAB)};
            pg8::gemm_phase<pg8::EpiRes, pg8::ResOrder, true, true>(P.lds, P.tid, g, S, E);
            PT1(pb + 8); SEAM(pb + 8);
        }
    }
#if defined(CLOCK_PROBE) || defined(PROBE_PHASE)
    {
        unsigned* pa = (unsigned*)(F.ws + WS_CTL) + 65536;
        if (threadIdx.x == 0) pa[blockIdx.x] = (unsigned)(pt1 - pt0);
        xcd_barrier(bar);
        float val = 0.f;
#ifdef PROBE_PHASE
        if (blockIdx.x == 0 && threadIdx.x == 0) { unsigned mx = 0, mn = 0xffffffffu; unsigned long long sm = 0; int imx = 0;
            for (unsigned b = 0; b < gridDim.x; ++b) { const unsigned v = __hip_atomic_load(pa + b, __ATOMIC_RELAXED, __HIP_MEMORY_SCOPE_AGENT); sm += v; if (v > mx) { mx = v; imx = (int)b; } if (v < mn) mn = v; }
            const float ghz = (float)(pc1 - pc0) / (float)(pt1 - pt0) * 0.1f;
            float xm[8]; unsigned xc[8];
            for (int x = 0; x < 8; ++x) { xm[x] = 0.f; xc[x] = 0; }
            for (unsigned b = 0; b < gridDim.x; ++b) { const unsigned v = __hip_atomic_load(pa + b, __ATOMIC_RELAXED, __HIP_MEMORY_SCOPE_AGENT); xm[b & 7] += (float)v; xc[b & 7]++; }
            float xmax = 0.f, xmin = 1e30f; int ixmax = 0;
            for (int x = 0; x < 8; ++x) { const float m = xm[x] / (float)xc[x]; if (m > xmax) { xmax = m; ixmax = x; } if (m < xmin) xmin = m; }
            if (PROBE_KIND == 9) val = ((float)mx - (float)(sm / gridDim.x)) * 0.01f + 35.f; else if (PROBE_KIND == 8) val = (float)mx * 0.01f - (float)PROBE_BASE; else if (PROBE_KIND == 7) val = 10.f * ((float)mx * 0.001f - (float)PROBE_BASE); else if (PROBE_KIND == 5) val = (xmax - xmin) * 0.01f; else if (PROBE_KIND == 6) val = 40.f + 10.f * (float)ixmax; else
            val = PROBE_KIND == 0 ? (float)mx * 0.001f : PROBE_KIND == 1 ? (float)(mx - mn) * 0.01f : PROBE_KIND == 2 ? (float)(sm / gridDim.x) * 0.001f : PROBE_KIND == 3 ? (float)(imx & 7) * 10.f + 1.f : 100.f * ghz; }
#else
        val = CLOCK_PROBE == 9 ? (float)pwait * 0.001f : 0.f;
#endif
        f32x4* o4 = (f32x4*)F.out; const size_t n4 = (size_t)ML * DM / 4, per = n4 / gridDim.x;
        for (size_t i = (size_t)blockIdx.x * per + threadIdx.x; i < (size_t)(blockIdx.x + 1) * per; i += NWAVES * 64) o4[i] = (f32x4){3000.f, 3000.f, 3000.f, 3000.f};
        __syncthreads();
        if (blockIdx.x == 0 && threadIdx.x == 0) { asm volatile("s_waitcnt vmcnt(0)" ::: "memory"); F.out[0] = 100.f * val; }
    }
#endif
#undef IN
#undef SEAM
}

#ifndef MK_PER_PHASE
#define MK_PER_PHASE 0
#endif
extern "C" void kernel_launch(void* const* d_in, const int* in_sizes, int n_in, void* d_out, int out_size, void* d_ws, size_t ws_size, hipStream_t stream) {
    static int grid = 0;
    if (grid == 0) {
        if (n_in != 25 || in_sizes[0] != ML * DM || out_size != ML * DM || ws_size < WS_END) {
            fprintf(stderr, "kernel_launch: shape mismatch: n_in %d in0 %d out %d ws %zu (need %zu); nothing launched\n", n_in, n_in > 0 ? in_sizes[0] : -1, out_size, ws_size, (size_t)WS_END); grid = -1; return; }
        int dev = 0, cus = 0, per_cu = 0;
        if (hipGetDevice(&dev) != hipSuccess || hipDeviceGetAttribute(&cus, hipDeviceAttributeMultiprocessorCount, dev) != hipSuccess) { grid = -1; return; }
        if (hipFuncSetAttribute((const void*)fwd_kernel, hipFuncAttributeMaxDynamicSharedMemorySize, LDS_BYTES) != hipSuccess) { fprintf(stderr, "kernel_launch: hipFuncSetAttribute failed\n"); grid = -1; return; }
        if (hipOccupancyMaxActiveBlocksPerMultiprocessor(&per_cu, (const void*)fwd_kernel, NWAVES * 64, LDS_BYTES) != hipSuccess || per_cu < 1)
            fprintf(stderr, "kernel_launch: note: occupancy query reports %d workgroups per CU\n", per_cu);
        (void)hipGetLastError();
        grid = cus > MAX_GRID ? MAX_GRID : cus;
    }
    if (grid < 0) return;
    if (hipMemsetAsync((char*)d_ws + WS_CTL, 0, CTL_ZERO_BYTES, stream) != hipSuccess) return;
    Args a{};
    for (int i = 0; i < 25; ++i) a.in[i] = (const float*)d_in[i];
    a.out = (float*)d_out; a.ws = (unsigned char*)d_ws; a.pad = 0;
#if MK_PER_PHASE
    constexpr int NL = N_PHASES; int rl[NL][2]; for (int p = 0; p < NL; ++p) { rl[p][0] = p; rl[p][1] = p + 1; }
#elif defined(PROBE_SEQ)
    const int rl[][2] = PROBE_SEQ; constexpr int NL = sizeof(rl) / sizeof(rl[0]);
#else
    constexpr int NL = 1; const int rl[1][2] = {{0, N_PHASES}};
#endif
    for (int li = 0; li < NL; ++li) { a.ph_lo = rl[li][0]; a.ph_hi = rl[li][1]; a.bar_region = li;
        hipLaunchKernelGGL(fwd_kernel, dim3(grid), dim3(NWAVES * 64), LDS_BYTES, stream, a); }
    const hipError_t le = hipPeekAtLastError();
    if (le != hipSuccess) fprintf(stderr, "kernel_launch: launch failed: %s\n", hipGetErrorName(le));
}
```

```cpp
#include <hip/hip_runtime.h>
#include <hip/hip_bf16.h>
#include <cstdio>
#include <cstdint>

constexpr int DM = 4096, NBATCH = 2, SEQ = 8192, CTXL = 256, DEPTH = 2;
constexpr int ML = NBATCH * SEQ, MC = NBATCH * CTXL, MT = ML + MC;
constexpr int IN_DIM = 28672, FF = 11008, NMOD = 6 * DM;
constexpr int ZC_BG = 0, ZC_CG = 2048, ZC_XIN = 4096, ZC_Q = 6144, ZC_K = 8192, ZC_V = 10240, ZC_U = 12288, ZC_VM = 14336, ZC_GATE = 16384;
constexpr float EPS = 1e-6f;
constexpr int NTM = MT / 256;

namespace pg8 {
#define PG8_LAS __attribute__((address_space(3)))
typedef unsigned short bf16_t;
typedef short bf16x8 __attribute__((ext_vector_type(8)));
typedef float f32x4 __attribute__((ext_vector_type(4)));
typedef unsigned u32x4 __attribute__((ext_vector_type(4)));
constexpr int BM = 256, BK = 64, HALF = 128, HTB = HALF * BK * 2  , STAGE_BYTES = 8 * HTB, NXCD = 8, WGM = 4;

__host__ __device__ __forceinline__ int lds_byte(int r, int c) { const int st = (r >> 4) * 2 + (c >> 5), rr = r & 15, cc = c & 31, ob = rr * 64 + cc * 2; return st * 1024 + (ob ^ (((ob >> 9) & 1) << 5)); }
__host__ __device__ __forceinline__ void stage_rc(int b, int& R, int& C) { const int st = b / 1024, sb = b % 1024, swz = sb ^ (((sb >> 9) & 1) << 5); R = (st >> 1) * 16 + swz / 64; C = (st & 1) * 32 + (swz % 64) / 2; }
__host__ __device__ __forceinline__ int perm32(int rho) { const int n = rho >> 4, i = rho & 15; return 8 * (i >> 2) + 4 * n + (i & 3); }

struct Unit { int pm, pn, k0, nk, ks; };
struct Gemm { const bf16_t* A; const bf16_t* Bt; int M, N, K; };

#ifndef XROT
#define XROT 0
#endif
struct StaticOrder {
    int nM, nN, nwg, G, c, nkf;
    int rs; unsigned* tk; PG8_LAS unsigned* slot;
    __host__ __device__ void init(int M, int N, int G_, int c_, int K_) { nM = M / BM; nN = N / BM; nwg = nM * nN; G = G_; c = c_; nkf = K_ / BK; rs = 0x7fffffff; tk = nullptr; slot = nullptr; }
    __device__ void ticketed(unsigned* t, PG8_LAS unsigned char* lds) { const int r = nwg / G; if (r >= 3 && !(G & 7)) { rs = r - 1; tk = t; slot = (PG8_LAS unsigned*)(lds + 147440); } }
    __device__ __forceinline__ long lin_t(int i) const {
        if (i + 1 < rs) return lin(i);
        if (threadIdx.x == 0) { const unsigned t = __hip_atomic_fetch_add(tk, 1u, __ATOMIC_RELAXED, __HIP_MEMORY_SCOPE_AGENT); *(volatile PG8_LAS unsigned*)(slot + ((i + 1) & 1)) = t; }
        if (i < rs) return lin(i);
        const unsigned t = *(volatile PG8_LAS unsigned*)(slot + (i & 1));
        return (long)rs * G + (long)__builtin_amdgcn_readfirstlane((int)t);
    }
    __host__ __device__ long lin(int i) const { return (G & 7) ? (long)i * G + c : (long)i * G + (long)((c + XROT) & 7) * (G >> 3) + (c >> 3); }
    __host__ __device__ void tile_of(int U, int& pm, int& pn) const {
        constexpr int CW = 8, R = WGM; const int cc = U / (nM * CW); int cw = nN - cc * CW; cw = cw > CW ? CW : cw;
        const int up = U - cc * nM * CW, g = up / (R * cw); int rg = nM - R * g; rg = rg > R ? R : rg;
        const int upp = up - g * R * cw; pn = cc * CW + upp / rg; pm = R * g + upp % rg;
    }
    __device__ __forceinline__ bool from_lin(long L, Unit& u) const {
        if (L >= nwg) return false;
        tile_of((int)L, u.pm, u.pn); u.k0 = 0; u.nk = nkf; u.ks = -1; return true;
    }
    __device__ __forceinline__ bool next(int i, Unit& u) const { return from_lin(lin_t(i), u); }
    __device__ __forceinline__ void a_ready(const Unit&) const {}
    __device__ __forceinline__ void done(const Unit&) const {}
};

__device__ __forceinline__ unsigned cvt_pk_bf16(float lo, float hi) { unsigned r; asm volatile("v_cvt_pk_bf16_f32 %0, %1, %2" : "=v"(r) : "v"(lo), "v"(hi)); return r; }
typedef float f32x2 __attribute__((ext_vector_type(2)));
__device__ __forceinline__ float fsigmoid(float x) { return __builtin_amdgcn_rcpf(1.f + __builtin_amdgcn_exp2f(-1.4426950408889634f * x)); }
__device__ __forceinline__ float fgelu(float x) { const float t = x * (1.f + 0.044715f * x * x); return x * __builtin_amdgcn_rcpf(1.f + __builtin_amdgcn_exp2f(-2.3022081981f * t)); }
__device__ __forceinline__ float bflo(unsigned w) { return __uint_as_float(w << 16); }
__device__ __forceinline__ float bfhi(unsigned w) { return __uint_as_float(w & 0xffff0000u); }

struct EpiZ {
    static constexpr bool PERM = true, AFTER_DRAIN = false, DRAIN_AFTER = false;
    __device__ static __forceinline__ bool reset_after(const Unit&) { return true; }
    bf16_t* Z; float* KVF;
    __device__ __forceinline__ void operator()(const f32x4 (&acc)[2][2][4][2], const Unit& u, int wr, int wc, int fr, int fq) const {
        const int row0 = u.pm * BM + wr * 64 + fr, col0 = u.pn * BM + wc * 32 + 8 * fq;
        if (u.ks >= 0) {
            float* slab = KVF + (size_t)u.ks * MC * 4096;
#pragma unroll
            for (int ai = 0; ai < 2; ++ai)
#pragma unroll
                for (int m = 0; m < 4; ++m) { float* rowp = slab + (size_t)(row0 - ML + ai * HALF + m * 16) * 4096 + (col0 - ZC_K);
#pragma unroll
                    for (int bj = 0; bj < 2; ++bj) { *(f32x4*)(rowp + bj * HALF) = acc[ai][bj][m][0]; *(f32x4*)(rowp + bj * HALF + 4) = acc[ai][bj][m][1]; } }
            return;
        }
        const int mode = u.pn < 48 ? 0 : (u.pn < 64 ? 1 : 2);
#pragma unroll
        for (int ai = 0; ai < 2; ++ai)
#pragma unroll
            for (int m = 0; m < 4; ++m) { bf16_t* rowp = Z + (size_t)(row0 + ai * HALF + m * 16) * IN_DIM + col0;
#pragma unroll
                for (int bj = 0; bj < 2; ++bj) { f32x4 v0 = acc[ai][bj][m][0], v1 = acc[ai][bj][m][1];
                    if (mode == 1) {
#pragma unroll
                        for (int e = 0; e < 4; ++e) { v0[e] = fgelu(v0[e]); v1[e] = fgelu(v1[e]); } }
                    else if (mode == 2) {
#pragma unroll
                        for (int e = 0; e < 4; ++e) { v0[e] = fmaxf(fsigmoid(v0[e]), 1e-7f); v1[e] = fmaxf(fsigmoid(v1[e]), 1e-7f); } }
                    u32x4 w; w.x = cvt_pk_bf16(v0[0], v0[1]); w.y = cvt_pk_bf16(v0[2], v0[3]); w.z = cvt_pk_bf16(v1[0], v1[1]); w.w = cvt_pk_bf16(v1[2], v1[3]);
                    *(u32x4*)(rowp + bj * HALF) = w; } }
    }
};

struct EpiBr {
    static constexpr bool PERM = true, AFTER_DRAIN = false, DRAIN_AFTER = true;
    const bf16_t* Z; bf16_t* Y;
    __device__ static __forceinline__ bool reset_after(const Unit& u) { return u.pm >= 2 * NTM; }
    __device__ __forceinline__ void operator()(f32x4 (&acc)[2][2][4][2], const Unit& u, int wr, int wc, int fr, int fq) const {
        const int br = u.pm / NTM, pm = u.pm - br * NTM, pn = u.pn - br * 16;
        const int row0 = pm * BM + wr * 64 + fr, col0 = pn * BM + wc * 32 + 8 * fq;
        if (br < 2) {
#pragma unroll
            for (int ai = 0; ai < 2; ++ai)
#pragma unroll
                for (int mh = 0; mh < 2; ++mh) {
                    u32x4 g[2][2], h[2][2];
#pragma unroll
                    for (int mm = 0; mm < 2; ++mm)
#pragma unroll
                        for (int bj = 0; bj < 2; ++bj) { const bf16_t* gp = Z + (size_t)(row0 + ai * HALF + (2 * mh + mm) * 16) * IN_DIM + ZC_GATE + br * DM + col0 + bj * HALF;
                            g[mm][bj] = *(const u32x4*)gp; h[mm][bj] = *(const u32x4*)(gp + DM); }
                    __builtin_amdgcn_sched_barrier(0);
#pragma unroll
                    for (int mm = 0; mm < 2; ++mm)
#pragma unroll
                        for (int bj = 0; bj < 2; ++bj) { const u32x4 gg = g[mm][bj], hh = h[mm][bj]; f32x4& v0 = acc[ai][bj][2 * mh + mm][0]; f32x4& v1 = acc[ai][bj][2 * mh + mm][1];
                            v0[0] *= bflo(gg.x) * __builtin_amdgcn_rcpf(bflo(hh.x)); v0[1] *= bfhi(gg.x) * __builtin_amdgcn_rcpf(bfhi(hh.x)); v0[2] *= bflo(gg.y) * __builtin_amdgcn_rcpf(bflo(hh.y)); v0[3] *= bfhi(gg.y) * __builtin_amdgcn_rcpf(bfhi(hh.y));
                            v1[0] *= bflo(gg.z) * __builtin_amdgcn_rcpf(bflo(hh.z)); v1[1] *= bfhi(gg.z) * __builtin_amdgcn_rcpf(bfhi(hh.z)); v1[2] *= bflo(gg.w) * __builtin_amdgcn_rcpf(bflo(hh.w)); v1[3] *= bfhi(gg.w) * __builtin_amdgcn_rcpf(bfhi(hh.w)); }
                    __builtin_amdgcn_sched_barrier(0);
                }
        } else {
#pragma unroll
            for (int ai = 0; ai < 2; ++ai) {
                u32x4 g[4][2];
#pragma unroll
                for (int m = 0; m < 4; ++m)
#pragma unroll
                    for (int bj = 0; bj < 2; ++bj) g[m][bj] = *(const u32x4*)(Z + (size_t)(row0 + ai * HALF + m * 16) * IN_DIM + ZC_GATE + 2 * DM + col0 + bj * HALF);
                __builtin_amdgcn_sched_barrier(0);
#pragma unroll
                for (int m = 0; m < 4; ++m)
#pragma unroll
                    for (int bj = 0; bj < 2; ++bj) { const u32x4 gg = g[m][bj]; const f32x4 a0 = acc[ai][bj][m][0], a1 = acc[ai][bj][m][1];
                        u32x4 w; w.x = cvt_pk_bf16(a0[0] * bflo(gg.x), a0[1] * bfhi(gg.x)); w.y = cvt_pk_bf16(a0[2] * bflo(gg.y), a0[3] * bfhi(gg.y));
                        w.z = cvt_pk_bf16(a1[0] * bflo(gg.z), a1[1] * bfhi(gg.z)); w.w = cvt_pk_bf16(a1[2] * bflo(gg.w), a1[3] * bfhi(gg.w));
                        *(u32x4*)(Y + (size_t)(row0 + ai * HALF + m * 16) * DM + col0 + bj * HALF) = w; }
                __builtin_amdgcn_sched_barrier(0);
            }
        }
    }
};

struct EpiRes {
    static constexpr bool PERM = false, AFTER_DRAIN = false, DRAIN_AFTER = true;
    __device__ static __forceinline__ bool reset_after(const Unit&) { return true; }
    const float* src_lat; const float* src_ctx; float* dst_lat; float* dst_ctx; const float* gvec; float* slabs;
    __device__ __forceinline__ void operator()(const f32x4 (&acc)[2][2][4][2], const Unit& u, int wr, int wc, int fr, int fq) const {
        const int pm = u.pm, cls = pm < 32 ? 0 : (pm < 64 ? 1 : 2);
        const float* src = pm < 64 ? src_lat + (size_t)pm * BM * DM : src_ctx + (size_t)(pm - 64) * BM * DM;
        float* dst = pm < 64 ? dst_lat + (size_t)pm * BM * DM : dst_ctx + (size_t)(pm - 64) * BM * DM;
        const int col0 = u.pn * BM + wc * 32 + 4 * fq; const float* gv = gvec + (size_t)cls * NMOD + col0;
        f32x4 g[2][2];
#pragma unroll
        for (int bj = 0; bj < 2; ++bj)
#pragma unroll
            for (int n = 0; n < 2; ++n) g[bj][n] = *(const f32x4*)(gv + bj * HALF + n * 16);
        if (u.ks >= 0) {
            float* slab = slabs + (size_t)u.ks * MC * DM + (size_t)(pm - 64) * BM * DM;
#pragma unroll
            for (int ai = 0; ai < 2; ++ai)
#pragma unroll
                for (int m = 0; m < 4; ++m) { float* rowp = slab + (size_t)(ai * HALF + wr * 64 + m * 16 + fr) * DM + col0;
#pragma unroll
                    for (int bj = 0; bj < 2; ++bj)
#pragma unroll
                        for (int n = 0; n < 2; ++n) *(f32x4*)(rowp + bj * HALF + n * 16) = g[bj][n] * acc[ai][bj][m][n]; }
            return;
        }
#pragma unroll
        for (int am = 0; am < 4; ++am) { const int ai = am >> 1, m0 = (am & 1) * 2;
            f32x4 s[2][2][2];
#pragma unroll
            for (int mm = 0; mm < 2; ++mm) { const size_t off = (size_t)(ai * HALF + wr * 64 + (m0 + mm) * 16 + fr) * DM + col0;
#pragma unroll
                for (int bj = 0; bj < 2; ++bj)
#pragma unroll
                    for (int n = 0; n < 2; ++n) s[mm][bj][n] = *(const f32x4*)(src + off + bj * HALF + n * 16); }
            __builtin_amdgcn_sched_barrier(0);
#pragma unroll
            for (int mm = 0; mm < 2; ++mm) { const size_t off = (size_t)(ai * HALF + wr * 64 + (m0 + mm) * 16 + fr) * DM + col0;
#pragma unroll
                for (int bj = 0; bj < 2; ++bj)
#pragma unroll
                    for (int n = 0; n < 2; ++n) *(f32x4*)(dst + off + bj * HALF + n * 16) = s[mm][bj][n] + g[bj][n] * acc[ai][bj][m0 + mm][n]; }
            __builtin_amdgcn_sched_barrier(0);
        }
    }
};

struct EpiGU {
    static constexpr bool PERM = true, AFTER_DRAIN = false, DRAIN_AFTER = false;
    __device__ static __forceinline__ bool reset_after(const Unit&) { return true; }
    bf16_t* H;
    __device__ __forceinline__ void operator()(const f32x4 (&acc)[2][2][4][2], const Unit& u, int wr, int wc, int fr, int fq) const {
        const int row0 = u.pm * BM + wr * 64 + fr, col0 = u.pn * HALF + wc * 32 + 8 * fq;
#pragma unroll
        for (int ai = 0; ai < 2; ++ai)
#pragma unroll
            for (int m = 0; m < 4; ++m) { f32x4 g0 = acc[ai][0][m][0], g1 = acc[ai][0][m][1]; const f32x4 u0 = acc[ai][1][m][0], u1 = acc[ai][1][m][1];
#pragma unroll
                for (int e = 0; e < 4; ++e) { g0[e] = g0[e] * fsigmoid(g0[e]) * u0[e]; g1[e] = g1[e] * fsigmoid(g1[e]) * u1[e]; }
                u32x4 w; w.x = cvt_pk_bf16(g0[0], g0[1]); w.y = cvt_pk_bf16(g0[2], g0[3]); w.z = cvt_pk_bf16(g1[0], g1[1]); w.w = cvt_pk_bf16(g1[2], g1[3]);
                *(u32x4*)(H + (size_t)(row0 + ai * HALF + m * 16) * FF + col0) = w; }
    }
};

struct BranchOrder {
    int G, c, nM;
    __device__ bool next(int i, Unit& u) const {
        const int ti = i / 3, br = i - 3 * ti; StaticOrder T; T.nM = nM; T.nN = 16; T.nwg = nM * 16; T.G = G; T.c = c; T.nkf = 2048 / BK;
        const long L = T.lin(ti); if (L >= T.nwg) return false;
        int pm, pn; T.tile_of((int)L, pm, pn);
        u.pm = br * NTM + pm; u.pn = br * 16 + pn; u.k0 = 0; u.nk = 2048 / BK; u.ks = -1; return true;
    }
    __device__ __forceinline__ void a_ready(const Unit&) const {}
    __device__ __forceinline__ void done(const Unit&) const {}
};
__device__ __forceinline__ void ksplit8(int nkf, int s, int& k0, int& nk) { const int e = (nkf / 8) & ~1, half = (nkf - 8 * e) / 2; k0 = s * e + 2 * (s < half ? s : half); nk = e + (s < half ? 2 : 0); }
struct InOrder {
    StaticOrder S; int nmain, kv_only;
    __device__ void init(int G, int c, bool last) { kv_only = last; S.init(last ? ML : MT, IN_DIM, G, c, DM); nmain = S.nwg; }
    __device__ bool next(int i, Unit& u) const {
        const long L0 = S.lin_t(i); if (S.from_lin(L0, u)) return true;
        if (!kv_only) return false;
        const long L = L0 - nmain; if (L < 0 || L >= 256) return false;
        const int tile = (int)(L >> 3); u.pm = 64 + (tile >> 4); u.pn = 32 + (tile & 15); u.ks = (int)(L & 7); ksplit8(DM / BK, u.ks, u.k0, u.nk); return true;
    }
    __device__ __forceinline__ void a_ready(const Unit&) const {}
    __device__ __forceinline__ void done(const Unit&) const {}
};
struct ResOrder {
    StaticOrder S; int nmain, with_ctx;
    __device__ void init(int G, int c, int K, bool ctx) { with_ctx = ctx; S.init(ML, DM, G, c, K); nmain = S.nwg; }
    __device__ bool next(int i, Unit& u) const {
        const long L0 = S.lin_t(i); if (S.from_lin(L0, u)) return true;
        if (!with_ctx) return false;
        const long L = L0 - nmain; if (L < 0 || L >= 256) return false;
        const int tile = (int)(L >> 3); u.pm = 64 + (tile >> 4); u.pn = tile & 15; u.ks = (int)(L & 7); ksplit8(S.nkf, u.ks, u.k0, u.nk); return true;
    }
    __device__ __forceinline__ void a_ready(const Unit&) const {}
    __device__ __forceinline__ void done(const Unit&) const {}
};

template <class Epi, class Sched, bool ALIGN_EPI = false, bool SP2 = false>
__device__ __forceinline__ void gemm_phase(PG8_LAS unsigned char* lds, const int tid, const Gemm g, const Sched& S, const Epi& E) {
    const int wid = __builtin_amdgcn_readfirstlane(tid >> 6), lane = tid & 63, wr = wid >> 2, wc = wid & 3, fr = lane & 15, fq = lane >> 4;
    const int K = g.K;
    unsigned voffA[2], voffB[2];
#pragma unroll
    for (int i = 0; i < 2; ++i) { int R, C; stage_rc(tid * 16 + i * 8192, R, C); const int Rb = Epi::PERM ? ((R & ~31) + perm32(R & 31)) : R;
        voffA[i] = (unsigned)(R * K + C) * 2u; voffB[i] = (unsigned)(Rb * K + C) * 2u; }
    const size_t kstep = (size_t)(BK * 2);
    const size_t hstep = (size_t)HALF * K * 2;
    const size_t tstep = 2 * hstep;
    const unsigned ldsw = (unsigned)wid * 1024u;
    const int aoff = lds_byte(wr * 64 + fr, fq * 8), boff = lds_byte(wc * 32 + fr, fq * 8);
#define PG8_SA(b, h) (((b) * 2 + (h)) * HTB)
#define PG8_SB(b, h) ((4 + (b) * 2 + (h)) * HTB)
#define PG8_STAGE(bufoff, gbase, voff) do { _Pragma("unroll") for (int _i = 0; _i < 2; ++_i) \
        __builtin_amdgcn_global_load_lds((const unsigned*)((const char*)(gbase) + (voff)[_i]), (PG8_LAS unsigned*)(lds + (bufoff) + ldsw + _i * 8192), 16, 0, 0); } while (0)
#define PG8_LDA(dst, b, h) do { _Pragma("unroll") for (int m = 0; m < 4; ++m) _Pragma("unroll") for (int k = 0; k < 2; ++k) dst[m][k] = *(const PG8_LAS bf16x8*)(lds + PG8_SA(b, h) + aoff + m * 2048 + k * 1024); } while (0)
#define PG8_LDB(dst, b, h) do { _Pragma("unroll") for (int n = 0; n < 2; ++n) _Pragma("unroll") for (int k = 0; k < 2; ++k) dst[n][k] = *(const PG8_LAS bf16x8*)(lds + PG8_SB(b, h) + boff + n * 2048 + k * 1024); } while (0)
#define PG8_MMA(ai, bj, At, Bt) do { __builtin_amdgcn_s_setprio(1); _Pragma("unroll") for (int m = 0; m < 4; ++m) _Pragma("unroll") for (int n = 0; n < 2; ++n) _Pragma("unroll") for (int k = 0; k < 2; ++k) \
        acc[ai][bj][m][n] = __builtin_amdgcn_mfma_f32_16x16x32_bf16(Bt[n][k], At[m][k], acc[ai][bj][m][n], 0, 0, 0); __builtin_amdgcn_s_setprio(0); } while (0)
#define PG8_WAIT_V(n) asm volatile("s_waitcnt vmcnt(" #n ")" ::: "memory")
#define PG8_WAIT_L(n) asm volatile("s_waitcnt lgkmcnt(" #n ")" ::: "memory")
#define PG8_BAR __builtin_amdgcn_s_barrier()
#define PG8_SCHED __builtin_amdgcn_sched_barrier(0)
    Unit cur, nxt; int ui = 0;
    if (!S.next(0, cur)) return;
    f32x4 acc[2][2][4][2];
#pragma unroll
    for (int a = 0; a < 2; ++a)
#pragma unroll
        for (int b = 0; b < 2; ++b)
#pragma unroll
            for (int m = 0; m < 4; ++m)
#pragma unroll
                for (int n = 0; n < 2; ++n) acc[a][b][m][n] = (f32x4){0.f, 0.f, 0.f, 0.f};
    bf16x8 At[4][2], B0[2][2], B1[2][2];
#ifdef GEMM_FIXED
#define PG8_PM(u) (((GEMM_FIXED) & 1) ? 0 : (u).pm)
#define PG8_PN(u) (((GEMM_FIXED) & 2) ? 0 : (u).pn)
#else
#define PG8_PM(u) ((u).pm)
#define PG8_PN(u) ((u).pn)
#endif
    const char* cA = (const char*)g.A + (size_t)PG8_PM(cur) * tstep + (size_t)cur.k0 * kstep; const char* cB = (const char*)g.Bt + (size_t)PG8_PN(cur) * tstep + (size_t)cur.k0 * kstep;
    int nt = cur.nk;
    S.a_ready(cur);
    if constexpr (SP2) {
        PG8_STAGE(PG8_SB(0, 0), cB, voffB); PG8_STAGE(PG8_SB(0, 1), cB + hstep, voffB); PG8_STAGE(PG8_SA(0, 0), cA, voffA); PG8_STAGE(PG8_SA(0, 1), cA + hstep, voffA);
        if (wr == 1) PG8_BAR;
        PG8_WAIT_V(2); PG8_BAR;
        PG8_STAGE(PG8_SB(1, 0), cB + kstep, voffB); PG8_STAGE(PG8_SA(1, 0), cA + kstep, voffA); PG8_STAGE(PG8_SB(1, 1), cB + hstep + kstep, voffB);
        PG8_WAIT_V(6); PG8_BAR;
    } else {
        PG8_STAGE(PG8_SB(0, 0), cB, voffB); PG8_STAGE(PG8_SA(0, 0), cA, voffA); PG8_STAGE(PG8_SB(0, 1), cB + hstep, voffB); PG8_STAGE(PG8_SA(0, 1), cA + hstep, voffA);
        if (wr == 1) PG8_BAR;
        PG8_WAIT_V(4); PG8_BAR;
        PG8_STAGE(PG8_SB(1, 0), cB + kstep, voffB); PG8_STAGE(PG8_SA(1, 0), cA + kstep, voffA); PG8_STAGE(PG8_SB(1, 1), cB + hstep + kstep, voffB);
        PG8_WAIT_V(6); PG8_BAR;
    }
    for (;;) {
        const bool has_next = S.next(ui + 1, nxt);
        const char* nA = has_next ? (const char*)g.A + (size_t)PG8_PM(nxt) * tstep + (size_t)nxt.k0 * kstep : cA; const char* nB = has_next ? (const char*)g.Bt + (size_t)PG8_PN(nxt) * tstep + (size_t)nxt.k0 * kstep : cB;
        for (int t = 0; t < nt; t += 2) {
            const bool last = (t == nt - 2);
            const char* a1 = cA + (size_t)(t + 1) * kstep;
            const char* a2 = last ? nA : cA + (size_t)(t + 2) * kstep; const char* b2 = last ? nB : cB + (size_t)(t + 2) * kstep;
            const char* a3 = a2 + kstep; const char* b3 = b2 + kstep;
            if (last && has_next) S.a_ready(nxt);
            if constexpr (SP2) {
            PG8_LDB(B0, 0, 0); PG8_LDB(B1, 0, 1); PG8_SCHED; PG8_LDA(At, 0, 0); PG8_STAGE(PG8_SA(1, 1), a1 + hstep, voffA);
            PG8_WAIT_V(8); PG8_WAIT_L(0); PG8_BAR; PG8_MMA(0, 0, At, B0); PG8_MMA(0, 1, At, B1); PG8_BAR; PG8_SCHED;
            PG8_LDA(At, 0, 1); PG8_STAGE(PG8_SB(0, 0), b2, voffB); PG8_STAGE(PG8_SB(0, 1), b2 + hstep, voffB); PG8_STAGE(PG8_SA(0, 0), a2, voffA);
            PG8_WAIT_V(8); PG8_WAIT_L(0); PG8_BAR; PG8_MMA(1, 0, At, B0); PG8_MMA(1, 1, At, B1); PG8_BAR; PG8_SCHED;
            PG8_LDB(B0, 1, 0); PG8_LDB(B1, 1, 1); PG8_SCHED; PG8_LDA(At, 1, 0); PG8_STAGE(PG8_SA(0, 1), a2 + hstep, voffA);
            PG8_WAIT_V(8); PG8_WAIT_L(0); PG8_BAR; PG8_MMA(0, 0, At, B0); PG8_MMA(0, 1, At, B1); PG8_BAR; PG8_SCHED;
            PG8_LDA(At, 1, 1); PG8_STAGE(PG8_SB(1, 0), b3, voffB); PG8_STAGE(PG8_SB(1, 1), b3 + hstep, voffB); PG8_STAGE(PG8_SA(1, 0), a3, voffA);
            PG8_WAIT_V(8); PG8_WAIT_L(0); PG8_BAR; PG8_MMA(1, 0, At, B0); PG8_MMA(1, 1, At, B1); PG8_BAR; PG8_SCHED;
            } else {
            PG8_LDB(B0, 0, 0); PG8_SCHED; PG8_LDA(At, 0, 0); PG8_STAGE(PG8_SA(1, 1), a1 + hstep, voffA);
            PG8_WAIT_L(8); PG8_BAR; PG8_WAIT_L(0); PG8_MMA(0, 0, At, B0); PG8_BAR; PG8_SCHED;
            PG8_LDB(B1, 0, 1); PG8_STAGE(PG8_SB(0, 0), b2, voffB);
            PG8_BAR; PG8_WAIT_L(0); PG8_MMA(0, 1, At, B1); PG8_BAR;
            PG8_LDA(At, 0, 1); PG8_STAGE(PG8_SA(0, 0), a2, voffA);
            PG8_BAR; PG8_WAIT_L(0); PG8_MMA(1, 0, At, B0); PG8_BAR; PG8_SCHED;
            PG8_STAGE(PG8_SB(0, 1), b2 + hstep, voffB);
            PG8_WAIT_V(6); PG8_BAR; PG8_MMA(1, 1, At, B1); PG8_BAR;
            PG8_LDB(B0, 1, 0); PG8_SCHED; PG8_LDA(At, 1, 0); PG8_STAGE(PG8_SA(0, 1), a2 + hstep, voffA);
            PG8_WAIT_L(8); PG8_BAR; PG8_WAIT_L(0); PG8_MMA(0, 0, At, B0); PG8_BAR; PG8_SCHED;
            PG8_LDB(B1, 1, 1); PG8_STAGE(PG8_SB(1, 0), b3, voffB);
            PG8_BAR; PG8_WAIT_L(0); PG8_MMA(0, 1, At, B1); PG8_BAR;
            PG8_LDA(At, 1, 1); PG8_STAGE(PG8_SA(1, 0), a3, voffA);
            PG8_BAR; PG8_WAIT_L(0); PG8_MMA(1, 0, At, B0); PG8_BAR; PG8_SCHED;
            PG8_STAGE(PG8_SB(1, 1), b3 + hstep, voffB);
            PG8_WAIT_V(6); PG8_BAR; PG8_MMA(1, 1, At, B1); PG8_BAR;
            }
        }
        if constexpr (ALIGN_EPI) { if (wr == 0) PG8_BAR; }
        if constexpr (!Epi::AFTER_DRAIN) { E(acc, cur, wr, wc, fr, fq); S.done(cur);
            if constexpr (Epi::DRAIN_AFTER) __builtin_amdgcn_s_waitcnt(0x0F70); }
        if (!has_next) break;
        if (Epi::reset_after(cur)) {
#pragma unroll
        for (int a = 0; a < 2; ++a)
#pragma unroll
            for (int b = 0; b < 2; ++b)
#pragma unroll
                for (int m = 0; m < 4; ++m)
#pragma unroll
                    for (int n = 0; n < 2; ++n) acc[a][b][m][n] = (f32x4){0.f, 0.f, 0.f, 0.f};
        }
        cur = nxt; cA = nA; cB = nB; nt = cur.nk; ++ui;
        if constexpr (ALIGN_EPI) { if (wr == 1) PG8_BAR; }
    }
    PG8_WAIT_V(0);
    if constexpr (!ALIGN_EPI) { if (wr == 0) PG8_BAR; }
    PG8_BAR;
    if constexpr (Epi::AFTER_DRAIN) { E.fused(acc, cur, wr, wc, fr, fq, lds, wid, lane); S.done(cur); }
#undef PG8_SA
#undef PG8_SB
#undef PG8_STAGE
#undef PG8_LDA
#undef PG8_LDB
#undef PG8_MMA
#undef PG8_WAIT_V
#undef PG8_WAIT_L
#undef PG8_BAR
#undef PG8_SCHED
}
}
namespace att {
using bf16x8 = __attribute__((ext_vector_type(8))) short;
using s16x4  = __attribute__((ext_vector_type(4))) short;
using f32x16 = __attribute__((ext_vector_type(16))) float;
using u32x4  = __attribute__((ext_vector_type(4))) unsigned;
typedef unsigned short bf16_t;
constexpr int NW = 8, QBLK = 32, KVBLK = 64;
constexpr float SCALE = 0.125f, THR = 8.f;
constexpr int LDQK = DM, LDV = IN_DIM;
constexpr int NSLOT = 4;
constexpr int SHM_V = KVBLK * 128 * 2, SHM_K = KVBLK * 64 * 2, SHM_ATTN = NSLOT * SHM_V + NSLOT * SHM_K + NW * 64 * 4;
#define KSWZ(row, colB) ((row) * 128 + ((colB) ^ ((((row) >> 1) & 7) << 4)))
#define SBAR() __builtin_amdgcn_sched_barrier(0)
__device__ __forceinline__ int crow(int r, int hi) { return (r & 3) + 8 * (r >> 2) + 4 * hi; }
__device__ __forceinline__ unsigned cvtpk(float lo, float hi) { unsigned r; asm volatile("v_cvt_pk_bf16_f32 %0, %1, %2" : "=v"(r) : "v"(lo), "v"(hi)); return r; }

__device__ __forceinline__ int v_st(int k, int c) { const int kk = (k & ~0xC) | ((k & 4) << 1) | ((k & 8) >> 1); return ((kk >> 3) * 4 + (c >> 5)) * 512 + ((kk & 7) * 32 + (c & 31)) * 2; }
__device__ __forceinline__ int v_rd_base(int lane) { return ((lane & 3) << 3) | (((lane >> 2) & 3) << 6) | (((lane >> 4) & 1) << 5) | (((lane >> 5) & 1) << 8); }
constexpr int v_rd_off(int d0, int ks, int half) { return d0 * 512 + ks * 4096 + half * 2048; }
template <int OFF> __device__ __forceinline__ s16x4 tr_read(int vb) {
  s16x4 r; asm volatile("ds_read_b64_tr_b16 %0, %1 offset:%2" : "=&v"(r) : "v"(vb), "i"(OFF) : "memory"); return r;
}
template <int D0> __device__ __forceinline__ void pv_one(f32x16& od, int vb, bf16x8 pa0, bf16x8 pa1, bf16x8 pa2, bf16x8 pa3) {
  const s16x4 l0 = tr_read<v_rd_off(D0, 0, 0)>(vb), h0 = tr_read<v_rd_off(D0, 0, 1)>(vb), l1 = tr_read<v_rd_off(D0, 1, 0)>(vb), h1 = tr_read<v_rd_off(D0, 1, 1)>(vb);
  const s16x4 l2 = tr_read<v_rd_off(D0, 2, 0)>(vb), h2 = tr_read<v_rd_off(D0, 2, 1)>(vb), l3 = tr_read<v_rd_off(D0, 3, 0)>(vb), h3 = tr_read<v_rd_off(D0, 3, 1)>(vb);
  asm volatile("s_waitcnt lgkmcnt(0)" ::: "memory"); SBAR();
#define PK(L, H) (bf16x8){L[0], L[1], L[2], L[3], H[0], H[1], H[2], H[3]}
  od = __builtin_amdgcn_mfma_f32_32x32x16_bf16(pa0, PK(l0, h0), od, 0, 0, 0);
  od = __builtin_amdgcn_mfma_f32_32x32x16_bf16(pa1, PK(l1, h1), od, 0, 0, 0);
  od = __builtin_amdgcn_mfma_f32_32x32x16_bf16(pa2, PK(l2, h2), od, 0, 0, 0);
  od = __builtin_amdgcn_mfma_f32_32x32x16_bf16(pa3, PK(l3, h3), od, 0, 0, 0);
#undef PK
}

typedef float f32x2 __attribute__((ext_vector_type(2)));
template <int OFF> __device__ __forceinline__ bf16x8 k_read(int ka) {
  bf16x8 r; asm volatile("ds_read_b128 %0, %1 offset:%2" : "=&v"(r) : "v"(ka), "i"(OFF) : "memory"); return r;
}
struct VFr { s16x4 l0, h0, l1, h1, l2, h2, l3, h3; };
template <int D0, int VS> __device__ __forceinline__ void v_issue(VFr& f, int vb) {
#ifdef ATT_NOVREAD
  f.l0 = f.h0 = f.l1 = f.h1 = f.l2 = f.h2 = f.l3 = f.h3 = (s16x4){1, 1, 1, 1}; return;
#endif
  f.l0 = tr_read<VS * SHM_V + v_rd_off(D0, 0, 0)>(vb); f.h0 = tr_read<VS * SHM_V + v_rd_off(D0, 0, 1)>(vb); f.l1 = tr_read<VS * SHM_V + v_rd_off(D0, 1, 0)>(vb); f.h1 = tr_read<VS * SHM_V + v_rd_off(D0, 1, 1)>(vb);
  f.l2 = tr_read<VS * SHM_V + v_rd_off(D0, 2, 0)>(vb); f.h2 = tr_read<VS * SHM_V + v_rd_off(D0, 2, 1)>(vb); f.l3 = tr_read<VS * SHM_V + v_rd_off(D0, 3, 0)>(vb); f.h3 = tr_read<VS * SHM_V + v_rd_off(D0, 3, 1)>(vb);
}
#define ATT_PK(L, H) (bf16x8){L[0], L[1], L[2], L[3], H[0], H[1], H[2], H[3]}
#define ATT_LGKM(n) asm volatile("s_waitcnt lgkmcnt(" #n ")" ::: "memory")
__device__ __forceinline__ void sm_pair(f32x16& c, const int e, const float) {
#ifdef ATT_NOEXP
  c[e] = c[e] * 0.5f; c[e + 1] = c[e + 1] * 0.5f;
#else
  c[e] = __builtin_amdgcn_exp2f(c[e]); c[e + 1] = __builtin_amdgcn_exp2f(c[e + 1]);
#endif
}
__device__ __forceinline__ void acc_pair(f32x2& lsum, const float a, const float b) {
#ifdef ATT_NOSUM
  return;
#endif
  asm volatile("v_add_f32 %0, %0, %1" : "+v"(lsum.x) : "v"(a)); asm volatile("v_add_f32 %0, %0, %1" : "+v"(lsum.y) : "v"(b));
}
template <int G>
__device__ __forceinline__ void gapv(f32x16& c0, f32x16& c1, bf16x8 (&pn)[4], f32x2& lsum, unsigned (&cv)[4], const float m0c) {
  if constexpr (G < 16) {
    if constexpr (G < 14) { constexpr int e = 4 + 2 * G; if constexpr (e < 16) sm_pair(c0, e, m0c); else sm_pair(c1, e - 16, m0c); }
    constexpr int a = 2 * G;
    if constexpr (a < 16) acc_pair(lsum, c0[a], c0[a + 1]); else acc_pair(lsum, c1[a - 16], c1[a - 15]);
  } else {
    constexpr int k = G - 16, q = k >> 1, B = (q & 1) * 8;
    f32x16& P = (q < 2) ? c0 : c1;
    if constexpr ((k & 1) == 0) { cv[0] = cvtpk(P[B + 0], P[B + 1]); cv[1] = cvtpk(P[B + 2], P[B + 3]); cv[2] = cvtpk(P[B + 4], P[B + 5]); cv[3] = cvtpk(P[B + 6], P[B + 7]); }
    else {
      auto r0 = __builtin_amdgcn_permlane32_swap(cv[0], cv[2], false, false); auto r1 = __builtin_amdgcn_permlane32_swap(cv[1], cv[3], false, false);
      u32x4 w = {r0[0], r1[0], r0[1], r1[1]}; pn[q] = *reinterpret_cast<bf16x8*>(&w);
    }
  }
}
#define ATT_GAP(G) do { SBAR(); gapv<G>(c0, c1, pn, lsum, cv, m0c); SBAR(); } while (0)
#define ATT_PVBLK(OD, F, G0) do { \
    OD = __builtin_amdgcn_mfma_f32_32x32x16_bf16(pp[0], ATT_PK(F.l0, F.h0), OD, 0, 0, 0); ATT_GAP(G0); \
    OD = __builtin_amdgcn_mfma_f32_32x32x16_bf16(pp[1], ATT_PK(F.l1, F.h1), OD, 0, 0, 0); ATT_GAP(G0 + 1); \
    OD = __builtin_amdgcn_mfma_f32_32x32x16_bf16(pp[2], ATT_PK(F.l2, F.h2), OD, 0, 0, 0); ATT_GAP(G0 + 2); \
    OD = __builtin_amdgcn_mfma_f32_32x32x16_bf16(pp[3], ATT_PK(F.l3, F.h3), OD, 0, 0, 0); ATT_GAP(G0 + 3); } while (0)
template <bool HAS_QK, bool HAS_PV, int KS, int VS, class Mid>
__device__ __forceinline__ void att_seg(const Mid& mid, f32x16& c0, f32x16& c1, f32x16& n0, f32x16& n1, const bf16x8 (&pp)[4], bf16x8 (&pn)[4], f32x16 (&o)[4], f32x2& lsum,
                                        const int (&ka)[4], const int vb, const bf16x8 (&qf)[4], const float m0c) {
  unsigned cv[4]; VFr va, vq; bf16x8 kf[8];
  if constexpr (HAS_PV) { v_issue<0, VS>(va, vb); v_issue<1, VS>(vq, vb); }
  SBAR(); sm_pair(c0, 0, m0c); sm_pair(c0, 2, m0c); SBAR();
#define ATT_KQ_ISSUE() do { _Pragma("unroll") for (int d0 = 0; d0 < 4; ++d0) { kf[2 * d0] = k_read<KS * SHM_K>(ka[d0]); kf[2 * d0 + 1] = k_read<KS * SHM_K + 4096>(ka[d0]); } } while (0)
  if constexpr (HAS_PV) {
    ATT_LGKM(8); SBAR();
    ATT_PVBLK(o[0], va, 0);
#ifndef ATT_NOMID
    mid();
#endif
    SBAR();
    v_issue<2, VS>(va, vb); ATT_LGKM(8); SBAR();
    ATT_PVBLK(o[1], vq, 4);
    v_issue<3, VS>(vq, vb); ATT_LGKM(8); SBAR();
    ATT_PVBLK(o[2], va, 8);
    if constexpr (HAS_QK) { ATT_KQ_ISSUE(); ATT_LGKM(8); } else { ATT_LGKM(0); }
    SBAR();
    ATT_PVBLK(o[3], vq, 12);
  } else {
    mid(); SBAR();
    if constexpr (HAS_QK) ATT_KQ_ISSUE();
    ATT_GAP(0); ATT_GAP(1); ATT_GAP(2); ATT_GAP(3); ATT_GAP(4); ATT_GAP(5); ATT_GAP(6); ATT_GAP(7);
    ATT_GAP(8); ATT_GAP(9); ATT_GAP(10); ATT_GAP(11); ATT_GAP(12); ATT_GAP(13); ATT_GAP(14); ATT_GAP(15);
  }
  if constexpr (HAS_QK) {
    n0 = f32x16{}; n1 = f32x16{};
    ATT_LGKM(0); SBAR();
    n0 = __builtin_amdgcn_mfma_f32_32x32x16_bf16(kf[0], qf[0], n0, 0, 0, 0); ATT_GAP(16);
    n1 = __builtin_amdgcn_mfma_f32_32x32x16_bf16(kf[1], qf[0], n1, 0, 0, 0); ATT_GAP(17);
    n0 = __builtin_amdgcn_mfma_f32_32x32x16_bf16(kf[2], qf[1], n0, 0, 0, 0); ATT_GAP(18);
    n1 = __builtin_amdgcn_mfma_f32_32x32x16_bf16(kf[3], qf[1], n1, 0, 0, 0); ATT_GAP(19);
    n0 = __builtin_amdgcn_mfma_f32_32x32x16_bf16(kf[4], qf[2], n0, 0, 0, 0); ATT_GAP(20);
    n1 = __builtin_amdgcn_mfma_f32_32x32x16_bf16(kf[5], qf[2], n1, 0, 0, 0); ATT_GAP(21);
    n0 = __builtin_amdgcn_mfma_f32_32x32x16_bf16(kf[6], qf[3], n0, 0, 0, 0); ATT_GAP(22);
    n1 = __builtin_amdgcn_mfma_f32_32x32x16_bf16(kf[7], qf[3], n1, 0, 0, 0); ATT_GAP(23);
  } else { ATT_GAP(16); ATT_GAP(17); ATT_GAP(18); ATT_GAP(19); ATT_GAP(20); ATT_GAP(21); ATT_GAP(22); ATT_GAP(23); }
#undef ATT_KQ_ISSUE
}

__device__ __forceinline__ void attn_unit(const int MODE, const bf16_t* __restrict__ Qb, const bf16_t* __restrict__ Kh, const bf16_t* __restrict__ Vh, float* __restrict__ OS, bf16_t* __restrict__ AOb,
                                          const float* __restrict__ subg, float lam, float osc, const float m0c, int rowa, int nt0, int rowb, int NT, char* lds, int tid) {
  asm volatile("" : "+v"(tid));
  const int wid = tid >> 6, lane = tid & 63, r32 = lane & 31, hi = lane >> 5;
  char* V_lds = lds; char* K_lds = lds + NSLOT * SHM_V;
  float* ws = (float*)(lds + NSLOT * SHM_V + NSLOT * SHM_K) + wid * 64; float* li_l = ws;
  f32x16 o[4] = {}; bf16x8 qr[4];
  const bf16_t* Qw = Qb + (long)(wid * QBLK + r32) * LDQK + hi * 8;
#pragma unroll
  for (int d0 = 0; d0 < 4; ++d0) qr[d0] = *reinterpret_cast<const bf16x8*>(Qw + d0 * 16);
  unsigned koffd, voffd0, voffd1;
  { const int b = wid * 1024 + lane * 16, row = b >> 7, colB = (b & 127) ^ (((row >> 1) & 7) << 4); koffd = (unsigned)(row * LDQK * 2 + colB); }
  { const int b = wid * 1024 + lane * 16, sub = b >> 9, e = (b & 511) >> 1, kk = (sub >> 2) * 8 + (e >> 5), k = (kk & ~0xC) | ((kk & 4) << 1) | ((kk & 8) >> 1), col = (sub & 3) * 32 + (e & 31);
    voffd0 = (unsigned)(k * LDV * 2 + col * 2); }
  { const int b = 8192 + wid * 1024 + lane * 16, sub = b >> 9, e = (b & 511) >> 1, kk = (sub >> 2) * 8 + (e >> 5), k = (kk & ~0xC) | ((kk & 4) << 1) | ((kk & 8) >> 1), col = (sub & 3) * 32 + (e & 31);
    voffd1 = (unsigned)(k * LDV * 2 + col * 2); }
  const unsigned wid_s = (unsigned)__builtin_amdgcn_readfirstlane(wid);
  const unsigned ldsK = (unsigned)(uintptr_t)(lds + NSLOT * SHM_V) + wid_s * 1024u, ldsV = (unsigned)(uintptr_t)lds + wid_s * 1024u;
  const int vb = (int)(uintptr_t)V_lds + v_rd_base(lane);
  int ka[4];
#pragma unroll
  for (int d0 = 0; d0 < 4; ++d0) ka[d0] = (int)(uintptr_t)K_lds + KSWZ(r32, (d0 * 16 + hi * 8) * 2);
#define KROW(j) ((j) < nt0 ? rowa + (j) * KVBLK : rowb + ((j) - nt0) * KVBLK)
#define GLDS(src, dst) do { unsigned keep_; asm volatile("s_mov_b32 %0, m0\n\ts_mov_b32 m0, %2\n\ts_nop 0\n\tglobal_load_lds_dwordx4 %1, off\n\ts_mov_b32 m0, %0" : "=&s"(keep_) : "v"(src), "s"(dst) : "memory"); } while (0)
#define KDMA(j, slot) do { const int jc_ = (j) < NT ? (j) : NT - 1; GLDS((const char*)Kh + (size_t)KROW(jc_) * (LDQK * 2) + koffd, ldsK + (unsigned)(slot) * SHM_K); } while (0)
#define VDMA(j, slot) do { const int jc_ = (j) < NT ? (j) : NT - 1; const char* vb_ = (const char*)Vh + (size_t)KROW(jc_) * (LDV * 2); \
    GLDS(vb_ + voffd0, ldsV + (unsigned)(slot) * SHM_V); GLDS(vb_ + voffd1, ldsV + (unsigned)(slot) * SHM_V + 8192u); } while (0)
#define SEGEND() do { asm volatile("s_waitcnt vmcnt(0) lgkmcnt(0)" ::: "memory"); __builtin_amdgcn_s_barrier(); asm volatile("" ::: "memory"); } while (0)
  f32x16 sA0, sA1, sB0, sB1; bf16x8 paA[4], paB[4]; f32x2 lsum = {0.f, 0.f};
  const auto nomid = [&]() {};
  KDMA(0, 0); KDMA(1, 1); KDMA(2, 2); VDMA(0, 0);
  SEGEND();
  { bf16x8 kf[8];
#pragma unroll
    for (int d0 = 0; d0 < 4; ++d0) { kf[2 * d0] = k_read<0>(ka[d0]); kf[2 * d0 + 1] = k_read<4096>(ka[d0]); }
    sA0 = f32x16{}; sA1 = f32x16{}; ATT_LGKM(0); SBAR();
#pragma unroll
    for (int d0 = 0; d0 < 4; ++d0) { sA0 = __builtin_amdgcn_mfma_f32_32x32x16_bf16(kf[2 * d0], qr[d0], sA0, 0, 0, 0); sA1 = __builtin_amdgcn_mfma_f32_32x32x16_bf16(kf[2 * d0 + 1], qr[d0], sA1, 0, 0, 0); } }
  SEGEND();
  att_seg<true, false, 1, 0>([&]() { KDMA(3, 3); KDMA(4, 0); VDMA(1, 1); VDMA(2, 2); }, sA0, sA1, sB0, sB1, paB  , paA, o, lsum, ka, vb, qr, m0c);
  att_seg<true, true, 2, 0>(nomid, sB0, sB1, sA0, sA1, paA, paB, o, lsum, ka, vb, qr, m0c);
  SEGEND();
  for (int j = 2; j + 2 < NT; j += 4) {
    att_seg<true, true, 3, 1>([&]() { KDMA(j + 3, 1); KDMA(j + 4, 2); VDMA(j + 1, 3); VDMA(j + 2, 0); }, sA0, sA1, sB0, sB1, paB, paA, o, lsum, ka, vb, qr, m0c);
    att_seg<true, true, 0, 2>(nomid, sB0, sB1, sA0, sA1, paA, paB, o, lsum, ka, vb, qr, m0c);
    SEGEND();
    att_seg<true, true, 1, 3>([&]() { KDMA(j + 5, 3); KDMA(j + 6, 0); VDMA(j + 3, 1); VDMA(j + 4, 2); }, sA0, sA1, sB0, sB1, paB, paA, o, lsum, ka, vb, qr, m0c);
    att_seg<true, true, 2, 0>(nomid, sB0, sB1, sA0, sA1, paA, paB, o, lsum, ka, vb, qr, m0c);
    SEGEND();
  }
  att_seg<true, true, 3, 1>([&]() { VDMA(NT - 1, 3); }, sA0, sA1, sB0, sB1, paB, paA, o, lsum, ka, vb, qr, m0c);
  att_seg<false, true, 0, 2>(nomid, sB0, sB1, sA0, sA1, paA, paB, o, lsum, ka, vb, qr, m0c);
  SEGEND();
  { VFr va, vq;
    v_issue<0, 3>(va, vb); v_issue<1, 3>(vq, vb); ATT_LGKM(8); SBAR();
#define ATT_PV4(OD, F, PP) do { OD = __builtin_amdgcn_mfma_f32_32x32x16_bf16(PP[0], ATT_PK(F.l0, F.h0), OD, 0, 0, 0); OD = __builtin_amdgcn_mfma_f32_32x32x16_bf16(PP[1], ATT_PK(F.l1, F.h1), OD, 0, 0, 0); \
    OD = __builtin_amdgcn_mfma_f32_32x32x16_bf16(PP[2], ATT_PK(F.l2, F.h2), OD, 0, 0, 0); OD = __builtin_amdgcn_mfma_f32_32x32x16_bf16(PP[3], ATT_PK(F.l3, F.h3), OD, 0, 0, 0); } while (0)
    ATT_PV4(o[0], va, paB); SBAR();
    v_issue<2, 3>(va, vb); ATT_LGKM(8); SBAR();
    ATT_PV4(o[1], vq, paB); SBAR();
    v_issue<3, 3>(vq, vb); ATT_LGKM(8); SBAR();
    ATT_PV4(o[2], va, paB); SBAR();
    ATT_LGKM(0); SBAR();
    ATT_PV4(o[3], vq, paB); }
  float l_reg = lsum.x + lsum.y;
  { auto rr = __builtin_amdgcn_permlane32_swap(__float_as_uint(l_reg), __float_as_uint(l_reg), false, false); l_reg = __uint_as_float(rr[0]) + __uint_as_float(rr[1]); }
  if (hi == 0) li_l[r32] = l_reg; asm volatile("s_waitcnt lgkmcnt(0)" ::: "memory");
  float rli[16];
#pragma unroll
  for (int r = 0; r < 16; ++r) rli[r] = __builtin_amdgcn_rcpf(li_l[crow(r, hi)]);
  int zo = 0; asm volatile("" : "+v"(zo));
  float* Ow = OS + (wid * QBLK) * 128 + zo;
  if (MODE == 0) {
#pragma unroll
    for (int r = 0; r < 16; ++r) { const int orow = crow(r, hi);
#pragma unroll
      for (int d0 = 0; d0 < 4; ++d0) Ow[orow * 128 + d0 * 32 + r32] = o[d0][r] * rli[r]; }
  } else {
    float sg[4];
#pragma unroll
    for (int d0 = 0; d0 < 4; ++d0) sg[d0] = subg[d0 * 32 + r32] * osc;
    bf16_t* Aw = AOb + (long)(wid * QBLK) * 2048 + zo;
#pragma unroll
    for (int r = 0; r < 16; ++r) { const int orow = crow(r, hi); float d[4]; float ss = 0.f;
#pragma unroll
      for (int d0 = 0; d0 < 4; ++d0) { d[d0] = __hip_atomic_load(&Ow[orow * 128 + d0 * 32 + r32], __ATOMIC_RELAXED, __HIP_MEMORY_SCOPE_AGENT) - lam * (o[d0][r] * rli[r]); ss += d[d0] * d[d0]; }
      { const int l4 = lane << 2;
#pragma unroll
        for (int k = 1; k < 32; k <<= 1) ss += __uint_as_float((unsigned)__builtin_amdgcn_ds_bpermute(l4 ^ (k << 2), (int)__float_as_uint(ss))); }
      const float rs = __builtin_amdgcn_rsqf(ss * (1.f / 128.f) + EPS);
#pragma unroll
      for (int d0 = 0; d0 < 4; ++d0) Aw[(long)orow * 2048 + d0 * 32 + r32] = (bf16_t)(cvtpk(d[d0] * rs * sg[d0], 0.f) & 0xffffu); }
  }
  asm volatile("s_waitcnt vmcnt(0)" ::: "memory");
  __syncthreads();
#undef KROW
#undef GLDS
#undef KDMA
#undef VDMA
#undef SEGEND
}
}

#define GAS __attribute__((address_space(1)))
#define LAS __attribute__((address_space(3)))
typedef unsigned short bf16;
typedef unsigned v4u __attribute__((ext_vector_type(4)));
typedef float f32x4 __attribute__((ext_vector_type(4)));
typedef short bf16x8 __attribute__((ext_vector_type(8)));
typedef GAS unsigned gu32;
typedef GAS unsigned long long gu64;
#define RLX_AGENT __ATOMIC_RELAXED, __HIP_MEMORY_SCOPE_AGENT
#define LDS_WAIT() asm volatile("s_waitcnt lgkmcnt(0)" ::: "memory")
#define VM_WAIT() asm volatile("s_waitcnt vmcnt(0)" ::: "memory")
__device__ __forceinline__ unsigned long long rt() { return __builtin_amdgcn_s_memrealtime(); }
__device__ __forceinline__ unsigned f2bf(float f) { unsigned u = __builtin_bit_cast(unsigned, f); return (u + 0x7fffu + ((u >> 16) & 1u)) >> 16; }
__device__ __forceinline__ unsigned pk2(float lo, float hi) { return f2bf(lo) | (f2bf(hi) << 16); }

#define XB_TMO      128
#define XB_XCNT(j)  (256  + 64 * (j))
#define XB_XSUB(j)  (1280 + 64 * (j))
#define XB_XGEN(j)  (2304 + 64 * (j))
#define XB_TOP      3328
#define XB_TOPGEN   3392
#define XCD_BAR_WORDS 3456
#define XB_SPIN_CAP (1u << 18)

__device__ __forceinline__ unsigned xb_ld(unsigned* p)              { return __hip_atomic_load(p, __ATOMIC_RELAXED, __HIP_MEMORY_SCOPE_AGENT); }
__device__ __forceinline__ unsigned xb_add(unsigned* p, unsigned v) { return __hip_atomic_fetch_add(p, v, __ATOMIC_RELAXED, __HIP_MEMORY_SCOPE_AGENT); }
__device__ __forceinline__ unsigned xb_xcc_id() { return (unsigned)__builtin_amdgcn_s_getreg((3 << 11) | 20) & 0xFu; }
#define XB_SPIN(cond, bar) do { unsigned _sp = 0; while (cond) { __builtin_amdgcn_s_sleep(1); \
    if ((++_sp & 255u) == 0u) { if (xb_ld(&(bar)[XB_TMO])) break; if (_sp > XB_SPIN_CAP) { atomicAdd(&(bar)[XB_TMO], 1u); break; } } } } while (0)

struct XcdBarrier {
    unsigned* bar; unsigned x;
    volatile LAS unsigned* st;
};

__device__ __forceinline__ XcdBarrier xcd_barrier_post(unsigned* bar, volatile LAS unsigned* st) {
    XcdBarrier b; b.bar = bar; b.x = xb_xcc_id(); b.st = st;
    if (threadIdx.x == 0) (void)xb_add(&bar[XB_XCNT(b.x)], 1u);
    return b;
}
__device__ __forceinline__ void xcd_barrier_complete(unsigned* bar, unsigned x, unsigned& nloc, unsigned& nx) {
    const unsigned G = gridDim.x * gridDim.y * gridDim.z;
    unsigned sum, cnt, mine, sp = 0u;
    for (;;) {
        sum = 0u; cnt = 0u; mine = 0u;
#pragma unroll
        for (unsigned j = 0; j < 16; ++j) { const unsigned c = xb_ld(&bar[XB_XCNT(j)]); sum += c; cnt += (c > 0u) ? 1u : 0u; mine = (j == x) ? c : mine; }
        if (sum == G) break;
        __builtin_amdgcn_s_sleep(1);
        if ((++sp & 255u) == 0u) { if (xb_ld(&bar[XB_TMO])) break; if (sp > XB_SPIN_CAP) { atomicAdd(&bar[XB_TMO], 1u); break; } }
    }
    nloc = mine > 0u ? mine : 1u; nx = cnt > 0u ? cnt : 1u;
}

__device__ __forceinline__ void xcd_barrier(const XcdBarrier& b) {
    asm volatile("s_waitcnt vmcnt(0)" ::: "memory");
    __syncthreads();
    if (threadIdx.x == 0) {
        unsigned* bar = b.bar;
        __builtin_amdgcn_s_waitcnt(0);
        unsigned nloc = b.st[0], nx = b.st[1];
        if (nloc == 0u) { xcd_barrier_complete(bar, b.x, nloc, nx); b.st[0] = nloc; b.st[1] = nx; }
        const unsigned old = xb_add(&bar[XB_XSUB(b.x)], 1u);
        const unsigned gen = old / nloc;
        if (old + 1u == (gen + 1u) * nloc) {
            __builtin_amdgcn_fence(__ATOMIC_RELEASE, "agent");
            asm volatile("s_waitcnt vmcnt(0)" ::: "memory");
            const unsigned og = xb_add(&bar[XB_TOP], 1u);
            const unsigned tg = og / nx;
            if (og + 1u == (tg + 1u) * nx) xb_add(&bar[XB_TOPGEN], 1u);
            else XB_SPIN(xb_ld(&bar[XB_TOPGEN]) == tg, bar);
            __builtin_amdgcn_fence(__ATOMIC_ACQUIRE, "agent");
            xb_add(&bar[XB_XGEN(b.x)], 1u);
            asm volatile("s_waitcnt vmcnt(0)" ::: "memory");
        } else {
            XB_SPIN(xb_ld(&bar[XB_XGEN(b.x)]) == gen, bar);
            __builtin_amdgcn_fence(__ATOMIC_ACQUIRE, "agent");
            asm volatile("s_waitcnt vmcnt(0)" ::: "memory");
        }
    }
    __syncthreads();
}
constexpr size_t MiB = 1u << 20;
constexpr size_t WS_CTL = 0, CTL_ZERO_BYTES = 1 * MiB;
constexpr size_t WS_MOD = 1 * MiB;
constexpr size_t WS_ROPE = 2 * MiB;
constexpr size_t WS_WSP = 4 * MiB;
constexpr size_t WS_HC = 5 * MiB;
constexpr size_t WS_RST = 13 * MiB;
constexpr size_t WS_W = 16 * MiB;
constexpr size_t W_IN = 0, W_BR = W_IN + (size_t)IN_DIM * DM * 2, W_O = W_BR + (size_t)3 * DM * 2048 * 2, W_GU = W_O + (size_t)DM * DM * 2, W_D = W_GU + (size_t)2 * FF * DM * 2,
                 W_LAYER = W_D + (size_t)DM * FF * 2;
constexpr size_t WS_Z = WS_W + 2 * W_LAYER;
constexpr size_t WS_ACT = WS_Z + (size_t)MT * IN_DIM * 2;
constexpr size_t WS_XB = WS_ACT + (size_t)MT * DM * 2;
constexpr size_t WS_O12 = WS_XB + (size_t)3 * MT * 2048 * 2;
constexpr size_t WS_QK = WS_O12 + (size_t)MT * DM * 4;
constexpr size_t WS_OS = WS_QK + (size_t)MT * DM * 2;
constexpr int MAX_GRID = 320;
constexpr size_t WS_KVF = WS_OS + (size_t)MAX_GRID * 256 * 128 * 4;
constexpr size_t WS_SLAB = WS_KVF + (size_t)8 * MC * 4096 * 4;
constexpr size_t WS_END = WS_SLAB + (size_t)8 * MC * DM * 4;
static_assert(W_LAYER % 256 == 0 && WS_Z % 256 == 0 && WS_ACT % 256 == 0 && WS_XB % 256 == 0 && WS_O12 % 256 == 0 && WS_QK % 256 == 0 && WS_OS % 256 == 0, "alignment");
constexpr int CW_BAR = 4096;

constexpr int NWAVES = 8;
constexpr int RING_BYTES = 131072, MISC_OFF = RING_BYTES + 320, LDS_BYTES = 147456;
static_assert(true, "");
constexpr int PPL = 9, N_PHASES = 1 + PPL * DEPTH;

__device__ __forceinline__ float sx(float v, int k, int lane) { return __uint_as_float((unsigned)__builtin_amdgcn_ds_bpermute((lane ^ k) << 2, (int)__float_as_uint(v))); }
__device__ __forceinline__ float wave_sum(float v, int lane) {
#pragma unroll
    for (int o = 1; o < 64; o <<= 1) v += sx(v, o, lane);
    return v;
}
__device__ __forceinline__ unsigned pkbf(float lo, float hi) { unsigned r; asm volatile("v_cvt_pk_bf16_f32 %0, %1, %2" : "=v"(r) : "v"(lo), "v"(hi)); return r; }
__device__ __forceinline__ float blo(unsigned w) { return __uint_as_float(w << 16); }
__device__ __forceinline__ float bhi(unsigned w) { return __uint_as_float(w & 0xffff0000u); }
__device__ __forceinline__ void unpack8(const v4u w, float (&x)[8]) { x[0] = blo(w.x); x[1] = bhi(w.x); x[2] = blo(w.y); x[3] = bhi(w.y); x[4] = blo(w.z); x[5] = bhi(w.z); x[6] = blo(w.w); x[7] = bhi(w.w); }
__device__ __forceinline__ v4u pack8(const float (&x)[8]) { v4u w; w.x = pkbf(x[0], x[1]); w.y = pkbf(x[2], x[3]); w.z = pkbf(x[4], x[5]); w.w = pkbf(x[6], x[7]); return w; }

struct Args { const float* in[25]; float* out; unsigned char* ws; int ph_lo, ph_hi, bar_region, pad; };
struct Ctx {
    LAS unsigned char* lds; int tid, lane, wave, vcu, G;
    float* out; unsigned char* ws; int bx;
};
__device__ __forceinline__ Ctx launder(const Ctx& F) {
    Ctx P = F; int t = F.tid; asm volatile("" : "+v"(t)); P.tid = t; P.lane = t & 63; P.wave = __builtin_amdgcn_readfirstlane(t >> 6);
    asm volatile("" : "+s"(P.vcu), "+s"(P.G), "+s"(P.bx)); unsigned long long z = 0; asm volatile("" : "+s"(z)); P.ws = F.ws + z; P.out = F.out + z;
    return P;
}


__device__ __forceinline__ void transpose_item(const float* W, int K, int N, bf16* WT, int k0, int n0, int drow0, LAS float* scr, int lane) {
    float tv[32];
#pragma unroll
    for (int i = 0; i < 32; ++i) { const int kk = 2 * i + (lane >> 5); tv[i] = W[(size_t)(k0 + kk) * N + n0 + (lane & 31)]; }
#pragma unroll
    for (int i = 0; i < 32; ++i) { const int kk = 2 * i + (lane >> 5); scr[kk * 33 + (lane & 31)] = tv[i]; }
    LDS_WAIT(); asm volatile("" ::: "memory");
    const int c = lane & 7;
#pragma unroll
    for (int j = 0; j < 4; ++j) { const int n = (lane >> 3) + 8 * j; const LAS float* s = scr + (8 * c) * 33 + n;
        v4u o; o.x = pkbf(s[0 * 33], s[1 * 33]); o.y = pkbf(s[2 * 33], s[3 * 33]); o.z = pkbf(s[4 * 33], s[5 * 33]); o.w = pkbf(s[6 * 33], s[7 * 33]);
        *(GAS v4u*)(WT + (size_t)(drow0 + n) * K + k0 + 8 * c) = o; }
    LDS_WAIT(); asm volatile("" ::: "memory");
}
template <int MODE> __device__ __forceinline__ void transpose_mat(const float* W, int K, int N, bf16* WT, LAS float* scr, int item, int lane) {
    const int nblk = N / 32, kb = item / nblk, nb = item % nblk, n0 = 32 * nb;
    const int drow0 = MODE == 0 ? n0 : ((n0 >> 7) * 256 + (n0 & 127) + (MODE == 2 ? 128 : 0));
    transpose_item(W, K, N, WT, 64 * kb, n0, drow0, scr, lane);
}

__device__ __forceinline__ void sincos_f(float a, float& s, float& c) {
    const double ad = (double)a; const double kq = __builtin_rint(ad * 0.63661977236758134308); const double r = ad - kq * 1.57079632679489661923; const double r2 = r * r;
    const double sp = r * (1.0 + r2 * (-1.0 / 6 + r2 * (1.0 / 120 + r2 * (-1.0 / 5040 + r2 * (1.0 / 362880 + r2 * (-1.0 / 39916800))))));
    const double cp = 1.0 + r2 * (-0.5 + r2 * (1.0 / 24 + r2 * (-1.0 / 720 + r2 * (1.0 / 40320 + r2 * (-1.0 / 3628800 + r2 * (1.0 / 479001600))))));
    const int q = ((int)kq) & 3;
    const double ss = (q == 0) ? sp : (q == 1) ? cp : (q == 2) ? -sp : -cp;
    const double cc = (q == 0) ? cp : (q == 1) ? -sp : (q == 2) ? -cp : sp;
    s = (float)ss; c = (float)cc;
}

__device__ __forceinline__ void p0_prologue(const Args& A, const Ctx& F) {
    const float* c = A.in[1]; const float* c_ctx = A.in[3]; const float* ada_w = A.in[4]; const float* ada_b = A.in[5];
    const float* norm_mix_g = A.in[6]; const float* norm_ffn_g = A.in[7];
    float* MOD = (float*)(F.ws + WS_MOD);
    LAS float* sv = (LAS float*)F.lds; LAS float* red = (LAS float*)(F.lds + 49152);
    for (int i = F.tid; i < 3 * DM; i += NWAVES * 64) { const int v = i >> 12, k = i & (DM - 1); const float x = v < 2 ? c[v * DM + k] : c_ctx[k]; sv[i] = x / (1.f + __expf(-x)); }
    __syncthreads();
    for (int ch = F.vcu; ch < 256; ch += F.G) {
        const int gcol = ch * 192, l = gcol / NMOD, j0 = gcol % NMOD;
        f32x4 a0 = {0.f, 0.f, 0.f, 0.f}, a1 = a0, a2 = a0;
        if (F.lane < 48) {
            const float* wp = ada_w + (size_t)l * DM * NMOD + (size_t)(F.wave * 512) * NMOD + j0 + F.lane * 4;
            const LAS float* s0 = sv + F.wave * 512;
#pragma unroll 8
            for (int k = 0; k < 512; ++k) { const f32x4 w = *(const f32x4*)(wp + (size_t)k * NMOD); a0 += w * s0[k]; a1 += w * s0[DM + k]; a2 += w * s0[2 * DM + k]; }
            *(LAS f32x4*)(red + (F.wave * 3 + 0) * 192 + F.lane * 4) = a0; *(LAS f32x4*)(red + (F.wave * 3 + 1) * 192 + F.lane * 4) = a1; *(LAS f32x4*)(red + (F.wave * 3 + 2) * 192 + F.lane * 4) = a2;
        }
        __syncthreads();
        for (int o = F.tid; o < 3 * 192; o += NWAVES * 64) { const int v = o / 192, jj = o % 192; float s = 0.f;
#pragma unroll
            for (int w = 0; w < 8; ++w) s += red[(w * 3 + v) * 192 + jj];
            const int j = j0 + jj, q = j >> 12, col = j & (DM - 1); float val = s + ada_b[l * NMOD + j];
            if (q == 1) val = norm_mix_g[l * DM + col] * (1.f + val); else if (q == 4) val = norm_ffn_g[l * DM + col] * (1.f + val);
            MOD[(size_t)(l * 3 + v) * NMOD + j] = val; }
        __syncthreads();
    }
    const int gtid = F.vcu * (NWAVES * 64) + F.tid, NTH = F.G * NWAVES * 64;
    { float* ROPE = (float*)(F.ws + WS_ROPE);
      for (int e = gtid; e < SEQ * 32; e += NTH) { const int t = e >> 5, j = e & 31; const int pos = j < 16 ? (t >> 6) : (t & 63);
          const float inv = exp2f(-(float)(j & 15) * (13.287712379549449f / 16.f)); float s, cs; sincos_f((float)pos * inv, s, cs); ROPE[2 * e] = cs; ROPE[2 * e + 1] = s; } }
    { const float* wsp = A.in[18]; bf16* o = (bf16*)(F.ws + WS_WSP);
      for (int e = gtid; e < DEPTH * 16 * 128 * 128 / 2; e += NTH) ((unsigned*)o)[e] = pkbf(wsp[2 * e], wsp[2 * e + 1]); }
    LAS float* scr = (LAS float*)(F.lds + F.wave * 16384);
    const int gw = F.vcu * NWAVES + F.wave, NGW = F.G * NWAVES;
    constexpr int I_IN = (DM / 64) * (IN_DIM / 32), I_BR = (2048 / 64) * (DM / 32), I_O = (DM / 64) * (DM / 32), I_GU = (DM / 64) * (FF / 32), I_D = (FF / 64) * (DM / 32);
    constexpr int I_LAYER = I_IN + 3 * I_BR + I_O + 2 * I_GU + I_D;
    for (int it = gw; it < DEPTH * I_LAYER; it += NGW) {
        const int l = it / I_LAYER; int r = it - l * I_LAYER; unsigned char* wl = F.ws + WS_W + (size_t)l * W_LAYER;
        if (r < I_IN) { transpose_mat<0>(A.in[8] + (size_t)l * DM * IN_DIM, DM, IN_DIM, (bf16*)(wl + W_IN), scr, r, F.lane); continue; } r -= I_IN;
        if (r < I_BR) { transpose_mat<0>(A.in[11] + (size_t)l * 2048 * DM, 2048, DM, (bf16*)(wl + W_BR), scr, r, F.lane); continue; } r -= I_BR;
        if (r < I_BR) { transpose_mat<0>(A.in[16] + (size_t)l * 2048 * DM, 2048, DM, (bf16*)(wl + W_BR) + (size_t)DM * 2048, scr, r, F.lane); continue; } r -= I_BR;
        if (r < I_BR) { transpose_mat<0>(A.in[20] + (size_t)l * 2048 * DM, 2048, DM, (bf16*)(wl + W_BR) + (size_t)2 * DM * 2048, scr, r, F.lane); continue; } r -= I_BR;
        if (r < I_O) { transpose_mat<0>(A.in[21] + (size_t)l * DM * DM, DM, DM, (bf16*)(wl + W_O), scr, r, F.lane); continue; } r -= I_O;
        if (r < I_GU) { transpose_mat<1>(A.in[22] + (size_t)l * DM * FF, DM, FF, (bf16*)(wl + W_GU), scr, r, F.lane); continue; } r -= I_GU;
        if (r < I_GU) { transpose_mat<2>(A.in[23] + (size_t)l * DM * FF, DM, FF, (bf16*)(wl + W_GU), scr, r, F.lane); continue; } r -= I_GU;
        transpose_mat<0>(A.in[24] + (size_t)l * FF * DM, FF, DM, (bf16*)(wl + W_D), scr, r, F.lane);
    }
}

__device__ __forceinline__ void norm_phase(const Ctx& F, int l, int which, const float* src_lat, const float* src_ctx, int nrows, bool slab_add, bool write_hc) {
    const float* MOD = (const float*)(F.ws + WS_MOD); bf16* XN = (bf16*)(F.ws + WS_ACT);
    const int gw = F.vcu * NWAVES + F.wave, NGW = F.G * NWAVES;
    for (int m = gw; m < nrows; m += NGW) {
        const float* xr = m < ML ? src_lat + (size_t)m * DM : src_ctx + (size_t)(m - ML) * DM;
        const int cls = m < SEQ ? 0 : (m < ML ? 1 : 2);
        const float* sh = MOD + (size_t)(l * 3 + cls) * NMOD + (which ? 3 : 0) * DM; const float* gs = sh + DM;
        f32x4 v[16], gg[16], sg[16]; float ss = 0.f;
#pragma unroll
        for (int j = 0; j < 16; ++j) v[j] = *(const f32x4*)(xr + 4 * F.lane + 256 * j);

        if (slab_add && m >= ML) {
            const float* sl = (const float*)(F.ws + WS_SLAB) + (size_t)(m - ML) * DM + 4 * F.lane;
#pragma clang loop unroll(disable)
            for (int s = 0; s < 8; s += 2) {
                f32x4 ta[16], tb[16];
#pragma unroll
                for (int j = 0; j < 16; ++j) { ta[j] = *(const f32x4*)(sl + (size_t)s * MC * DM + 256 * j); tb[j] = *(const f32x4*)(sl + (size_t)(s + 1) * MC * DM + 256 * j); }
                __builtin_amdgcn_sched_barrier(0);
#pragma unroll
                for (int j = 0; j < 16; ++j) v[j] += ta[j] + tb[j];
                __builtin_amdgcn_sched_barrier(0);
            }
            if (write_hc) { float* hc = (float*)(F.ws + WS_HC) + (size_t)(m - ML) * DM + 4 * F.lane;
#pragma unroll
                for (int j = 0; j < 16; ++j) *(f32x4*)(hc + 256 * j) = v[j]; }
        }
#pragma unroll
        for (int j = 0; j < 16; ++j) { gg[j] = *(const f32x4*)(gs + 4 * F.lane + 256 * j); sg[j] = *(const f32x4*)(sh + 4 * F.lane + 256 * j); }
#pragma unroll
        for (int j = 0; j < 16; ++j) ss += (v[j].x * v[j].x + v[j].y * v[j].y) + (v[j].z * v[j].z + v[j].w * v[j].w);
        const float rstd = __builtin_amdgcn_rsqf(wave_sum(ss, F.lane) * (1.f / DM) + EPS);
        unsigned long long* o8 = (unsigned long long*)(XN + (size_t)m * DM) + F.lane;
#pragma unroll
        for (int j = 0; j < 16; ++j) { const f32x4 g = gg[j], s = sg[j];
            const f32x4 y = v[j] * rstd * g + s;
            o8[64 * j] = (unsigned long long)pkbf(y.x, y.y) | ((unsigned long long)pkbf(y.z, y.w) << 32); }
    }
}

__device__ __forceinline__ void qk_phase(const Args& A, const Ctx& F, int l, int nrows_stat, bool kvf_ctx) {
    typedef unsigned u32x2 __attribute__((ext_vector_type(2)));
    const bf16* Z = (const bf16*)(F.ws + WS_Z); bf16* QK = (bf16*)(F.ws + WS_QK); const float* ROPE = (const float*)(F.ws + WS_ROPE); float* RST = (float*)(F.ws + WS_RST);
    const float* KVF = (const float*)(F.ws + WS_KVF); bf16* Zw = (bf16*)(F.ws + WS_Z);
    const int gw = F.vcu * NWAVES + F.wave, NGW = F.G * NWAVES, p = F.lane & 7, go = (F.lane >> 3) * 64 + 4 * p;
    constexpr float QC = 0.125f * 1.4426950408889634f;
    const f32x4 gq0 = *(const f32x4*)(A.in[12] + l * 64 + 4 * p) * QC, gq1 = *(const f32x4*)(A.in[12] + l * 64 + 32 + 4 * p) * QC;
    const f32x4 gk0 = *(const f32x4*)(A.in[13] + l * 64 + 4 * p), gk1 = *(const f32x4*)(A.in[13] + l * 64 + 32 + 4 * p);
    for (int m = gw; m < MT; m += NGW) {
        const bf16* zr = Z + (size_t)m * IN_DIM + ZC_Q + go; bf16* qr = QK + (size_t)m * DM + go; const bool lat = m < ML; const int t = m & (SEQ - 1);
        f32x4 cs = {1.f, 1.f, 1.f, 1.f}, sn = {0.f, 0.f, 0.f, 0.f};
        if (lat) { const float* rp = ROPE + ((size_t)t * 32 + 4 * p) * 2; const f32x4 w0 = *(const f32x4*)rp, w1 = *(const f32x4*)(rp + 4); cs = (f32x4){w0.x, w0.z, w1.x, w1.z}; sn = (f32x4){w0.y, w0.w, w1.y, w1.w}; }
        if (m < nrows_stat) {
            const bf16* vr = Z + (size_t)m * IN_DIM + ZC_VM; float ss = 0.f;
#pragma unroll
            for (int i = 0; i < 4; ++i) { float x[8]; unpack8(*(const v4u*)(vr + i * 512 + F.lane * 8), x);
#pragma unroll
                for (int e = 0; e < 8; ++e) ss += x[e] * x[e]; }
            ss = wave_sum(ss, F.lane); if (F.lane == 0) RST[m] = __builtin_amdgcn_rsqf(ss * (1.f / 2048.f) + EPS); }
        const bool fromf = kvf_ctx && !lat;
        if (fromf) {
            const float* vr = KVF + (size_t)(m - ML) * 4096 + 2048; bf16* vo = Zw + (size_t)m * IN_DIM + ZC_V;
#pragma unroll
            for (int i = 0; i < 4; ++i) { f32x4 ta[8], tb[8];
#pragma unroll
                for (int s = 0; s < 8; ++s) { ta[s] = *(const f32x4*)(vr + (size_t)s * MC * 4096 + i * 512 + F.lane * 8); tb[s] = *(const f32x4*)(vr + (size_t)s * MC * 4096 + i * 512 + F.lane * 8 + 4); }
                __builtin_amdgcn_sched_barrier(0);
                const f32x4 a = ((ta[0] + ta[1]) + (ta[2] + ta[3])) + ((ta[4] + ta[5]) + (ta[6] + ta[7])), b = ((tb[0] + tb[1]) + (tb[2] + tb[3])) + ((tb[4] + tb[5]) + (tb[6] + tb[7]));
                v4u w; w.x = pkbf(a.x, a.y); w.y = pkbf(a.z, a.w); w.z = pkbf(b.x, b.y); w.w = pkbf(b.z, b.w); *(v4u*)(vo + i * 512 + F.lane * 8) = w; }
        }
        u32x2 wa[8], wb[8];
        if (!fromf) {
#pragma unroll
            for (int i = 0; i < 8; ++i) { wa[i] = *(const u32x2*)(zr + i * 512); wb[i] = *(const u32x2*)(zr + i * 512 + 32); }
        }
        __builtin_amdgcn_sched_barrier(0);
#pragma unroll
        for (int i = 0; i < 8; ++i) {
            f32x4 x1, x2;
            if (fromf) { if (i < 4) continue; const float* kr = KVF + (size_t)(m - ML) * 4096 + (i - 4) * 512 + go; f32x4 ta[8], tb[8];
#pragma unroll
                for (int s = 0; s < 8; ++s) { ta[s] = *(const f32x4*)(kr + (size_t)s * MC * 4096); tb[s] = *(const f32x4*)(kr + (size_t)s * MC * 4096 + 32); }
                __builtin_amdgcn_sched_barrier(0);
                x1 = ((ta[0] + ta[1]) + (ta[2] + ta[3])) + ((ta[4] + ta[5]) + (ta[6] + ta[7])); x2 = ((tb[0] + tb[1]) + (tb[2] + tb[3])) + ((tb[4] + tb[5]) + (tb[6] + tb[7])); }
            else { const u32x2 w0 = wa[i], w1 = wb[i];
                x1 = (f32x4){blo(w0.x), bhi(w0.x), blo(w0.y), bhi(w0.y)}; x2 = (f32x4){blo(w1.x), bhi(w1.x), blo(w1.y), bhi(w1.y)}; }
            float ss = (x1.x * x1.x + x1.y * x1.y) + (x1.z * x1.z + x1.w * x1.w) + (x2.x * x2.x + x2.y * x2.y) + (x2.z * x2.z + x2.w * x2.w);
            ss += sx(ss, 1, F.lane); ss += sx(ss, 2, F.lane); ss += sx(ss, 4, F.lane);
            const float r = __builtin_amdgcn_rsqf(ss * (1.f / 64.f) + EPS);
            x1 = x1 * r * (i < 4 ? gq0 : gk0); x2 = x2 * r * (i < 4 ? gq1 : gk1);
            const f32x4 y1 = x1 * cs - x2 * sn, y2 = x2 * cs + x1 * sn;
            u32x2 o0, o1; o0.x = pkbf(y1.x, y1.y); o0.y = pkbf(y1.z, y1.w); o1.x = pkbf(y2.x, y2.y); o1.y = pkbf(y2.z, y2.w);
            *(u32x2*)(qr + i * 512) = o0; *(u32x2*)(qr + i * 512 + 32) = o1;
        }
    }
}

__device__ __forceinline__ void conv_phase(const Args& A, const Ctx& F, int l, int nrows) {
    const bf16* Z = (const bf16*)(F.ws + WS_Z); bf16* CV = (bf16*)(F.ws + WS_XB);
    const float* cw = A.in[9] + (size_t)l * 3 * 2048; const float* cb = A.in[10] + (size_t)l * 2048;
    const int gtid = F.vcu * (NWAVES * 64) + F.tid, NTH = F.G * NWAVES * 64;
    for (int it = gtid; it < (nrows / 2) * 256; it += NTH) {
        const int m = 2 * (it >> 8), c = (it & 255) * 8;
        const int t = m < ML ? (m & (SEQ - 1)) : ((m - ML) & (CTXL - 1)), T = m < ML ? SEQ : CTXL;
        const bf16* zr = Z + (size_t)m * IN_DIM + c;
        const bool hp = t > 0, hn = t + 2 < T;
        const v4u zero = {0u, 0u, 0u, 0u};
        const v4u bgA = *(const v4u*)(zr + ZC_BG), bgB = *(const v4u*)(zr + IN_DIM + ZC_BG);
        const v4u c0 = *(const v4u*)(zr + ZC_CG), x0 = *(const v4u*)(zr + ZC_XIN), c1 = *(const v4u*)(zr + IN_DIM + ZC_CG), x1 = *(const v4u*)(zr + IN_DIM + ZC_XIN);
        const v4u cp = hp ? *(const v4u*)(zr - IN_DIM + ZC_CG) : zero, xp = hp ? *(const v4u*)(zr - IN_DIM + ZC_XIN) : zero;
        const v4u cn = hn ? *(const v4u*)(zr + 2 * IN_DIM + ZC_CG) : zero, xn = hn ? *(const v4u*)(zr + 2 * IN_DIM + ZC_XIN) : zero;
        const f32x4 w00 = *(const f32x4*)(cw + c), w01 = *(const f32x4*)(cw + c + 4), w10 = *(const f32x4*)(cw + 2048 + c), w11 = *(const f32x4*)(cw + 2048 + c + 4);
        const f32x4 w20 = *(const f32x4*)(cw + 4096 + c), w21 = *(const f32x4*)(cw + 4096 + c + 4), b0 = *(const f32x4*)(cb + c), b1 = *(const f32x4*)(cb + c + 4);
        float a[8], b[8], zp[8], z0[8], z1[8], zn[8], gA[8], gB[8];
        unpack8(cp, a); unpack8(xp, b);
#pragma unroll
        for (int e = 0; e < 8; ++e) zp[e] = a[e] * b[e];
        unpack8(c0, a); unpack8(x0, b);
#pragma unroll
        for (int e = 0; e < 8; ++e) z0[e] = a[e] * b[e];
        unpack8(c1, a); unpack8(x1, b);
#pragma unroll
        for (int e = 0; e < 8; ++e) z1[e] = a[e] * b[e];
        unpack8(cn, a); unpack8(xn, b);
#pragma unroll
        for (int e = 0; e < 8; ++e) zn[e] = a[e] * b[e];
        unpack8(bgA, gA); unpack8(bgB, gB);
        float yA[8], yB[8];
#pragma unroll
        for (int e = 0; e < 4; ++e) {
            yA[e] = gA[e] * (zp[e] * w00[e] + z0[e] * w10[e] + z1[e] * w20[e] + b0[e]); yA[4 + e] = gA[4 + e] * (zp[4 + e] * w01[e] + z0[4 + e] * w11[e] + z1[4 + e] * w21[e] + b1[e]);
            yB[e] = gB[e] * (z0[e] * w00[e] + z1[e] * w10[e] + zn[e] * w20[e] + b0[e]); yB[4 + e] = gB[4 + e] * (z0[4 + e] * w01[e] + z1[4 + e] * w11[e] + zn[4 + e] * w21[e] + b1[e]); }
        *(v4u*)(CV + (size_t)m * 2048 + c) = pack8(yA); *(v4u*)(CV + (size_t)(m + 1) * 2048 + c) = pack8(yB);
    }
}

__device__ __forceinline__ void mlp_unit(const Args& A, const Ctx& F, int l, int chunk, int g) {
    const bf16* Z = (const bf16*)(F.ws + WS_Z); bf16* MO = (bf16*)(F.ws + WS_XB) + (size_t)2 * MT * 2048; const float* RST = (const float*)(F.ws + WS_RST);
    const bf16* WSP = (const bf16*)(F.ws + WS_WSP) + ((size_t)l * 16 + g) * 128 * 128;
    const float* gnorm = A.in[17] + (size_t)l * 2048 + g * 128; const float* bsp = A.in[19] + ((size_t)l * 16 + g) * 128;
    LAS unsigned char* Vl = F.lds;
    const int r32 = F.lane & 31, hi = F.lane >> 5, rb = F.wave & 3, ch = F.wave >> 2, sr = F.tid >> 4, sc = (F.tid & 15) * 8, row0 = chunk * 128;
    att::bf16x8 pa[2][4];
#pragma unroll
    for (int kt = 0; kt < 2; ++kt)
#pragma unroll
        for (int s = 0; s < 4; ++s) pa[kt][s] = *(const att::bf16x8*)(WSP + (size_t)(32 * rb + r32) * 128 + 64 * kt + 16 * s + 8 * hi);
    const f32x4 gn0 = *(const f32x4*)(gnorm + sc), gn1 = *(const f32x4*)(gnorm + sc + 4);
#pragma unroll
    for (int i = 0; i < 4; ++i) { const int q = sr + 32 * i; float x[8]; unpack8(*(const v4u*)(Z + (size_t)(row0 + q) * IN_DIM + ZC_VM + g * 128 + sc), x);
        const float r = RST[row0 + q];
#pragma unroll
        for (int e = 0; e < 4; ++e) { x[e] = x[e] * r * gn0[e]; x[4 + e] = x[4 + e] * r * gn1[e]; }
        *(LAS v4u*)(Vl + (q >> 6) * 16384 + att::v_st(q & 63, sc)) = pack8(x); }
    __syncthreads();
    att::f32x16 acc0 = {}, acc1 = {};
#pragma unroll
    for (int kt = 0; kt < 2; ++kt) { const int vb = (int)(uintptr_t)Vl + kt * 16384 + ch * 1024 + att::v_rd_base(F.lane);
        att::pv_one<0>(acc0, vb, pa[kt][0], pa[kt][1], pa[kt][2], pa[kt][3]); att::pv_one<1>(acc1, vb, pa[kt][0], pa[kt][1], pa[kt][2], pa[kt][3]); }
    float bias[16]; bf16 u0[16], u1[16];
    const int col = g * 128 + ch * 64 + r32;
#pragma unroll
    for (int r = 0; r < 16; ++r) { const int pr = 32 * rb + att::crow(r, hi); const size_t row = (size_t)(row0 + pr);
        bias[r] = bsp[pr]; u0[r] = Z[row * IN_DIM + ZC_U + col]; u1[r] = Z[row * IN_DIM + ZC_U + col + 32]; }
    __builtin_amdgcn_sched_barrier(0);
#pragma unroll
    for (int r = 0; r < 16; ++r) { const int pr = 32 * rb + att::crow(r, hi); const size_t row = (size_t)(row0 + pr);
        const float a0 = __uint_as_float((unsigned)u0[r] << 16), a1 = __uint_as_float((unsigned)u1[r] << 16);
        MO[row * 2048 + col] = (bf16)(pkbf(a0 * (acc0[r] + bias[r]), 0.f) & 0xffffu); MO[row * 2048 + col + 32] = (bf16)(pkbf(a1 * (acc1[r] + bias[r]), 0.f) & 0xffffu); }
    __syncthreads();
}

__device__ __forceinline__ void attn_phase(const Args& A, const Ctx& F, int l, bool with_ctx, float lam_init) {
    static_assert(att::SHM_ATTN <= RING_BYTES, "attention LDS vs frame");
    const int nchunk = (with_ctx ? MT : ML) / 128;
    for (int u = F.vcu; u < nchunk * 16; u += F.G) mlp_unit(A, F, l, u >> 4, u & 15);
    const bf16* Z = (const bf16*)(F.ws + WS_Z); const bf16* QK = (const bf16*)(F.ws + WS_QK); bf16* AO = (bf16*)(F.ws + WS_XB) + (size_t)MT * 2048;
    float* OS = (float*)(F.ws + WS_OS) + (size_t)F.vcu * 256 * 128;
    const float* lq = A.in[14] + (size_t)l * 256;
    const float s01 = wave_sum(lq[F.lane] * lq[64 + F.lane], F.lane), s23 = wave_sum(lq[128 + F.lane] * lq[192 + F.lane], F.lane);
    const float lam = __uint_as_float(__builtin_amdgcn_readfirstlane(__float_as_uint(expf(s01) - expf(s23) + lam_init))), osc = 1.f - lam_init;
    const float* subg = A.in[15] + (size_t)l * 128;
    float gqm = fabsf(A.in[12][l * 64 + F.lane]), gkm = fabsf(A.in[13][l * 64 + F.lane]);
#pragma unroll
    for (int o = 1; o < 64; o <<= 1) { gqm = fmaxf(gqm, sx(gqm, o, F.lane)); gkm = fmaxf(gkm, sx(gkm, o, F.lane)); }
    const float m0c = __uint_as_float(__builtin_amdgcn_readfirstlane(__float_as_uint(0.125f * 64.f * 1.02f * gqm * gkm * 1.4426950408889634f)));
    const int npair = 1024 + (with_ctx ? 32 : 0);
    for (int u = F.vcu; u < npair; u += F.G) {
        const bool isl = u < 1024; const int bh = isl ? (u >> 5) : (u - 1024), b = bh >> 4, h = bh & 15;
        const int qrow = isl ? b * SEQ + (u & 31) * 256 : ML + b * CTXL;
        const int rowa = isl ? b * SEQ : qrow, nt0 = isl ? SEQ / 64 : CTXL / 64, rowb = ML + b * CTXL, NT = isl ? SEQ / 64 + CTXL / 64 : CTXL / 64;
#pragma clang loop unroll(disable)
        for (int mp = 0; mp < 2; ++mp)
            att::attn_unit(mp, QK + (size_t)qrow * DM + h * 128 + mp * 64, QK + 2048 + h * 128 + mp * 64, Z + ZC_V + h * 128, OS, AO + (size_t)qrow * 2048 + h * 128, subg, lam, osc, m0c,
                           rowa, nt0, rowb, NT, (char*)F.lds, F.tid);
    }
}

__global__ void __launch_bounds__(NWAVES * 64, 2) fwd_kernel(Args args) {
    extern __shared__ __attribute__((aligned(16))) unsigned char lds[];
    Ctx F;
    F.lds = (LAS unsigned char*)lds; F.tid = threadIdx.x; F.lane = F.tid & 63; F.wave = __builtin_amdgcn_readfirstlane(F.tid >> 6);
    F.G = gridDim.x; F.bx = blockIdx.x; { const int bx = blockIdx.x; F.vcu = (F.G % 8 == 0) ? (bx % 8) * (F.G / 8) + bx / 8 : bx; }
    F.out = args.out; F.ws = args.ws;
    volatile LAS unsigned* MISC = (volatile LAS unsigned*)(F.lds + MISC_OFF);
    for (int u = F.tid; u < (LDS_BYTES - RING_BYTES) / 4; u += NWAVES * 64) ((LAS unsigned*)(F.lds + RING_BYTES))[u] = 0u;
    __syncthreads();
    const int lo = args.ph_lo, hi = args.ph_hi;
    unsigned* barw = (unsigned*)(F.ws + WS_CTL) + CW_BAR + args.bar_region * XCD_BAR_WORDS;
    XcdBarrier bar; bar.bar = barw; bar.x = 0; bar.st = nullptr;
    if (hi - lo > 1) bar = xcd_barrier_post(barw, MISC + 8);
#ifndef PHM
#define PHM 0xfff
#endif
#define IN(k) (lo <= (k) && (k) < hi)
#ifndef PROBE_BASE
#define PROBE_BASE 0
#endif
#ifdef PROBE_PHASE
#define PT0(k) do { if ((k) == PROBE_PHASE) { pc0 = __builtin_readcyclecounter(); pt0 = __builtin_amdgcn_s_memrealtime(); } } while (0)
#define PT1(k) do { if ((k) == PROBE_PHASE) { pc1 = __builtin_readcyclecounter(); pt1 = __builtin_amdgcn_s_memrealtime(); } } while (0)
#else
#define PT0(k) do {} while (0)
#define PT1(k) do {} while (0)
#endif
#if defined(CLOCK_PROBE) && CLOCK_PROBE == 9
#define SEAM(k) do { if (IN(k) && IN((k) + 1)) { const unsigned long long ta_ = __builtin_amdgcn_s_memrealtime(); xcd_barrier(bar); pwait += __builtin_amdgcn_s_memrealtime() - ta_; } } while (0)
#else
#define SEAM(k) do { if (IN(k) && IN((k) + 1)) xcd_barrier(bar); } while (0)
#endif

#if defined(CLOCK_PROBE) || defined(PROBE_PHASE)
    unsigned long long pc0 = 0, pc1 = 0, pt0 = 0, pt1 = 1, pwait = 0; (void)pwait; (void)pc0; (void)pc1;
#endif
    if ((PHM & 1) && IN(0)) { PT0(0); const Ctx P = launder(F); p0_prologue(args, P); PT1(0); SEAM(0); }

    for (int l = 0; l < DEPTH; ++l) {
        const int pb = 1 + PPL * l; const bool last = l + 1 == DEPTH; const int MR = last ? ML : MT;
#define TK(k) ((unsigned*)(P.ws + WS_CTL) + 131072 + (l * 4 + (k)) * 32)
#define PTRS() bf16* Zb = (bf16*)(P.ws + WS_Z); bf16* ACT = (bf16*)(P.ws + WS_ACT); bf16* XB = (bf16*)(P.ws + WS_XB); float* YF = (float*)(P.ws + WS_O12); float* HC = (float*)(P.ws + WS_HC); \
        bf16* HID = (bf16*)(P.ws + WS_Z); const unsigned char* wl = P.ws + WS_W + (size_t)l * W_LAYER; const float* MODl = (const float*)(P.ws + WS_MOD) + (size_t)l * 3 * NMOD; \
        const float* h_lat = l == 0 ? args.in[0] : P.out; const float* h_ctx = l == 0 ? args.in[2] : HC; \
        (void)Zb; (void)ACT; (void)XB; (void)YF; (void)HC; (void)HID; (void)wl; (void)MODl; (void)h_lat; (void)h_ctx;
        if ((PHM & 2) && IN(pb + 0)) { PT0(pb + 0); const Ctx P = launder(F); PTRS(); norm_phase(P, l, 0, h_lat, h_ctx, MT, l > 0, false); PT1(pb + 0); SEAM(pb + 0); }
        if ((PHM & 4) && IN(pb + 1)) { PT0(pb + 1); const Ctx P = launder(F); PTRS();
            pg8::Gemm g{ACT, (const bf16*)(wl + W_IN), MT, IN_DIM, DM}; pg8::InOrder S; S.init(P.G, P.bx, last); S.S.ticketed(TK(0), P.lds);
            pg8::EpiZ E{Zb, (float*)(P.ws + WS_KVF)};
            pg8::gemm_phase<pg8::EpiZ, pg8::InOrder, true, true>(P.lds, P.tid, g, S, E);
            PT1(pb + 1); SEAM(pb + 1);
        }
        if ((PHM & 8) && IN(pb + 2)) { PT0(pb + 2); { const Ctx P = launder(F); qk_phase(args, P, l, MR, last); } { const Ctx P = launder(F); conv_phase(args, P, l, MR); } PT1(pb + 2); SEAM(pb + 2); }
        if ((PHM & 16) && IN(pb + 3)) { PT0(pb + 3); const Ctx P = launder(F); attn_phase(args, P, l, !last, l == 0 ? 0.2f : 0.35550906759096924f); PT1(pb + 3); SEAM(pb + 3); }
        if ((PHM & 64) && IN(pb + 4)) { PT0(pb + 4); const Ctx P = launder(F); PTRS();
            pg8::Gemm g{XB, (const bf16*)(wl + W_BR), 3 * MT, 3 * DM, 2048}; pg8::BranchOrder S{P.G, P.bx, MR / 256};
            pg8::EpiBr E{Zb, ACT};
            pg8::gemm_phase<pg8::EpiBr, pg8::BranchOrder, true, true>(P.lds, P.tid, g, S, E);
            PT1(pb + 4); SEAM(pb + 4);
        }
        if ((PHM & 128) && IN(pb + 5)) { PT0(pb + 5); const Ctx P = launder(F); PTRS();
            pg8::Gemm g{ACT, (const bf16*)(wl + W_O), MR, DM, DM}; pg8::ResOrder S; S.init(P.G, P.bx, DM, !last); S.S.ticketed(TK(1), P.lds);
            pg8::EpiRes E{h_lat, h_ctx, P.out, HC, MODl + 2 * DM, (float*)(P.ws + WS_SLAB)};
            pg8::gemm_phase<pg8::EpiRes, pg8::ResOrder, true, true>(P.lds, P.tid, g, S, E);
            PT1(pb + 5); SEAM(pb + 5);
        }
        if ((PHM & 256) && IN(pb + 6)) { PT0(pb + 6); const Ctx P = launder(F); PTRS(); norm_phase(P, l, 1, P.out, l == 0 ? args.in[2] : HC, MR, !last, !last); PT1(pb + 6); SEAM(pb + 6); }
        if ((PHM & 512) && IN(pb + 7)) { PT0(pb + 7); const Ctx P = launder(F); PTRS();
            pg8::Gemm g{ACT, (const bf16*)(wl + W_GU), MR, 2 * FF, DM}; pg8::StaticOrder S; S.init(MR, 2 * FF, P.G, P.bx, DM); S.ticketed(TK(2), P.lds);
            pg8::EpiGU E{HID};
            pg8::gemm_phase<pg8::EpiGU, pg8::StaticOrder, true, true>(P.lds, P.tid, g, S, E);
            PT1(pb + 7); SEAM(pb + 7);
        }
        if ((PHM & 1024) && IN(pb + 8)) { PT0(pb + 8); const Ctx P = launder(F); PTRS();
            pg8::Gemm g{HID, (const bf16*)(wl + W_D), MR, DM, FF}; pg8::ResOrder S; S.init(P.G, P.bx, FF, !last); S.S.ticketed(TK(3), P.lds);
            pg8::EpiRes E{P.out, HC, P.out, HC, MODl + 5 * DM, (float*)(P.ws + WS_SLAB)};
            pg8::gemm_phase<pg8::EpiRes, pg8::ResOrder, true, true>(P.lds, P.tid, g, S, E);
            PT1(pb + 8); SEAM(pb + 8);
        }
    }
#if defined(CLOCK_PROBE) || defined(PROBE_PHASE)
    {
        unsigned* pa = (unsigned*)(F.ws + WS_CTL) + 65536;
        if (threadIdx.x == 0) pa[blockIdx.x] = (unsigned)(pt1 - pt0);
        xcd_barrier(bar);
        float val = 0.f;
#ifdef PROBE_PHASE
        if (blockIdx.x == 0 && threadIdx.x == 0) { unsigned mx = 0, mn = 0xffffffffu; unsigned long long sm = 0; int imx = 0;
            for (unsigned b = 0; b < gridDim.x; ++b) { const unsigned v = __hip_atomic_load(pa + b, __ATOMIC_RELAXED, __HIP_MEMORY_SCOPE_AGENT); sm += v; if (v > mx) { mx = v; imx = (int)b; } if (v < mn) mn = v; }
            const float ghz = (float)(pc1 - pc0) / (float)(pt1 - pt0) * 0.1f;
            float xm[8]; unsigned xc[8];
            for (int x = 0; x < 8; ++x) { xm[x] = 0.f; xc[x] = 0; }
            for (unsigned b = 0; b < gridDim.x; ++b) { const unsigned v = __hip_atomic_load(pa + b, __ATOMIC_RELAXED, __HIP_MEMORY_SCOPE_AGENT); xm[b & 7] += (float)v; xc[b & 7]++; }
            float xmax = 0.f, xmin = 1e30f; int ixmax = 0;
            for (int x = 0; x < 8; ++x) { const float m = xm[x] / (float)xc[x]; if (m > xmax) { xmax = m; ixmax = x; } if (m < xmin) xmin = m; }
            if (PROBE_KIND == 9) val = ((float)mx - (float)(sm / gridDim.x)) * 0.01f + 35.f; else if (PROBE_KIND == 8) val = (float)mx * 0.01f - (float)PROBE_BASE; else if (PROBE_KIND == 7) val = 10.f * ((float)mx * 0.001f - (float)PROBE_BASE); else if (PROBE_KIND == 5) val = (xmax - xmin) * 0.01f; else if (PROBE_KIND == 6) val = 40.f + 10.f * (float)ixmax; else
            val = PROBE_KIND == 0 ? (float)mx * 0.001f : PROBE_KIND == 1 ? (float)(mx - mn) * 0.01f : PROBE_KIND == 2 ? (float)(sm / gridDim.x) * 0.001f : PROBE_KIND == 3 ? (float)(imx & 7) * 10.f + 1.f : 100.f * ghz; }
#else
        val = CLOCK_PROBE == 9 ? (float)pwait * 0.001f : 0.f;
#endif
        f32x4* o4 = (f32x4*)F.out; const size_t n4 = (size_t)ML * DM / 4, per = n4 / gridDim.x;
        for (size_t i = (size_t)blockIdx.x * per + threadIdx.x; i < (size_t)(blockIdx.x + 1) * per; i += NWAVES * 64) o4[i] = (f32x4){3000.f, 3000.f, 3000.f, 3000.f};
        __syncthreads();
        if (blockIdx.x == 0 && threadIdx.x == 0) { asm volatile("s_waitcnt vmcnt(0)" ::: "memory"); F.out[0] = 100.f * val; }
    }
#endif
#undef IN
#undef SEAM
}

#ifndef MK_PER_PHASE
#define MK_PER_PHASE 0
#endif
extern "C" void kernel_launch(void* const* d_in, const int* in_sizes, int n_in, void* d_out, int out_size, void* d_ws, size_t ws_size, hipStream_t stream) {
    static int grid = 0;
    if (grid == 0) {
        if (n_in != 25 || in_sizes[0] != ML * DM || out_size != ML * DM || ws_size < WS_END) {
            fprintf(stderr, "kernel_launch: shape mismatch: n_in %d in0 %d out %d ws %zu (need %zu); nothing launched\n", n_in, n_in > 0 ? in_sizes[0] : -1, out_size, ws_size, (size_t)WS_END); grid = -1; return; }
        int dev = 0, cus = 0, per_cu = 0;
        if (hipGetDevice(&dev) != hipSuccess || hipDeviceGetAttribute(&cus, hipDeviceAttributeMultiprocessorCount, dev) != hipSuccess) { grid = -1; return; }
        if (hipFuncSetAttribute((const void*)fwd_kernel, hipFuncAttributeMaxDynamicSharedMemorySize, LDS_BYTES) != hipSuccess) { fprintf(stderr, "kernel_launch: hipFuncSetAttribute failed\n"); grid = -1; return; }
        if (hipOccupancyMaxActiveBlocksPerMultiprocessor(&per_cu, (const void*)fwd_kernel, NWAVES * 64, LDS_BYTES) != hipSuccess || per_cu < 1)
            fprintf(stderr, "kernel_launch: note: occupancy query reports %d workgroups per CU\n", per_cu);
        (void)hipGetLastError();
        grid = cus > MAX_GRID ? MAX_GRID : cus;
    }
    if (grid < 0) return;
    if (hipMemsetAsync((char*)d_ws + WS_CTL, 0, CTL_ZERO_BYTES, stream) != hipSuccess) return;
    Args a{};
    for (int i = 0; i < 25; ++i) a.in[i] = (const float*)d_in[i];
    a.out = (float*)d_out; a.ws = (unsigned char*)d_ws; a.pad = 0;
#if MK_PER_PHASE
    constexpr int NL = N_PHASES; int rl[NL][2]; for (int p = 0; p < NL; ++p) { rl[p][0] = p; rl[p][1] = p + 1; }
#elif defined(PROBE_SEQ)
    const int rl[][2] = PROBE_SEQ; constexpr int NL = sizeof(rl) / sizeof(rl[0]);
#else
    constexpr int NL = 1; const int rl[1][2] = {{0, N_PHASES}};
#endif
    for (int li = 0; li < NL; ++li) { a.ph_lo = rl[li][0]; a.ph_hi = rl[li][1]; a.bar_region = li;
        hipLaunchKernelGGL(fwd_kernel, dim3(grid), dim3(NWAVES * 64), LDS_BYTES, stream, a); }
    const hipError_t le = hipPeekAtLastError();
    if (le != hipSuccess) fprintf(stderr, "kernel_launch: launch failed: %s\n", hipGetErrorName(le));
}
```

```cpp
#include <hip/hip_runtime.h>
#include <hip/hip_bf16.h>
#include <cstdio>
#include <cstdint>

constexpr int DM = 4096, NBATCH = 2, SEQ = 8192, CTXL = 256, DEPTH = 2;
constexpr int ML = NBATCH * SEQ, MC = NBATCH * CTXL, MT = ML + MC;
constexpr int IN_DIM = 28672, FF = 11008, NMOD = 6 * DM;
constexpr int ZC_BG = 0, ZC_CG = 2048, ZC_XIN = 4096, ZC_Q = 6144, ZC_K = 8192, ZC_V = 10240, ZC_U = 12288, ZC_VM = 14336, ZC_GATE = 16384;
constexpr float EPS = 1e-6f;
constexpr int NTM = MT / 256;

namespace pg8 {
#define PG8_LAS __attribute__((address_space(3)))
typedef unsigned short bf16_t;
typedef short bf16x8 __attribute__((ext_vector_type(8)));
typedef float f32x4 __attribute__((ext_vector_type(4)));
typedef unsigned u32x4 __attribute__((ext_vector_type(4)));
constexpr int BM = 256, BK = 64, HALF = 128, HTB = HALF * BK * 2  , STAGE_BYTES = 8 * HTB, NXCD = 8, WGM = 4;

__host__ __device__ __forceinline__ int lds_byte(int r, int c) { const int st = (r >> 4) * 2 + (c >> 5), rr = r & 15, cc = c & 31, ob = rr * 64 + cc * 2; return st * 1024 + (ob ^ (((ob >> 9) & 1) << 5)); }
__host__ __device__ __forceinline__ void stage_rc(int b, int& R, int& C) { const int st = b / 1024, sb = b % 1024, swz = sb ^ (((sb >> 9) & 1) << 5); R = (st >> 1) * 16 + swz / 64; C = (st & 1) * 32 + (swz % 64) / 2; }
__host__ __device__ __forceinline__ int perm32(int rho) { const int n = rho >> 4, i = rho & 15; return 8 * (i >> 2) + 4 * n + (i & 3); }

struct Unit { int pm, pn, k0, nk, ks; };
struct Gemm { const bf16_t* A; const bf16_t* Bt; int M, N, K; };

#ifndef XROT
#define XROT 0
#endif
struct StaticOrder {
    int nM, nN, nwg, G, c, nkf;
    int rs; unsigned* tk; PG8_LAS unsigned* slot;
    __host__ __device__ void init(int M, int N, int G_, int c_, int K_) { nM = M / BM; nN = N / BM; nwg = nM * nN; G = G_; c = c_; nkf = K_ / BK; rs = 0x7fffffff; tk = nullptr; slot = nullptr; }
    __device__ void ticketed(unsigned* t, PG8_LAS unsigned char* lds) { const int r = nwg / G; if (r >= 3 && !(G & 7)) { rs = r - 1; tk = t; slot = (PG8_LAS unsigned*)(lds + 147440); } }
    __device__ __forceinline__ long lin_t(int i) const {
        if (i + 1 < rs) return lin(i);
        if (threadIdx.x == 0) { const unsigned t = __hip_atomic_fetch_add(tk, 1u, __ATOMIC_RELAXED, __HIP_MEMORY_SCOPE_AGENT); *(volatile PG8_LAS unsigned*)(slot + ((i + 1) & 1)) = t; }
        if (i < rs) return lin(i);
        const unsigned t = *(volatile PG8_LAS unsigned*)(slot + (i & 1));
        return (long)rs * G + (long)__builtin_amdgcn_readfirstlane((int)t);
    }
    __host__ __device__ long lin(int i) const { return (G & 7) ? (long)i * G + c : (long)i * G + (long)((c + XROT) & 7) * (G >> 3) + (c >> 3); }
    __host__ __device__ void tile_of(int U, int& pm, int& pn) const {
        constexpr int CW = 8, R = WGM; const int cc = U / (nM * CW); int cw = nN - cc * CW; cw = cw > CW ? CW : cw;
        const int up = U - cc * nM * CW, g = up / (R * cw); int rg = nM - R * g; rg = rg > R ? R : rg;
        const int upp = up - g * R * cw; pn = cc * CW + upp / rg; pm = R * g + upp % rg;
    }
    __device__ __forceinline__ bool from_lin(long L, Unit& u) const {
        if (L >= nwg) return false;
        tile_of((int)L, u.pm, u.pn); u.k0 = 0; u.nk = nkf; u.ks = -1; return true;
    }
    __device__ __forceinline__ bool next(int i, Unit& u) const { return from_lin(lin_t(i), u); }
    __device__ __forceinline__ void a_ready(const Unit&) const {}
    __device__ __forceinline__ void done(const Unit&) const {}
};

__device__ __forceinline__ unsigned cvt_pk_bf16(float lo, float hi) { unsigned r; asm volatile("v_cvt_pk_bf16_f32 %0, %1, %2" : "=v"(r) : "v"(lo), "v"(hi)); return r; }
typedef float f32x2 __attribute__((ext_vector_type(2)));
__device__ __forceinline__ float fsigmoid(float x) { return __builtin_amdgcn_rcpf(1.f + __builtin_amdgcn_exp2f(-1.4426950408889634f * x)); }
__device__ __forceinline__ float fgelu(float x) { const float t = x * (1.f + 0.044715f * x * x); return x * __builtin_amdgcn_rcpf(1.f + __builtin_amdgcn_exp2f(-2.3022081981f * t)); }
__device__ __forceinline__ float bflo(unsigned w) { return __uint_as_float(w << 16); }
__device__ __forceinline__ float bfhi(unsigned w) { return __uint_as_float(w & 0xffff0000u); }

struct EpiZ {
    static constexpr bool PERM = true, AFTER_DRAIN = false, DRAIN_AFTER = false;
    __device__ static __forceinline__ bool reset_after(const Unit&) { return true; }
    bf16_t* Z; float* KVF;
    __device__ __forceinline__ void operator()(const f32x4 (&acc)[2][2][4][2], const Unit& u, int wr, int wc, int fr, int fq) const {
        const int row0 = u.pm * BM + wr * 64 + fr, col0 = u.pn * BM + wc * 32 + 8 * fq;
        if (u.ks >= 0) {
            float* slab = KVF + (size_t)u.ks * MC * 4096;
#pragma unroll
            for (int ai = 0; ai < 2; ++ai)
#pragma unroll
                for (int m = 0; m < 4; ++m) { float* rowp = slab + (size_t)(row0 - ML + ai * HALF + m * 16) * 4096 + (col0 - ZC_K);
#pragma unroll
                    for (int bj = 0; bj < 2; ++bj) { *(f32x4*)(rowp + bj * HALF) = acc[ai][bj][m][0]; *(f32x4*)(rowp + bj * HALF + 4) = acc[ai][bj][m][1]; } }
            return;
        }
        const int mode = u.pn < 48 ? 0 : (u.pn < 64 ? 1 : 2);
#pragma unroll
        for (int ai = 0; ai < 2; ++ai)
#pragma unroll
            for (int m = 0; m < 4; ++m) { bf16_t* rowp = Z + (size_t)(row0 + ai * HALF + m * 16) * IN_DIM + col0;
#pragma unroll
                for (int bj = 0; bj < 2; ++bj) { f32x4 v0 = acc[ai][bj][m][0], v1 = acc[ai][bj][m][1];
                    if (mode == 1) {
#pragma unroll
                        for (int e = 0; e < 4; ++e) { v0[e] = fgelu(v0[e]); v1[e] = fgelu(v1[e]); } }
                    else if (mode == 2) {
#pragma unroll
                        for (int e = 0; e < 4; ++e) { v0[e] = fmaxf(fsigmoid(v0[e]), 1e-7f); v1[e] = fmaxf(fsigmoid(v1[e]), 1e-7f); } }
                    u32x4 w; w.x = cvt_pk_bf16(v0[0], v0[1]); w.y = cvt_pk_bf16(v0[2], v0[3]); w.z = cvt_pk_bf16(v1[0], v1[1]); w.w = cvt_pk_bf16(v1[2], v1[3]);
                    *(u32x4*)(rowp + bj * HALF) = w; } }
    }
};

struct EpiBr {
    static constexpr bool PERM = true, AFTER_DRAIN = false, DRAIN_AFTER = true;
    const bf16_t* Z; bf16_t* Y;
    __device__ static __forceinline__ bool reset_after(const Unit& u) { return u.pm >= 2 * NTM; }
    __device__ __forceinline__ void operator()(f32x4 (&acc)[2][2][4][2], const Unit& u, int wr, int wc, int fr, int fq) const {
        const int br = u.pm / NTM, pm = u.pm - br * NTM, pn = u.pn - br * 16;
        const int row0 = pm * BM + wr * 64 + fr, col0 = pn * BM + wc * 32 + 8 * fq;
        if (br < 2) {
#pragma unroll
            for (int ai = 0; ai < 2; ++ai)
#pragma unroll
                for (int mh = 0; mh < 2; ++mh) {
                    u32x4 g[2][2], h[2][2];
#pragma unroll
                    for (int mm = 0; mm < 2; ++mm)
#pragma unroll
                        for (int bj = 0; bj < 2; ++bj) { const bf16_t* gp = Z + (size_t)(row0 + ai * HALF + (2 * mh + mm) * 16) * IN_DIM + ZC_GATE + br * DM + col0 + bj * HALF;
                            g[mm][bj] = *(const u32x4*)gp; h[mm][bj] = *(const u32x4*)(gp + DM); }
                    __builtin_amdgcn_sched_barrier(0);
#pragma unroll
                    for (int mm = 0; mm < 2; ++mm)
#pragma unroll
                        for (int bj = 0; bj < 2; ++bj) { const u32x4 gg = g[mm][bj], hh = h[mm][bj]; f32x4& v0 = acc[ai][bj][2 * mh + mm][0]; f32x4& v1 = acc[ai][bj][2 * mh + mm][1];
                            v0[0] *= bflo(gg.x) * __builtin_amdgcn_rcpf(bflo(hh.x)); v0[1] *= bfhi(gg.x) * __builtin_amdgcn_rcpf(bfhi(hh.x)); v0[2] *= bflo(gg.y) * __builtin_amdgcn_rcpf(bflo(hh.y)); v0[3] *= bfhi(gg.y) * __builtin_amdgcn_rcpf(bfhi(hh.y));
                            v1[0] *= bflo(gg.z) * __builtin_amdgcn_rcpf(bflo(hh.z)); v1[1] *= bfhi(gg.z) * __builtin_amdgcn_rcpf(bfhi(hh.z)); v1[2] *= bflo(gg.w) * __builtin_amdgcn_rcpf(bflo(hh.w)); v1[3] *= bfhi(gg.w) * __builtin_amdgcn_rcpf(bfhi(hh.w)); }
                    __builtin_amdgcn_sched_barrier(0);
                }
        } else {
#pragma unroll
            for (int ai = 0; ai < 2; ++ai) {
                u32x4 g[4][2];
#pragma unroll
                for (int m = 0; m < 4; ++m)
#pragma unroll
                    for (int bj = 0; bj < 2; ++bj) g[m][bj] = *(const u32x4*)(Z + (size_t)(row0 + ai * HALF + m * 16) * IN_DIM + ZC_GATE + 2 * DM + col0 + bj * HALF);
                __builtin_amdgcn_sched_barrier(0);
#pragma unroll
                for (int m = 0; m < 4; ++m)
#pragma unroll
                    for (int bj = 0; bj < 2; ++bj) { const u32x4 gg = g[m][bj]; const f32x4 a0 = acc[ai][bj][m][0], a1 = acc[ai][bj][m][1];
                        u32x4 w; w.x = cvt_pk_bf16(a0[0] * bflo(gg.x), a0[1] * bfhi(gg.x)); w.y = cvt_pk_bf16(a0[2] * bflo(gg.y), a0[3] * bfhi(gg.y));
                        w.z = cvt_pk_bf16(a1[0] * bflo(gg.z), a1[1] * bfhi(gg.z)); w.w = cvt_pk_bf16(a1[2] * bflo(gg.w), a1[3] * bfhi(gg.w));
                        *(u32x4*)(Y + (size_t)(row0 + ai * HALF + m * 16) * DM + col0 + bj * HALF) = w; }
                __builtin_amdgcn_sched_barrier(0);
            }
        }
    }
};

struct EpiRes {
    static constexpr bool PERM = false, AFTER_DRAIN = false, DRAIN_AFTER = true;
    __device__ static __forceinline__ bool reset_after(const Unit&) { return true; }
    const float* src_lat; const float* src_ctx; float* dst_lat; float* dst_ctx; const float* gvec; float* slabs;
    __device__ __forceinline__ void operator()(const f32x4 (&acc)[2][2][4][2], const Unit& u, int wr, int wc, int fr, int fq) const {
        const int pm = u.pm, cls = pm < 32 ? 0 : (pm < 64 ? 1 : 2);
        const float* src = pm < 64 ? src_lat + (size_t)pm * BM * DM : src_ctx + (size_t)(pm - 64) * BM * DM;
        float* dst = pm < 64 ? dst_lat + (size_t)pm * BM * DM : dst_ctx + (size_t)(pm - 64) * BM * DM;
        const int col0 = u.pn * BM + wc * 32 + 4 * fq; const float* gv = gvec + (size_t)cls * NMOD + col0;
        f32x4 g[2][2];
#pragma unroll
        for (int bj = 0; bj < 2; ++bj)
#pragma unroll
            for (int n = 0; n < 2; ++n) g[bj][n] = *(const f32x4*)(gv + bj * HALF + n * 16);
        if (u.ks >= 0) {
            float* slab = slabs + (size_t)u.ks * MC * DM + (size_t)(pm - 64) * BM * DM;
#pragma unroll
            for (int ai = 0; ai < 2; ++ai)
#pragma unroll
                for (int m = 0; m < 4; ++m) { float* rowp = slab + (size_t)(ai * HALF + wr * 64 + m * 16 + fr) * DM + col0;
#pragma unroll
                    for (int bj = 0; bj < 2; ++bj)
#pragma unroll
                        for (int n = 0; n < 2; ++n) *(f32x4*)(rowp + bj * HALF + n * 16) = g[bj][n] * acc[ai][bj][m][n]; }
            return;
        }
#pragma unroll
        for (int am = 0; am < 4; ++am) { const int ai = am >> 1, m0 = (am & 1) * 2;
            f32x4 s[2][2][2];
#pragma unroll
            for (int mm = 0; mm < 2; ++mm) { const size_t off = (size_t)(ai * HALF + wr * 64 + (m0 + mm) * 16 + fr) * DM + col0;
#pragma unroll
                for (int bj = 0; bj < 2; ++bj)
#pragma unroll
                    for (int n = 0; n < 2; ++n) s[mm][bj][n] = *(const f32x4*)(src + off + bj * HALF + n * 16); }
            __builtin_amdgcn_sched_barrier(0);
#pragma unroll
            for (int mm = 0; mm < 2; ++mm) { const size_t off = (size_t)(ai * HALF + wr * 64 + (m0 + mm) * 16 + fr) * DM + col0;
#pragma unroll
                for (int bj = 0; bj < 2; ++bj)
#pragma unroll
                    for (int n = 0; n < 2; ++n) *(f32x4*)(dst + off + bj * HALF + n * 16) = s[mm][bj][n] + g[bj][n] * acc[ai][bj][m0 + mm][n]; }
            __builtin_amdgcn_sched_barrier(0);
        }
    }
};

struct EpiGU {
    static constexpr bool PERM = true, AFTER_DRAIN = false, DRAIN_AFTER = false;
    __device__ static __forceinline__ bool reset_after(const Unit&) { return true; }
    bf16_t* H;
    __device__ __forceinline__ void operator()(const f32x4 (&acc)[2][2][4][2], const Unit& u, int wr, int wc, int fr, int fq) const {
        const int row0 = u.pm * BM + wr * 64 + fr, col0 = u.pn * HALF + wc * 32 + 8 * fq;
#pragma unroll
        for (int ai = 0; ai < 2; ++ai)
#pragma unroll
            for (int m = 0; m < 4; ++m) { f32x4 g0 = acc[ai][0][m][0], g1 = acc[ai][0][m][1]; const f32x4 u0 = acc[ai][1][m][0], u1 = acc[ai][1][m][1];
#pragma unroll
                for (int e = 0; e < 4; ++e) { g0[e] = g0[e] * fsigmoid(g0[e]) * u0[e]; g1[e] = g1[e] * fsigmoid(g1[e]) * u1[e]; }
                u32x4 w; w.x = cvt_pk_bf16(g0[0], g0[1]); w.y = cvt_pk_bf16(g0[2], g0[3]); w.z = cvt_pk_bf16(g1[0], g1[1]); w.w = cvt_pk_bf16(g1[2], g1[3]);
                *(u32x4*)(H + (size_t)(row0 + ai * HALF + m * 16) * FF + col0) = w; }
    }
};

struct BranchOrder {
    int G, c, nM;
    __device__ bool next(int i, Unit& u) const {
        const int ti = i / 3, br = i - 3 * ti; StaticOrder T; T.nM = nM; T.nN = 16; T.nwg = nM * 16; T.G = G; T.c = c; T.nkf = 2048 / BK;
        const long L = T.lin(ti); if (L >= T.nwg) return false;
        int pm, pn; T.tile_of((int)L, pm, pn);
        u.pm = br * NTM + pm; u.pn = br * 16 + pn; u.k0 = 0; u.nk = 2048 / BK; u.ks = -1; return true;
    }
    __device__ __forceinline__ void a_ready(const Unit&) const {}
    __device__ __forceinline__ void done(const Unit&) const {}
};
__device__ __forceinline__ void ksplit8(int nkf, int s, int& k0, int& nk) { const int e = (nkf / 8) & ~1, half = (nkf - 8 * e) / 2; k0 = s * e + 2 * (s < half ? s : half); nk = e + (s < half ? 2 : 0); }
struct InOrder {
    StaticOrder S; int nmain, kv_only;
    __device__ void init(int G, int c, bool last) { kv_only = last; S.init(last ? ML : MT, IN_DIM, G, c, DM); nmain = S.nwg; }
    __device__ bool next(int i, Unit& u) const {
        const long L0 = S.lin_t(i); if (S.from_lin(L0, u)) return true;
        if (!kv_only) return false;
        const long L = L0 - nmain; if (L < 0 || L >= 256) return false;
        const int tile = (int)(L >> 3); u.pm = 64 + (tile >> 4); u.pn = 32 + (tile & 15); u.ks = (int)(L & 7); ksplit8(DM / BK, u.ks, u.k0, u.nk); return true;
    }
    __device__ __forceinline__ void a_ready(const Unit&) const {}
    __device__ __forceinline__ void done(const Unit&) const {}
};
struct ResOrder {
    StaticOrder S; int nmain, with_ctx;
    __device__ void init(int G, int c, int K, bool ctx) { with_ctx = ctx; S.init(ML, DM, G, c, K); nmain = S.nwg; }
    __device__ bool next(int i, Unit& u) const {
        const long L0 = S.lin_t(i); if (S.from_lin(L0, u)) return true;
        if (!with_ctx) return false;
        const long L = L0 - nmain; if (L < 0 || L >= 256) return false;
        const int tile = (int)(L >> 3); u.pm = 64 + (tile >> 4); u.pn = tile & 15; u.ks = (int)(L & 7); ksplit8(S.nkf, u.ks, u.k0, u.nk); return true;
    }
    __device__ __forceinline__ void a_ready(const Unit&) const {}
    __device__ __forceinline__ void done(const Unit&) const {}
};

template <class Epi, class Sched, bool ALIGN_EPI = false, bool SP2 = false>
__device__ __forceinline__ void gemm_phase(PG8_LAS unsigned char* lds, const int tid, const Gemm g, const Sched& S, const Epi& E) {
    const int wid = __builtin_amdgcn_readfirstlane(tid >> 6), lane = tid & 63, wr = wid >> 2, wc = wid & 3, fr = lane & 15, fq = lane >> 4;
    const int K = g.K;
    unsigned voffA[2], voffB[2];
#pragma unroll
    for (int i = 0; i < 2; ++i) { int R, C; stage_rc(tid * 16 + i * 8192, R, C); const int Rb = Epi::PERM ? ((R & ~31) + perm32(R & 31)) : R;
        voffA[i] = (unsigned)(R * K + C) * 2u; voffB[i] = (unsigned)(Rb * K + C) * 2u; }
    const size_t kstep = (size_t)(BK * 2);
    const size_t hstep = (size_t)HALF * K * 2;
    const size_t tstep = 2 * hstep;
    const unsigned ldsw = (unsigned)wid * 1024u;
    const int aoff = lds_byte(wr * 64 + fr, fq * 8), boff = lds_byte(wc * 32 + fr, fq * 8);
#define PG8_SA(b, h) (((b) * 2 + (h)) * HTB)
#define PG8_SB(b, h) ((4 + (b) * 2 + (h)) * HTB)
#define PG8_STAGE(bufoff, gbase, voff) do { _Pragma("unroll") for (int _i = 0; _i < 2; ++_i) \
        __builtin_amdgcn_global_load_lds((const unsigned*)((const char*)(gbase) + (voff)[_i]), (PG8_LAS unsigned*)(lds + (bufoff) + ldsw + _i * 8192), 16, 0, 0); } while (0)
#define PG8_LDA(dst, b, h) do { _Pragma("unroll") for (int m = 0; m < 4; ++m) _Pragma("unroll") for (int k = 0; k < 2; ++k) dst[m][k] = *(const PG8_LAS bf16x8*)(lds + PG8_SA(b, h) + aoff + m * 2048 + k * 1024); } while (0)
#define PG8_LDB(dst, b, h) do { _Pragma("unroll") for (int n = 0; n < 2; ++n) _Pragma("unroll") for (int k = 0; k < 2; ++k) dst[n][k] = *(const PG8_LAS bf16x8*)(lds + PG8_SB(b, h) + boff + n * 2048 + k * 1024); } while (0)
#define PG8_MMA(ai, bj, At, Bt) do { __builtin_amdgcn_s_setprio(1); _Pragma("unroll") for (int m = 0; m < 4; ++m) _Pragma("unroll") for (int n = 0; n < 2; ++n) _Pragma("unroll") for (int k = 0; k < 2; ++k) \
        acc[ai][bj][m][n] = __builtin_amdgcn_mfma_f32_16x16x32_bf16(Bt[n][k], At[m][k], acc[ai][bj][m][n], 0, 0, 0); __builtin_amdgcn_s_setprio(0); } while (0)
#define PG8_WAIT_V(n) asm volatile("s_waitcnt vmcnt(" #n ")" ::: "memory")
#define PG8_WAIT_L(n) asm volatile("s_waitcnt lgkmcnt(" #n ")" ::: "memory")
#define PG8_BAR __builtin_amdgcn_s_barrier()
#define PG8_SCHED __builtin_amdgcn_sched_barrier(0)
    Unit cur, nxt; int ui = 0;
    if (!S.next(0, cur)) return;
    f32x4 acc[2][2][4][2];
#pragma unroll
    for (int a = 0; a < 2; ++a)
#pragma unroll
        for (int b = 0; b < 2; ++b)
#pragma unroll
            for (int m = 0; m < 4; ++m)
#pragma unroll
                for (int n = 0; n < 2; ++n) acc[a][b][m][n] = (f32x4){0.f, 0.f, 0.f, 0.f};
    bf16x8 At[4][2], B0[2][2], B1[2][2];
#ifdef GEMM_FIXED
#define PG8_PM(u) (((GEMM_FIXED) & 1) ? 0 : (u).pm)
#define PG8_PN(u) (((GEMM_FIXED) & 2) ? 0 : (u).pn)
#else
#define PG8_PM(u) ((u).pm)
#define PG8_PN(u) ((u).pn)
#endif
    const char* cA = (const char*)g.A + (size_t)PG8_PM(cur) * tstep + (size_t)cur.k0 * kstep; const char* cB = (const char*)g.Bt + (size_t)PG8_PN(cur) * tstep + (size_t)cur.k0 * kstep;
    int nt = cur.nk;
    S.a_ready(cur);
    if constexpr (SP2) {
        PG8_STAGE(PG8_SB(0, 0), cB, voffB); PG8_STAGE(PG8_SB(0, 1), cB + hstep, voffB); PG8_STAGE(PG8_SA(0, 0), cA, voffA); PG8_STAGE(PG8_SA(0, 1), cA + hstep, voffA);
        if (wr == 1) PG8_BAR;
        PG8_WAIT_V(2); PG8_BAR;
        PG8_STAGE(PG8_SB(1, 0), cB + kstep, voffB); PG8_STAGE(PG8_SA(1, 0), cA + kstep, voffA); PG8_STAGE(PG8_SB(1, 1), cB + hstep + kstep, voffB);
        PG8_WAIT_V(6); PG8_BAR;
    } else {
        PG8_STAGE(PG8_SB(0, 0), cB, voffB); PG8_STAGE(PG8_SA(0, 0), cA, voffA); PG8_STAGE(PG8_SB(0, 1), cB + hstep, voffB); PG8_STAGE(PG8_SA(0, 1), cA + hstep, voffA);
        if (wr == 1) PG8_BAR;
        PG8_WAIT_V(4); PG8_BAR;
        PG8_STAGE(PG8_SB(1, 0), cB + kstep, voffB); PG8_STAGE(PG8_SA(1, 0), cA + kstep, voffA); PG8_STAGE(PG8_SB(1, 1), cB + hstep + kstep, voffB);
        PG8_WAIT_V(6); PG8_BAR;
    }
    for (;;) {
        const bool has_next = S.next(ui + 1, nxt);
        const char* nA = has_next ? (const char*)g.A + (size_t)PG8_PM(nxt) * tstep + (size_t)nxt.k0 * kstep : cA; const char* nB = has_next ? (const char*)g.Bt + (size_t)PG8_PN(nxt) * tstep + (size_t)nxt.k0 * kstep : cB;
        for (int t = 0; t < nt; t += 2) {
            const bool last = (t == nt - 2);
            const char* a1 = cA + (size_t)(t + 1) * kstep;
            const char* a2 = last ? nA : cA + (size_t)(t + 2) * kstep; const char* b2 = last ? nB : cB + (size_t)(t + 2) * kstep;
            const char* a3 = a2 + kstep; const char* b3 = b2 + kstep;
            if (last && has_next) S.a_ready(nxt);
            if constexpr (SP2) {
            PG8_LDB(B0, 0, 0); PG8_LDB(B1, 0, 1); PG8_SCHED; PG8_LDA(At, 0, 0); PG8_STAGE(PG8_SA(1, 1), a1 + hstep, voffA);
            PG8_WAIT_V(8); PG8_WAIT_L(0); PG8_BAR; PG8_MMA(0, 0, At, B0); PG8_MMA(0, 1, At, B1); PG8_BAR; PG8_SCHED;
            PG8_LDA(At, 0, 1); PG8_STAGE(PG8_SB(0, 0), b2, voffB); PG8_STAGE(PG8_SB(0, 1), b2 + hstep, voffB); PG8_STAGE(PG8_SA(0, 0), a2, voffA);
            PG8_WAIT_V(8); PG8_WAIT_L(0); PG8_BAR; PG8_MMA(1, 0, At, B0); PG8_MMA(1, 1, At, B1); PG8_BAR; PG8_SCHED;
            PG8_LDB(B0, 1, 0); PG8_LDB(B1, 1, 1); PG8_SCHED; PG8_LDA(At, 1, 0); PG8_STAGE(PG8_SA(0, 1), a2 + hstep, voffA);
            PG8_WAIT_V(8); PG8_WAIT_L(0); PG8_BAR; PG8_MMA(0, 0, At, B0); PG8_MMA(0, 1, At, B1); PG8_BAR; PG8_SCHED;
            PG8_LDA(At, 1, 1); PG8_STAGE(PG8_SB(1, 0), b3, voffB); PG8_STAGE(PG8_SB(1, 1), b3 + hstep, voffB); PG8_STAGE(PG8_SA(1, 0), a3, voffA);
            PG8_WAIT_V(8); PG8_WAIT_L(0); PG8_BAR; PG8_MMA(1, 0, At, B0); PG8_MMA(1, 1, At, B1); PG8_BAR; PG8_SCHED;
            } else {
            PG8_LDB(B0, 0, 0); PG8_SCHED; PG8_LDA(At, 0, 0); PG8_STAGE(PG8_SA(1, 1), a1 + hstep, voffA);
            PG8_WAIT_L(8); PG8_BAR; PG8_WAIT_L(0); PG8_MMA(0, 0, At, B0); PG8_BAR; PG8_SCHED;
            PG8_LDB(B1, 0, 1); PG8_STAGE(PG8_SB(0, 0), b2, voffB);
            PG8_BAR; PG8_WAIT_L(0); PG8_MMA(0, 1, At, B1); PG8_BAR;
            PG8_LDA(At, 0, 1); PG8_STAGE(PG8_SA(0, 0), a2, voffA);
            PG8_BAR; PG8_WAIT_L(0); PG8_MMA(1, 0, At, B0); PG8_BAR; PG8_SCHED;
            PG8_STAGE(PG8_SB(0, 1), b2 + hstep, voffB);
            PG8_WAIT_V(6); PG8_BAR; PG8_MMA(1, 1, At, B1); PG8_BAR;
            PG8_LDB(B0, 1, 0); PG8_SCHED; PG8_LDA(At, 1, 0); PG8_STAGE(PG8_SA(0, 1), a2 + hstep, voffA);
            PG8_WAIT_L(8); PG8_BAR; PG8_WAIT_L(0); PG8_MMA(0, 0, At, B0); PG8_BAR; PG8_SCHED;
            PG8_LDB(B1, 1, 1); PG8_STAGE(PG8_SB(1, 0), b3, voffB);
            PG8_BAR; PG8_WAIT_L(0); PG8_MMA(0, 1, At, B1); PG8_BAR;
            PG8_LDA(At, 1, 1); PG8_STAGE(PG8_SA(1, 0), a3, voffA);
            PG8_BAR; PG8_WAIT_L(0); PG8_MMA(1, 0, At, B0); PG8_BAR; PG8_SCHED;
            PG8_STAGE(PG8_SB(1, 1), b3 + hstep, voffB);
            PG8_WAIT_V(6); PG8_BAR; PG8_MMA(1, 1, At, B1); PG8_BAR;
            }
        }
        if constexpr (ALIGN_EPI) { if (wr == 0) PG8_BAR; }
        if constexpr (!Epi::AFTER_DRAIN) { E(acc, cur, wr, wc, fr, fq); S.done(cur);
            if constexpr (Epi::DRAIN_AFTER) __builtin_amdgcn_s_waitcnt(0x0F70); }
        if (!has_next) break;
        if (Epi::reset_after(cur)) {
#pragma unroll
        for (int a = 0; a < 2; ++a)
#pragma unroll
            for (int b = 0; b < 2; ++b)
#pragma unroll
                for (int m = 0; m < 4; ++m)
#pragma unroll
                    for (int n = 0; n < 2; ++n) acc[a][b][m][n] = (f32x4){0.f, 0.f, 0.f, 0.f};
        }
        cur = nxt; cA = nA; cB = nB; nt = cur.nk; ++ui;
        if constexpr (ALIGN_EPI) { if (wr == 1) PG8_BAR; }
    }
    PG8_WAIT_V(0);
    if constexpr (!ALIGN_EPI) { if (wr == 0) PG8_BAR; }
    PG8_BAR;
    if constexpr (Epi::AFTER_DRAIN) { E.fused(acc, cur, wr, wc, fr, fq, lds, wid, lane); S.done(cur); }
#undef PG8_SA
#undef PG8_SB
#undef PG8_STAGE
#undef PG8_LDA
#undef PG8_LDB
#undef PG8_MMA
#undef PG8_WAIT_V
#undef PG8_WAIT_L
#undef PG8_BAR
#undef PG8_SCHED
}
}
namespace att {
using bf16x8 = __attribute__((ext_vector_type(8))) short;
using s16x4  = __attribute__((ext_vector_type(4))) short;
using f32x16 = __attribute__((ext_vector_type(16))) float;
using u32x4  = __attribute__((ext_vector_type(4))) unsigned;
typedef unsigned short bf16_t;
constexpr int NW = 8, QBLK = 32, KVBLK = 64;
constexpr float SCALE = 0.125f, THR = 8.f;
constexpr int LDQK = DM, LDV = IN_DIM;
constexpr int NSLOT = 4;
constexpr int SHM_V = KVBLK * 128 * 2, SHM_K = KVBLK * 64 * 2, SHM_ATTN = NSLOT * SHM_V + NSLOT * SHM_K + NW * 64 * 4;
#define KSWZ(row, colB) ((row) * 128 + ((colB) ^ ((((row) >> 1) & 7) << 4)))
#define SBAR() __builtin_amdgcn_sched_barrier(0)
__device__ __forceinline__ int crow(int r, int hi) { return (r & 3) + 8 * (r >> 2) + 4 * hi; }
__device__ __forceinline__ unsigned cvtpk(float lo, float hi) { unsigned r; asm volatile("v_cvt_pk_bf16_f32 %0, %1, %2" : "=v"(r) : "v"(lo), "v"(hi)); return r; }

__device__ __forceinline__ int v_st(int k, int c) { const int kk = (k & ~0xC) | ((k & 4) << 1) | ((k & 8) >> 1); return ((kk >> 3) * 4 + (c >> 5)) * 512 + ((kk & 7) * 32 + (c & 31)) * 2; }
__device__ __forceinline__ int v_rd_base(int lane) { return ((lane & 3) << 3) | (((lane >> 2) & 3) << 6) | (((lane >> 4) & 1) << 5) | (((lane >> 5) & 1) << 8); }
constexpr int v_rd_off(int d0, int ks, int half) { return d0 * 512 + ks * 4096 + half * 2048; }
template <int OFF> __device__ __forceinline__ s16x4 tr_read(int vb) {
  s16x4 r; asm volatile("ds_read_b64_tr_b16 %0, %1 offset:%2" : "=&v"(r) : "v"(vb), "i"(OFF) : "memory"); return r;
}
template <int D0> __device__ __forceinline__ void pv_one(f32x16& od, int vb, bf16x8 pa0, bf16x8 pa1, bf16x8 pa2, bf16x8 pa3) {
  const s16x4 l0 = tr_read<v_rd_off(D0, 0, 0)>(vb), h0 = tr_read<v_rd_off(D0, 0, 1)>(vb), l1 = tr_read<v_rd_off(D0, 1, 0)>(vb), h1 = tr_read<v_rd_off(D0, 1, 1)>(vb);
  const s16x4 l2 = tr_read<v_rd_off(D0, 2, 0)>(vb), h2 = tr_read<v_rd_off(D0, 2, 1)>(vb), l3 = tr_read<v_rd_off(D0, 3, 0)>(vb), h3 = tr_read<v_rd_off(D0, 3, 1)>(vb);
  asm volatile("s_waitcnt lgkmcnt(0)" ::: "memory"); SBAR();
#define PK(L, H) (bf16x8){L[0], L[1], L[2], L[3], H[0], H[1], H[2], H[3]}
  od = __builtin_amdgcn_mfma_f32_32x32x16_bf16(pa0, PK(l0, h0), od, 0, 0, 0);
  od = __builtin_amdgcn_mfma_f32_32x32x16_bf16(pa1, PK(l1, h1), od, 0, 0, 0);
  od = __builtin_amdgcn_mfma_f32_32x32x16_bf16(pa2, PK(l2, h2), od, 0, 0, 0);
  od = __builtin_amdgcn_mfma_f32_32x32x16_bf16(pa3, PK(l3, h3), od, 0, 0, 0);
#undef PK
}

typedef float f32x2 __attribute__((ext_vector_type(2)));
template <int OFF> __device__ __forceinline__ bf16x8 k_read(int ka) {
  bf16x8 r; asm volatile("ds_read_b128 %0, %1 offset:%2" : "=&v"(r) : "v"(ka), "i"(OFF) : "memory"); return r;
}
struct VFr { s16x4 l0, h0, l1, h1, l2, h2, l3, h3; };
template <int D0, int VS> __device__ __forceinline__ void v_issue(VFr& f, int vb) {
#ifdef ATT_NOVREAD
  f.l0 = f.h0 = f.l1 = f.h1 = f.l2 = f.h2 = f.l3 = f.h3 = (s16x4){1, 1, 1, 1}; return;
#endif
  f.l0 = tr_read<VS * SHM_V + v_rd_off(D0, 0, 0)>(vb); f.h0 = tr_read<VS * SHM_V + v_rd_off(D0, 0, 1)>(vb); f.l1 = tr_read<VS * SHM_V + v_rd_off(D0, 1, 0)>(vb); f.h1 = tr_read<VS * SHM_V + v_rd_off(D0, 1, 1)>(vb);
  f.l2 = tr_read<VS * SHM_V + v_rd_off(D0, 2, 0)>(vb); f.h2 = tr_read<VS * SHM_V + v_rd_off(D0, 2, 1)>(vb); f.l3 = tr_read<VS * SHM_V + v_rd_off(D0, 3, 0)>(vb); f.h3 = tr_read<VS * SHM_V + v_rd_off(D0, 3, 1)>(vb);
}
#define ATT_PK(L, H) (bf16x8){L[0], L[1], L[2], L[3], H[0], H[1], H[2], H[3]}
#define ATT_LGKM(n) asm volatile("s_waitcnt lgkmcnt(" #n ")" ::: "memory")
__device__ __forceinline__ void sm_pair(f32x16& c, const int e, const float) {
#ifdef ATT_NOEXP
  c[e] = c[e] * 0.5f; c[e + 1] = c[e + 1] * 0.5f;
#else
  c[e] = __builtin_amdgcn_exp2f(c[e]); c[e + 1] = __builtin_amdgcn_exp2f(c[e + 1]);
#endif
}
__device__ __forceinline__ void acc_pair(f32x2& lsum, const float a, const float b) {
#ifdef ATT_NOSUM
  return;
#endif
  asm volatile("v_add_f32 %0, %0, %1" : "+v"(lsum.x) : "v"(a)); asm volatile("v_add_f32 %0, %0, %1" : "+v"(lsum.y) : "v"(b));
}
template <int G>
__device__ __forceinline__ void gapv(f32x16& c0, f32x16& c1, bf16x8 (&pn)[4], f32x2& lsum, unsigned (&cv)[4], const float m0c) {
  if constexpr (G < 16) {
    if constexpr (G < 14) { constexpr int e = 4 + 2 * G; if constexpr (e < 16) sm_pair(c0, e, m0c); else sm_pair(c1, e - 16, m0c); }
    constexpr int a = 2 * G;
    if constexpr (a < 16) acc_pair(lsum, c0[a], c0[a + 1]); else acc_pair(lsum, c1[a - 16], c1[a - 15]);
  } else {
    constexpr int k = G - 16, q = k >> 1, B = (q & 1) * 8;
    f32x16& P = (q < 2) ? c0 : c1;
    if constexpr ((k & 1) == 0) { cv[0] = cvtpk(P[B + 0], P[B + 1]); cv[1] = cvtpk(P[B + 2], P[B + 3]); cv[2] = cvtpk(P[B + 4], P[B + 5]); cv[3] = cvtpk(P[B + 6], P[B + 7]); }
    else {
      auto r0 = __builtin_amdgcn_permlane32_swap(cv[0], cv[2], false, false); auto r1 = __builtin_amdgcn_permlane32_swap(cv[1], cv[3], false, false);
      u32x4 w = {r0[0], r1[0], r0[1], r1[1]}; pn[q] = *reinterpret_cast<bf16x8*>(&w);
    }
  }
}
#define ATT_GAP(G) do { SBAR(); gapv<G>(c0, c1, pn, lsum, cv, m0c); SBAR(); } while (0)
#define ATT_PVBLK(OD, F, G0) do { \
    OD = __builtin_amdgcn_mfma_f32_32x32x16_bf16(pp[0], ATT_PK(F.l0, F.h0), OD, 0, 0, 0); ATT_GAP(G0); \
    OD = __builtin_amdgcn_mfma_f32_32x32x16_bf16(pp[1], ATT_PK(F.l1, F.h1), OD, 0, 0, 0); ATT_GAP(G0 + 1); \
    OD = __builtin_amdgcn_mfma_f32_32x32x16_bf16(pp[2], ATT_PK(F.l2, F.h2), OD, 0, 0, 0); ATT_GAP(G0 + 2); \
    OD = __builtin_amdgcn_mfma_f32_32x32x16_bf16(pp[3], ATT_PK(F.l3, F.h3), OD, 0, 0, 0); ATT_GAP(G0 + 3); } while (0)
template <bool HAS_QK, bool HAS_PV, int KS, int VS, class Mid>
__device__ __forceinline__ void att_seg(const Mid& mid, f32x16& c0, f32x16& c1, f32x16& n0, f32x16& n1, const bf16x8 (&pp)[4], bf16x8 (&pn)[4], f32x16 (&o)[4], f32x2& lsum,
                                        const int (&ka)[4], const int vb, const bf16x8 (&qf)[4], const float m0c) {
  unsigned cv[4]; VFr va, vq; bf16x8 kf[8];
  if constexpr (HAS_PV) { v_issue<0, VS>(va, vb); v_issue<1, VS>(vq, vb); }
  SBAR(); sm_pair(c0, 0, m0c); sm_pair(c0, 2, m0c); SBAR();
#define ATT_KQ_ISSUE() do { _Pragma("unroll") for (int d0 = 0; d0 < 4; ++d0) { kf[2 * d0] = k_read<KS * SHM_K>(ka[d0]); kf[2 * d0 + 1] = k_read<KS * SHM_K + 4096>(ka[d0]); } } while (0)
  if constexpr (HAS_PV) {
    ATT_LGKM(8); SBAR();
    ATT_PVBLK(o[0], va, 0);
#ifndef ATT_NOMID
    mid();
#endif
    SBAR();
    v_issue<2, VS>(va, vb); ATT_LGKM(8); SBAR();
    ATT_PVBLK(o[1], vq, 4);
    v_issue<3, VS>(vq, vb); ATT_LGKM(8); SBAR();
    ATT_PVBLK(o[2], va, 8);
    if constexpr (HAS_QK) { ATT_KQ_ISSUE(); ATT_LGKM(8); } else { ATT_LGKM(0); }
    SBAR();
    ATT_PVBLK(o[3], vq, 12);
  } else {
    mid(); SBAR();
    if constexpr (HAS_QK) ATT_KQ_ISSUE();
    ATT_GAP(0); ATT_GAP(1); ATT_GAP(2); ATT_GAP(3); ATT_GAP(4); ATT_GAP(5); ATT_GAP(6); ATT_GAP(7);
    ATT_GAP(8); ATT_GAP(9); ATT_GAP(10); ATT_GAP(11); ATT_GAP(12); ATT_GAP(13); ATT_GAP(14); ATT_GAP(15);
  }
  if constexpr (HAS_QK) {
    n0 = f32x16{}; n1 = f32x16{};
    ATT_LGKM(0); SBAR();
    n0 = __builtin_amdgcn_mfma_f32_32x32x16_bf16(kf[0], qf[0], n0, 0, 0, 0); ATT_GAP(16);
    n1 = __builtin_amdgcn_mfma_f32_32x32x16_bf16(kf[1], qf[0], n1, 0, 0, 0); ATT_GAP(17);
    n0 = __builtin_amdgcn_mfma_f32_32x32x16_bf16(kf[2], qf[1], n0, 0, 0, 0); ATT_GAP(18);
    n1 = __builtin_amdgcn_mfma_f32_32x32x16_bf16(kf[3], qf[1], n1, 0, 0, 0); ATT_GAP(19);
    n0 = __builtin_amdgcn_mfma_f32_32x32x16_bf16(kf[4], qf[2], n0, 0, 0, 0); ATT_GAP(20);
    n1 = __builtin_amdgcn_mfma_f32_32x32x16_bf16(kf[5], qf[2], n1, 0, 0, 0); ATT_GAP(21);
    n0 = __builtin_amdgcn_mfma_f32_32x32x16_bf16(kf[6], qf[3], n0, 0, 0, 0); ATT_GAP(22);
    n1 = __builtin_amdgcn_mfma_f32_32x32x16_bf16(kf[7], qf[3], n1, 0, 0, 0); ATT_GAP(23);
  } else { ATT_GAP(16); ATT_GAP(17); ATT_GAP(18); ATT_GAP(19); ATT_GAP(20); ATT_GAP(21); ATT_GAP(22); ATT_GAP(23); }
#undef ATT_KQ_ISSUE
}

__device__ __forceinline__ void attn_unit(const int MODE, const bf16_t* __restrict__ Qb, const bf16_t* __restrict__ Kh, const bf16_t* __restrict__ Vh, float* __restrict__ OS, bf16_t* __restrict__ AOb,
                                          const float* __restrict__ subg, float lam, float osc, const float m0c, int rowa, int nt0, int rowb, int NT, char* lds, int tid) {
  asm volatile("" : "+v"(tid));
  const int wid = tid >> 6, lane = tid & 63, r32 = lane & 31, hi = lane >> 5;
  char* V_lds = lds; char* K_lds = lds + NSLOT * SHM_V;
  float* ws = (float*)(lds + NSLOT * SHM_V + NSLOT * SHM_K) + wid * 64; float* li_l = ws;
  f32x16 o[4] = {}; bf16x8 qr[4];
  const bf16_t* Qw = Qb + (long)(wid * QBLK + r32) * LDQK + hi * 8;
#pragma unroll
  for (int d0 = 0; d0 < 4; ++d0) qr[d0] = *reinterpret_cast<const bf16x8*>(Qw + d0 * 16);
  unsigned koffd, voffd0, voffd1;
  { const int b = wid * 1024 + lane * 16, row = b >> 7, colB = (b & 127) ^ (((row >> 1) & 7) << 4); koffd = (unsigned)(row * LDQK * 2 + colB); }
  { const int b = wid * 1024 + lane * 16, sub = b >> 9, e = (b & 511) >> 1, kk = (sub >> 2) * 8 + (e >> 5), k = (kk & ~0xC) | ((kk & 4) << 1) | ((kk & 8) >> 1), col = (sub & 3) * 32 + (e & 31);
    voffd0 = (unsigned)(k * LDV * 2 + col * 2); }
  { const int b = 8192 + wid * 1024 + lane * 16, sub = b >> 9, e = (b & 511) >> 1, kk = (sub >> 2) * 8 + (e >> 5), k = (kk & ~0xC) | ((kk & 4) << 1) | ((kk & 8) >> 1), col = (sub & 3) * 32 + (e & 31);
    voffd1 = (unsigned)(k * LDV * 2 + col * 2); }
  const unsigned wid_s = (unsigned)__builtin_amdgcn_readfirstlane(wid);
  const unsigned ldsK = (unsigned)(uintptr_t)(lds + NSLOT * SHM_V) + wid_s * 1024u, ldsV = (unsigned)(uintptr_t)lds + wid_s * 1024u;
  const int vb = (int)(uintptr_t)V_lds + v_rd_base(lane);
  int ka[4];
#pragma unroll
  for (int d0 = 0; d0 < 4; ++d0) ka[d0] = (int)(uintptr_t)K_lds + KSWZ(r32, (d0 * 16 + hi * 8) * 2);
#define KROW(j) ((j) < nt0 ? rowa + (j) * KVBLK : rowb + ((j) - nt0) * KVBLK)
#define GLDS(src, dst) do { unsigned keep_; asm volatile("s_mov_b32 %0, m0\n\ts_mov_b32 m0, %2\n\ts_nop 0\n\tglobal_load_lds_dwordx4 %1, off\n\ts_mov_b32 m0, %0" : "=&s"(keep_) : "v"(src), "s"(dst) : "memory"); } while (0)
#define KDMA(j, slot) do { const int jc_ = (j) < NT ? (j) : NT - 1; GLDS((const char*)Kh + (size_t)KROW(jc_) * (LDQK * 2) + koffd, ldsK + (unsigned)(slot) * SHM_K); } while (0)
#define VDMA(j, slot) do { const int jc_ = (j) < NT ? (j) : NT - 1; const char* vb_ = (const char*)Vh + (size_t)KROW(jc_) * (LDV * 2); \
    GLDS(vb_ + voffd0, ldsV + (unsigned)(slot) * SHM_V); GLDS(vb_ + voffd1, ldsV + (unsigned)(slot) * SHM_V + 8192u); } while (0)
#define SEGEND() do { asm volatile("s_waitcnt vmcnt(0) lgkmcnt(0)" ::: "memory"); __builtin_amdgcn_s_barrier(); asm volatile("" ::: "memory"); } while (0)
  f32x16 sA0, sA1, sB0, sB1; bf16x8 paA[4], paB[4]; f32x2 lsum = {0.f, 0.f};
  const auto nomid = [&]() {};
  KDMA(0, 0); KDMA(1, 1); KDMA(2, 2); VDMA(0, 0);
  SEGEND();
  { bf16x8 kf[8];
#pragma unroll
    for (int d0 = 0; d0 < 4; ++d0) { kf[2 * d0] = k_read<0>(ka[d0]); kf[2 * d0 + 1] = k_read<4096>(ka[d0]); }
    sA0 = f32x16{}; sA1 = f32x16{}; ATT_LGKM(0); SBAR();
#pragma unroll
    for (int d0 = 0; d0 < 4; ++d0) { sA0 = __builtin_amdgcn_mfma_f32_32x32x16_bf16(kf[2 * d0], qr[d0], sA0, 0, 0, 0); sA1 = __builtin_amdgcn_mfma_f32_32x32x16_bf16(kf[2 * d0 + 1], qr[d0], sA1, 0, 0, 0); } }
  SEGEND();
  att_seg<true, false, 1, 0>([&]() { KDMA(3, 3); KDMA(4, 0); VDMA(1, 1); VDMA(2, 2); }, sA0, sA1, sB0, sB1, paB  , paA, o, lsum, ka, vb, qr, m0c);
  att_seg<true, true, 2, 0>(nomid, sB0, sB1, sA0, sA1, paA, paB, o, lsum, ka, vb, qr, m0c);
  SEGEND();
  for (int j = 2; j + 2 < NT; j += 4) {
    att_seg<true, true, 3, 1>([&]() { KDMA(j + 3, 1); KDMA(j + 4, 2); VDMA(j + 1, 3); VDMA(j + 2, 0); }, sA0, sA1, sB0, sB1, paB, paA, o, lsum, ka, vb, qr, m0c);
    att_seg<true, true, 0, 2>(nomid, sB0, sB1, sA0, sA1, paA, paB, o, lsum, ka, vb, qr, m0c);
    SEGEND();
    att_seg<true, true, 1, 3>([&]() { KDMA(j + 5, 3); KDMA(j + 6, 0); VDMA(j + 3, 1); VDMA(j + 4, 2); }, sA0, sA1, sB0, sB1, paB, paA, o, lsum, ka, vb, qr, m0c);
    att_seg<true, true, 2, 0>(nomid, sB0, sB1, sA0, sA1, paA, paB, o, lsum, ka, vb, qr, m0c);
    SEGEND();
  }
  att_seg<true, true, 3, 1>([&]() { VDMA(NT - 1, 3); }, sA0, sA1, sB0, sB1, paB, paA, o, lsum, ka, vb, qr, m0c);
  att_seg<false, true, 0, 2>(nomid, sB0, sB1, sA0, sA1, paA, paB, o, lsum, ka, vb, qr, m0c);
  SEGEND();
  { VFr va, vq;
    v_issue<0, 3>(va, vb); v_issue<1, 3>(vq, vb); ATT_LGKM(8); SBAR();
#define ATT_PV4(OD, F, PP) do { OD = __builtin_amdgcn_mfma_f32_32x32x16_bf16(PP[0], ATT_PK(F.l0, F.h0), OD, 0, 0, 0); OD = __builtin_amdgcn_mfma_f32_32x32x16_bf16(PP[1], ATT_PK(F.l1, F.h1), OD, 0, 0, 0); \
    OD = __builtin_amdgcn_mfma_f32_32x32x16_bf16(PP[2], ATT_PK(F.l2, F.h2), OD, 0, 0, 0); OD = __builtin_amdgcn_mfma_f32_32x32x16_bf16(PP[3], ATT_PK(F.l3, F.h3), OD, 0, 0, 0); } while (0)
    ATT_PV4(o[0], va, paB); SBAR();
    v_issue<2, 3>(va, vb); ATT_LGKM(8); SBAR();
    ATT_PV4(o[1], vq, paB); SBAR();
    v_issue<3, 3>(vq, vb); ATT_LGKM(8); SBAR();
    ATT_PV4(o[2], va, paB); SBAR();
    ATT_LGKM(0); SBAR();
    ATT_PV4(o[3], vq, paB); }
  float l_reg = lsum.x + lsum.y;
  { auto rr = __builtin_amdgcn_permlane32_swap(__float_as_uint(l_reg), __float_as_uint(l_reg), false, false); l_reg = __uint_as_float(rr[0]) + __uint_as_float(rr[1]); }
  if (hi == 0) li_l[r32] = l_reg; asm volatile("s_waitcnt lgkmcnt(0)" ::: "memory");
  float rli[16];
#pragma unroll
  for (int r = 0; r < 16; ++r) rli[r] = __builtin_amdgcn_rcpf(li_l[crow(r, hi)]);
  int zo = 0; asm volatile("" : "+v"(zo));
  float* Ow = OS + (wid * QBLK) * 128 + zo;
  if (MODE == 0) {
#pragma unroll
    for (int r = 0; r < 16; ++r) { const int orow = crow(r, hi);
#pragma unroll
      for (int d0 = 0; d0 < 4; ++d0) Ow[orow * 128 + d0 * 32 + r32] = o[d0][r] * rli[r]; }
  } else {
    float sg[4];
#pragma unroll
    for (int d0 = 0; d0 < 4; ++d0) sg[d0] = subg[d0 * 32 + r32] * osc;
    bf16_t* Aw = AOb + (long)(wid * QBLK) * 2048 + zo;
#pragma unroll
    for (int r = 0; r < 16; ++r) { const int orow = crow(r, hi); float d[4]; float ss = 0.f;
#pragma unroll
      for (int d0 = 0; d0 < 4; ++d0) { d[d0] = __hip_atomic_load(&Ow[orow * 128 + d0 * 32 + r32], __ATOMIC_RELAXED, __HIP_MEMORY_SCOPE_AGENT) - lam * (o[d0][r] * rli[r]); ss += d[d0] * d[d0]; }
      { const int l4 = lane << 2;
#pragma unroll
        for (int k = 1; k < 32; k <<= 1) ss += __uint_as_float((unsigned)__builtin_amdgcn_ds_bpermute(l4 ^ (k << 2), (int)__float_as_uint(ss))); }
      const float rs = __builtin_amdgcn_rsqf(ss * (1.f / 128.f) + EPS);
#pragma unroll
      for (int d0 = 0; d0 < 4; ++d0) Aw[(long)orow * 2048 + d0 * 32 + r32] = (bf16_t)(cvtpk(d[d0] * rs * sg[d0], 0.f) & 0xffffu); }
  }
  asm volatile("s_waitcnt vmcnt(0)" ::: "memory");
  __syncthreads();
#undef KROW
#undef GLDS
#undef KDMA
#undef VDMA
#undef SEGEND
}
}

#define GAS __attribute__((address_space(1)))
#define LAS __attribute__((address_space(3)))
typedef unsigned short bf16;
typedef unsigned v4u __attribute__((ext_vector_type(4)));
typedef float f32x4 __attribute__((ext_vector_type(4)));
typedef short bf16x8 __attribute__((ext_vector_type(8)));
typedef GAS unsigned gu32;
typedef GAS unsigned long long gu64;
#define RLX_AGENT __ATOMIC_RELAXED, __HIP_MEMORY_SCOPE_AGENT
#define LDS_WAIT() asm volatile("s_waitcnt lgkmcnt(0)" ::: "memory")
#define VM_WAIT() asm volatile("s_waitcnt vmcnt(0)" ::: "memory")
__device__ __forceinline__ unsigned long long rt() { return __builtin_amdgcn_s_memrealtime(); }
__device__ __forceinline__ unsigned f2bf(float f) { unsigned u = __builtin_bit_cast(unsigned, f); return (u + 0x7fffu + ((u >> 16) & 1u)) >> 16; }
__device__ __forceinline__ unsigned pk2(float lo, float hi) { return f2bf(lo) | (f2bf(hi) << 16); }

#define XB_TMO      128
#define XB_XCNT(j)  (256  + 64 * (j))
#define XB_XSUB(j)  (1280 + 64 * (j))
#define XB_XGEN(j)  (2304 + 64 * (j))
#define XB_TOP      3328
#define XB_TOPGEN   3392
#define XCD_BAR_WORDS 3456
#define XB_SPIN_CAP (1u << 18)

__device__ __forceinline__ unsigned xb_ld(unsigned* p)              { return __hip_atomic_load(p, __ATOMIC_RELAXED, __HIP_MEMORY_SCOPE_AGENT); }
__device__ __forceinline__ unsigned xb_add(unsigned* p, unsigned v) { return __hip_atomic_fetch_add(p, v, __ATOMIC_RELAXED, __HIP_MEMORY_SCOPE_AGENT); }
__device__ __forceinline__ unsigned xb_xcc_id() { return (unsigned)__builtin_amdgcn_s_getreg((3 << 11) | 20) & 0xFu; }
#define XB_SPIN(cond, bar) do { unsigned _sp = 0; while (cond) { __builtin_amdgcn_s_sleep(1); \
    if ((++_sp & 255u) == 0u) { if (xb_ld(&(bar)[XB_TMO])) break; if (_sp > XB_SPIN_CAP) { atomicAdd(&(bar)[XB_TMO], 1u); break; } } } } while (0)

struct XcdBarrier {
    unsigned* bar; unsigned x;
    volatile LAS unsigned* st;
};

__device__ __forceinline__ XcdBarrier xcd_barrier_post(unsigned* bar, volatile LAS unsigned* st) {
    XcdBarrier b; b.bar = bar; b.x = xb_xcc_id(); b.st = st;
    if (threadIdx.x == 0) (void)xb_add(&bar[XB_XCNT(b.x)], 1u);
    return b;
}
__device__ __forceinline__ void xcd_barrier_complete(unsigned* bar, unsigned x, unsigned& nloc, unsigned& nx) {
    const unsigned G = gridDim.x * gridDim.y * gridDim.z;
    unsigned sum, cnt, mine, sp = 0u;
    for (;;) {
        sum = 0u; cnt = 0u; mine = 0u;
#pragma unroll
        for (unsigned j = 0; j < 16; ++j) { const unsigned c = xb_ld(&bar[XB_XCNT(j)]); sum += c; cnt += (c > 0u) ? 1u : 0u; mine = (j == x) ? c : mine; }
        if (sum == G) break;
        __builtin_amdgcn_s_sleep(1);
        if ((++sp & 255u) == 0u) { if (xb_ld(&bar[XB_TMO])) break; if (sp > XB_SPIN_CAP) { atomicAdd(&bar[XB_TMO], 1u); break; } }
    }
    nloc = mine > 0u ? mine : 1u; nx = cnt > 0u ? cnt : 1u;
}

__device__ __forceinline__ void xcd_barrier(const XcdBarrier& b) {
    asm volatile("s_waitcnt vmcnt(0)" ::: "memory");
    __syncthreads();
    if (threadIdx.x == 0) {
        unsigned* bar = b.bar;
        __builtin_amdgcn_s_waitcnt(0);
        unsigned nloc = b.st[0], nx = b.st[1];
        if (nloc == 0u) { xcd_barrier_complete(bar, b.x, nloc, nx); b.st[0] = nloc; b.st[1] = nx; }
        const unsigned old = xb_add(&bar[XB_XSUB(b.x)], 1u);
        const unsigned gen = old / nloc;
        if (old + 1u == (gen + 1u) * nloc) {
            __builtin_amdgcn_fence(__ATOMIC_RELEASE, "agent");
            asm volatile("s_waitcnt vmcnt(0)" ::: "memory");
            const unsigned og = xb_add(&bar[XB_TOP], 1u);
            const unsigned tg = og / nx;
            if (og + 1u == (tg + 1u) * nx) xb_add(&bar[XB_TOPGEN], 1u);
            else XB_SPIN(xb_ld(&bar[XB_TOPGEN]) == tg, bar);
            __builtin_amdgcn_fence(__ATOMIC_ACQUIRE, "agent");
            xb_add(&bar[XB_XGEN(b.x)], 1u);
            asm volatile("s_waitcnt vmcnt(0)" ::: "memory");
        } else {
            XB_SPIN(xb_ld(&bar[XB_XGEN(b.x)]) == gen, bar);
            __builtin_amdgcn_fence(__ATOMIC_ACQUIRE, "agent");
            asm volatile("s_waitcnt vmcnt(0)" ::: "memory");
        }
    }
    __syncthreads();
}
constexpr size_t MiB = 1u << 20;
constexpr size_t WS_CTL = 0, CTL_ZERO_BYTES = 1 * MiB;
constexpr size_t WS_MOD = 1 * MiB;
constexpr size_t WS_ROPE = 2 * MiB;
constexpr size_t WS_WSP = 4 * MiB;
constexpr size_t WS_HC = 5 * MiB;
constexpr size_t WS_RST = 13 * MiB;
constexpr size_t WS_W = 16 * MiB;
constexpr size_t W_IN = 0, W_BR = W_IN + (size_t)IN_DIM * DM * 2, W_O = W_BR + (size_t)3 * DM * 2048 * 2, W_GU = W_O + (size_t)DM * DM * 2, W_D = W_GU + (size_t)2 * FF * DM * 2,
                 W_LAYER = W_D + (size_t)DM * FF * 2;
constexpr size_t WS_Z = WS_W + 2 * W_LAYER;
constexpr size_t WS_ACT = WS_Z + (size_t)MT * IN_DIM * 2;
constexpr size_t WS_XB = WS_ACT + (size_t)MT * DM * 2;
constexpr size_t WS_O12 = WS_XB + (size_t)3 * MT * 2048 * 2;
constexpr size_t WS_QK = WS_O12 + (size_t)MT * DM * 4;
constexpr size_t WS_OS = WS_QK + (size_t)MT * DM * 2;
constexpr int MAX_GRID = 320;
constexpr size_t WS_KVF = WS_OS + (size_t)MAX_GRID * 256 * 128 * 4;
constexpr size_t WS_SLAB = WS_KVF + (size_t)8 * MC * 4096 * 4;
constexpr size_t WS_END = WS_SLAB + (size_t)8 * MC * DM * 4;
static_assert(W_LAYER % 256 == 0 && WS_Z % 256 == 0 && WS_ACT % 256 == 0 && WS_XB % 256 == 0 && WS_O12 % 256 == 0 && WS_QK % 256 == 0 && WS_OS % 256 == 0, "alignment");
constexpr int CW_BAR = 4096;

constexpr int NWAVES = 8;
constexpr int RING_BYTES = 131072, MISC_OFF = RING_BYTES + 320, LDS_BYTES = 147456;
static_assert(true, "");
constexpr int PPL = 9, N_PHASES = 1 + PPL * DEPTH;

__device__ __forceinline__ float sx(float v, int k, int lane) { return __uint_as_float((unsigned)__builtin_amdgcn_ds_bpermute((lane ^ k) << 2, (int)__float_as_uint(v))); }
__device__ __forceinline__ float wave_sum(float v, int lane) {
#pragma unroll
    for (int o = 1; o < 64; o <<= 1) v += sx(v, o, lane);
    return v;
}
__device__ __forceinline__ unsigned pkbf(float lo, float hi) { unsigned r; asm volatile("v_cvt_pk_bf16_f32 %0, %1, %2" : "=v"(r) : "v"(lo), "v"(hi)); return r; }
__device__ __forceinline__ float blo(unsigned w) { return __uint_as_float(w << 16); }
__device__ __forceinline__ float bhi(unsigned w) { return __uint_as_float(w & 0xffff0000u); }
__device__ __forceinline__ void unpack8(const v4u w, float (&x)[8]) { x[0] = blo(w.x); x[1] = bhi(w.x); x[2] = blo(w.y); x[3] = bhi(w.y); x[4] = blo(w.z); x[5] = bhi(w.z); x[6] = blo(w.w); x[7] = bhi(w.w); }
__device__ __forceinline__ v4u pack8(const float (&x)[8]) { v4u w; w.x = pkbf(x[0], x[1]); w.y = pkbf(x[2], x[3]); w.z = pkbf(x[4], x[5]); w.w = pkbf(x[6], x[7]); return w; }

struct Args { const float* in[25]; float* out; unsigned char* ws; int ph_lo, ph_hi, bar_region, pad; };
struct Ctx {
    LAS unsigned char* lds; int tid, lane, wave, vcu, G;
    float* out; unsigned char* ws; int bx;
};
__device__ __forceinline__ Ctx launder(const Ctx& F) {
    Ctx P = F; int t = F.tid; asm volatile("" : "+v"(t)); P.tid = t; P.lane = t & 63; P.wave = __builtin_amdgcn_readfirstlane(t >> 6);
    asm volatile("" : "+s"(P.vcu), "+s"(P.G), "+s"(P.bx)); unsigned long long z = 0; asm volatile("" : "+s"(z)); P.ws = F.ws + z; P.out = F.out + z;
    return P;
}


__device__ __forceinline__ void transpose_item(const float* W, int K, int N, bf16* WT, int k0, int n0, int drow0, LAS float* scr, int lane) {
    float tv[32];
#pragma unroll
    for (int i = 0; i < 32; ++i) { const int kk = 2 * i + (lane >> 5); tv[i] = W[(size_t)(k0 + kk) * N + n0 + (lane & 31)]; }
#pragma unroll
    for (int i = 0; i < 32; ++i) { const int kk = 2 * i + (lane >> 5); scr[kk * 33 + (lane & 31)] = tv[i]; }
    LDS_WAIT(); asm volatile("" ::: "memory");
    const int c = lane & 7;
#pragma unroll
    for (int j = 0; j < 4; ++j) { const int n = (lane >> 3) + 8 * j; const LAS float* s = scr + (8 * c) * 33 + n;
        v4u o; o.x = pkbf(s[0 * 33], s[1 * 33]); o.y = pkbf(s[2 * 33], s[3 * 33]); o.z = pkbf(s[4 * 33], s[5 * 33]); o.w = pkbf(s[6 * 33], s[7 * 33]);
        *(GAS v4u*)(WT + (size_t)(drow0 + n) * K + k0 + 8 * c) = o; }
    LDS_WAIT(); asm volatile("" ::: "memory");
}
template <int MODE> __device__ __forceinline__ void transpose_mat(const float* W, int K, int N, bf16* WT, LAS float* scr, int item, int lane) {
    const int nblk = N / 32, kb = item / nblk, nb = item % nblk, n0 = 32 * nb;
    const int drow0 = MODE == 0 ? n0 : ((n0 >> 7) * 256 + (n0 & 127) + (MODE == 2 ? 128 : 0));
    transpose_item(W, K, N, WT, 64 * kb, n0, drow0, scr, lane);
}

__device__ __forceinline__ void sincos_f(float a, float& s, float& c) {
    const double ad = (double)a; const double kq = __builtin_rint(ad * 0.63661977236758134308); const double r = ad - kq * 1.57079632679489661923; const double r2 = r * r;
    const double sp = r * (1.0 + r2 * (-1.0 / 6 + r2 * (1.0 / 120 + r2 * (-1.0 / 5040 + r2 * (1.0 / 362880 + r2 * (-1.0 / 39916800))))));
    const double cp = 1.0 + r2 * (-0.5 + r2 * (1.0 / 24 + r2 * (-1.0 / 720 + r2 * (1.0 / 40320 + r2 * (-1.0 / 3628800 + r2 * (1.0 / 479001600))))));
    const int q = ((int)kq) & 3;
    const double ss = (q == 0) ? sp : (q == 1) ? cp : (q == 2) ? -sp : -cp;
    const double cc = (q == 0) ? cp : (q == 1) ? -sp : (q == 2) ? -cp : sp;
    s = (float)ss; c = (float)cc;
}

__device__ __forceinline__ void p0_prologue(const Args& A, const Ctx& F) {
    const float* c = A.in[1]; const float* c_ctx = A.in[3]; const float* ada_w = A.in[4]; const float* ada_b = A.in[5];
    const float* norm_mix_g = A.in[6]; const float* norm_ffn_g = A.in[7];
    float* MOD = (float*)(F.ws + WS_MOD);
    LAS float* sv = (LAS float*)F.lds; LAS float* red = (LAS float*)(F.lds + 49152);
    for (int i = F.tid; i < 3 * DM; i += NWAVES * 64) { const int v = i >> 12, k = i & (DM - 1); const float x = v < 2 ? c[v * DM + k] : c_ctx[k]; sv[i] = x / (1.f + __expf(-x)); }
    __syncthreads();
    for (int ch = F.vcu; ch < 256; ch += F.G) {
        const int gcol = ch * 192, l = gcol / NMOD, j0 = gcol % NMOD;
        f32x4 a0 = {0.f, 0.f, 0.f, 0.f}, a1 = a0, a2 = a0;
        if (F.lane < 48) {
            const float* wp = ada_w + (size_t)l * DM * NMOD + (size_t)(F.wave * 512) * NMOD + j0 + F.lane * 4;
            const LAS float* s0 = sv + F.wave * 512;
#pragma unroll 8
            for (int k = 0; k < 512; ++k) { const f32x4 w = *(const f32x4*)(wp + (size_t)k * NMOD); a0 += w * s0[k]; a1 += w * s0[DM + k]; a2 += w * s0[2 * DM + k]; }
            *(LAS f32x4*)(red + (F.wave * 3 + 0) * 192 + F.lane * 4) = a0; *(LAS f32x4*)(red + (F.wave * 3 + 1) * 192 + F.lane * 4) = a1; *(LAS f32x4*)(red + (F.wave * 3 + 2) * 192 + F.lane * 4) = a2;
        }
        __syncthreads();
        for (int o = F.tid; o < 3 * 192; o += NWAVES * 64) { const int v = o / 192, jj = o % 192; float s = 0.f;
#pragma unroll
            for (int w = 0; w < 8; ++w) s += red[(w * 3 + v) * 192 + jj];
            const int j = j0 + jj, q = j >> 12, col = j & (DM - 1); float val = s + ada_b[l * NMOD + j];
            if (q == 1) val = norm_mix_g[l * DM + col] * (1.f + val); else if (q == 4) val = norm_ffn_g[l * DM + col] * (1.f + val);
            MOD[(size_t)(l * 3 + v) * NMOD + j] = val; }
        __syncthreads();
    }
    const int gtid = F.vcu * (NWAVES * 64) + F.tid, NTH = F.G * NWAVES * 64;
    { float* ROPE = (float*)(F.ws + WS_ROPE);
      for (int e = gtid; e < SEQ * 32; e += NTH) { const int t = e >> 5, j = e & 31; const int pos = j < 16 ? (t >> 6) : (t & 63);
          const float inv = exp2f(-(float)(j & 15) * (13.287712379549449f / 16.f)); float s, cs; sincos_f((float)pos * inv, s, cs); ROPE[2 * e] = cs; ROPE[2 * e + 1] = s; } }
    { const float* wsp = A.in[18]; bf16* o = (bf16*)(F.ws + WS_WSP);
      for (int e = gtid; e < DEPTH * 16 * 128 * 128 / 2; e += NTH) ((unsigned*)o)[e] = pkbf(wsp[2 * e], wsp[2 * e + 1]); }
    LAS float* scr = (LAS float*)(F.lds + F.wave * 16384);
    const int gw = F.vcu * NWAVES + F.wave, NGW = F.G * NWAVES;
    constexpr int I_IN = (DM / 64) * (IN_DIM / 32), I_BR = (2048 / 64) * (DM / 32), I_O = (DM / 64) * (DM / 32), I_GU = (DM / 64) * (FF / 32), I_D = (FF / 64) * (DM / 32);
    constexpr int I_LAYER = I_IN + 3 * I_BR + I_O + 2 * I_GU + I_D;
    for (int it = gw; it < DEPTH * I_LAYER; it += NGW) {
        const int l = it / I_LAYER; int r = it - l * I_LAYER; unsigned char* wl = F.ws + WS_W + (size_t)l * W_LAYER;
        if (r < I_IN) { transpose_mat<0>(A.in[8] + (size_t)l * DM * IN_DIM, DM, IN_DIM, (bf16*)(wl + W_IN), scr, r, F.lane); continue; } r -= I_IN;
        if (r < I_BR) { transpose_mat<0>(A.in[11] + (size_t)l * 2048 * DM, 2048, DM, (bf16*)(wl + W_BR), scr, r, F.lane); continue; } r -= I_BR;
        if (r < I_BR) { transpose_mat<0>(A.in[16] + (size_t)l * 2048 * DM, 2048, DM, (bf16*)(wl + W_BR) + (size_t)DM * 2048, scr, r, F.lane); continue; } r -= I_BR;
        if (r < I_BR) { transpose_mat<0>(A.in[20] + (size_t)l * 2048 * DM, 2048, DM, (bf16*)(wl + W_BR) + (size_t)2 * DM * 2048, scr, r, F.lane); continue; } r -= I_BR;
        if (r < I_O) { transpose_mat<0>(A.in[21] + (size_t)l * DM * DM, DM, DM, (bf16*)(wl + W_O), scr, r, F.lane); continue; } r -= I_O;
        if (r < I_GU) { transpose_mat<1>(A.in[22] + (size_t)l * DM * FF, DM, FF, (bf16*)(wl + W_GU), scr, r, F.lane); continue; } r -= I_GU;
        if (r < I_GU) { transpose_mat<2>(A.in[23] + (size_t)l * DM * FF, DM, FF, (bf16*)(wl + W_GU), scr, r, F.lane); continue; } r -= I_GU;
        transpose_mat<0>(A.in[24] + (size_t)l * FF * DM, FF, DM, (bf16*)(wl + W_D), scr, r, F.lane);
    }
}

__device__ __forceinline__ void norm_phase(const Ctx& F, int l, int which, const float* src_lat, const float* src_ctx, int nrows, bool slab_add, bool write_hc) {
    const float* MOD = (const float*)(F.ws + WS_MOD); bf16* XN = (bf16*)(F.ws + WS_ACT);
    const int gw = F.vcu * NWAVES + F.wave, NGW = F.G * NWAVES;
    for (int m = gw; m < nrows; m += NGW) {
        const float* xr = m < ML ? src_lat + (size_t)m * DM : src_ctx + (size_t)(m - ML) * DM;
        const int cls = m < SEQ ? 0 : (m < ML ? 1 : 2);
        const float* sh = MOD + (size_t)(l * 3 + cls) * NMOD + (which ? 3 : 0) * DM; const float* gs = sh + DM;
        f32x4 v[16], gg[16], sg[16]; float ss = 0.f;
#pragma unroll
        for (int j = 0; j < 16; ++j) v[j] = *(const f32x4*)(xr + 4 * F.lane + 256 * j);

        if (slab_add && m >= ML) {
            const float* sl = (const float*)(F.ws + WS_SLAB) + (size_t)(m - ML) * DM + 4 * F.lane;
#pragma clang loop unroll(disable)
            for (int s = 0; s < 8; s += 2) {
                f32x4 ta[16], tb[16];
#pragma unroll
                for (int j = 0; j < 16; ++j) { ta[j] = *(const f32x4*)(sl + (size_t)s * MC * DM + 256 * j); tb[j] = *(const f32x4*)(sl + (size_t)(s + 1) * MC * DM + 256 * j); }
                __builtin_amdgcn_sched_barrier(0);
#pragma unroll
                for (int j = 0; j < 16; ++j) v[j] += ta[j] + tb[j];
                __builtin_amdgcn_sched_barrier(0);
            }
            if (write_hc) { float* hc = (float*)(F.ws + WS_HC) + (size_t)(m - ML) * DM + 4 * F.lane;
#pragma unroll
                for (int j = 0; j < 16; ++j) *(f32x4*)(hc + 256 * j) = v[j]; }
        }
#pragma unroll
        for (int j = 0; j < 16; ++j) { gg[j] = *(const f32x4*)(gs + 4 * F.lane + 256 * j); sg[j] = *(const f32x4*)(sh + 4 * F.lane + 256 * j); }
#pragma unroll
        for (int j = 0; j < 16; ++j) ss += (v[j].x * v[j].x + v[j].y * v[j].y) + (v[j].z * v[j].z + v[j].w * v[j].w);
        const float rstd = __builtin_amdgcn_rsqf(wave_sum(ss, F.lane) * (1.f / DM) + EPS);
        unsigned long long* o8 = (unsigned long long*)(XN + (size_t)m * DM) + F.lane;
#pragma unroll
        for (int j = 0; j < 16; ++j) { const f32x4 g = gg[j], s = sg[j];
            const f32x4 y = v[j] * rstd * g + s;
            o8[64 * j] = (unsigned long long)pkbf(y.x, y.y) | ((unsigned long long)pkbf(y.z, y.w) << 32); }
    }
}

__device__ __forceinline__ void qk_phase(const Args& A, const Ctx& F, int l, int nrows_stat, bool kvf_ctx) {
    typedef unsigned u32x2 __attribute__((ext_vector_type(2)));
    const bf16* Z = (const bf16*)(F.ws + WS_Z); bf16* QK = (bf16*)(F.ws + WS_QK); const float* ROPE = (const float*)(F.ws + WS_ROPE); float* RST = (float*)(F.ws + WS_RST);
    const float* KVF = (const float*)(F.ws + WS_KVF); bf16* Zw = (bf16*)(F.ws + WS_Z);
    const int gw = F.vcu * NWAVES + F.wave, NGW = F.G * NWAVES, p = F.lane & 7, go = (F.lane >> 3) * 64 + 4 * p;
    constexpr float QC = 0.125f * 1.4426950408889634f;
    const f32x4 gq0 = *(const f32x4*)(A.in[12] + l * 64 + 4 * p) * QC, gq1 = *(const f32x4*)(A.in[12] + l * 64 + 32 + 4 * p) * QC;
    const f32x4 gk0 = *(const f32x4*)(A.in[13] + l * 64 + 4 * p), gk1 = *(const f32x4*)(A.in[13] + l * 64 + 32 + 4 * p);
    for (int m = gw; m < MT; m += NGW) {
        const bf16* zr = Z + (size_t)m * IN_DIM + ZC_Q + go; bf16* qr = QK + (size_t)m * DM + go; const bool lat = m < ML; const int t = m & (SEQ - 1);
        f32x4 cs = {1.f, 1.f, 1.f, 1.f}, sn = {0.f, 0.f, 0.f, 0.f};
        if (lat) { const float* rp = ROPE + ((size_t)t * 32 + 4 * p) * 2; const f32x4 w0 = *(const f32x4*)rp, w1 = *(const f32x4*)(rp + 4); cs = (f32x4){w0.x, w0.z, w1.x, w1.z}; sn = (f32x4){w0.y, w0.w, w1.y, w1.w}; }
        if (m < nrows_stat) {
            const bf16* vr = Z + (size_t)m * IN_DIM + ZC_VM; float ss = 0.f;
#pragma unroll
            for (int i = 0; i < 4; ++i) { float x[8]; unpack8(*(const v4u*)(vr + i * 512 + F.lane * 8), x);
#pragma unroll
                for (int e = 0; e < 8; ++e) ss += x[e] * x[e]; }
            ss = wave_sum(ss, F.lane); if (F.lane == 0) RST[m] = __builtin_amdgcn_rsqf(ss * (1.f / 2048.f) + EPS); }
        const bool fromf = kvf_ctx && !lat;
        if (fromf) {
            const float* vr = KVF + (size_t)(m - ML) * 4096 + 2048; bf16* vo = Zw + (size_t)m * IN_DIM + ZC_V;
#pragma unroll
            for (int i = 0; i < 4; ++i) { f32x4 ta[8], tb[8];
#pragma unroll
                for (int s = 0; s < 8; ++s) { ta[s] = *(const f32x4*)(vr + (size_t)s * MC * 4096 + i * 512 + F.lane * 8); tb[s] = *(const f32x4*)(vr + (size_t)s * MC * 4096 + i * 512 + F.lane * 8 + 4); }
                __builtin_amdgcn_sched_barrier(0);
                const f32x4 a = ((ta[0] + ta[1]) + (ta[2] + ta[3])) + ((ta[4] + ta[5]) + (ta[6] + ta[7])), b = ((tb[0] + tb[1]) + (tb[2] + tb[3])) + ((tb[4] + tb[5]) + (tb[6] + tb[7]));
                v4u w; w.x = pkbf(a.x, a.y); w.y = pkbf(a.z, a.w); w.z = pkbf(b.x, b.y); w.w = pkbf(b.z, b.w); *(v4u*)(vo + i * 512 + F.lane * 8) = w; }
        }
        u32x2 wa[8], wb[8];
        if (!fromf) {
#pragma unroll
            for (int i = 0; i < 8; ++i) { wa[i] = *(const u32x2*)(zr + i * 512); wb[i] = *(const u32x2*)(zr + i * 512 + 32); }
        }
        __builtin_amdgcn_sched_barrier(0);
#pragma unroll
        for (int i = 0; i < 8; ++i) {
            f32x4 x1, x2;
            if (fromf) { if (i < 4) continue; const float* kr = KVF + (size_t)(m - ML) * 4096 + (i - 4) * 512 + go; f32x4 ta[8], tb[8];
#pragma unroll
                for (int s = 0; s < 8; ++s) { ta[s] = *(const f32x4*)(kr + (size_t)s * MC * 4096); tb[s] = *(const f32x4*)(kr + (size_t)s * MC * 4096 + 32); }
                __builtin_amdgcn_sched_barrier(0);
                x1 = ((ta[0] + ta[1]) + (ta[2] + ta[3])) + ((ta[4] + ta[5]) + (ta[6] + ta[7])); x2 = ((tb[0] + tb[1]) + (tb[2] + tb[3])) + ((tb[4] + tb[5]) + (tb[6] + tb[7])); }
            else { const u32x2 w0 = wa[i], w1 = wb[i];
                x1 = (f32x4){blo(w0.x), bhi(w0.x), blo(w0.y), bhi(w0.y)}; x2 = (f32x4){blo(w1.x), bhi(w1.x), blo(w1.y), bhi(w1.y)}; }
            float ss = (x1.x * x1.x + x1.y * x1.y) + (x1.z * x1.z + x1.w * x1.w) + (x2.x * x2.x + x2.y * x2.y) + (x2.z * x2.z + x2.w * x2.w);
            ss += sx(ss, 1, F.lane); ss += sx(ss, 2, F.lane); ss += sx(ss, 4, F.lane);
            const float r = __builtin_amdgcn_rsqf(ss * (1.f / 64.f) + EPS);
            x1 = x1 * r * (i < 4 ? gq0 : gk0); x2 = x2 * r * (i < 4 ? gq1 : gk1);
            const f32x4 y1 = x1 * cs - x2 * sn, y2 = x2 * cs + x1 * sn;
            u32x2 o0, o1; o0.x = pkbf(y1.x, y1.y); o0.y = pkbf(y1.z, y1.w); o1.x = pkbf(y2.x, y2.y); o1.y = pkbf(y2.z, y2.w);
            *(u32x2*)(qr + i * 512) = o0; *(u32x2*)(qr + i * 512 + 32) = o1;
        }
    }
}

__device__ __forceinline__ void conv_phase(const Args& A, const Ctx& F, int l, int nrows) {
    const bf16* Z = (const bf16*)(F.ws + WS_Z); bf16* CV = (bf16*)(F.ws + WS_XB);
    const float* cw = A.in[9] + (size_t)l * 3 * 2048; const float* cb = A.in[10] + (size_t)l * 2048;
    const int gtid = F.vcu * (NWAVES * 64) + F.tid, NTH = F.G * NWAVES * 64;
    for (int it = gtid; it < (nrows / 2) * 256; it += NTH) {
        const int m = 2 * (it >> 8), c = (it & 255) * 8;
        const int t = m < ML ? (m & (SEQ - 1)) : ((m - ML) & (CTXL - 1)), T = m < ML ? SEQ : CTXL;
        const bf16* zr = Z + (size_t)m * IN_DIM + c;
        const bool hp = t > 0, hn = t + 2 < T;
        const v4u zero = {0u, 0u, 0u, 0u};
        const v4u bgA = *(const v4u*)(zr + ZC_BG), bgB = *(const v4u*)(zr + IN_DIM + ZC_BG);
        const v4u c0 = *(const v4u*)(zr + ZC_CG), x0 = *(const v4u*)(zr + ZC_XIN), c1 = *(const v4u*)(zr + IN_DIM + ZC_CG), x1 = *(const v4u*)(zr + IN_DIM + ZC_XIN);
        const v4u cp = hp ? *(const v4u*)(zr - IN_DIM + ZC_CG) : zero, xp = hp ? *(const v4u*)(zr - IN_DIM + ZC_XIN) : zero;
        const v4u cn = hn ? *(const v4u*)(zr + 2 * IN_DIM + ZC_CG) : zero, xn = hn ? *(const v4u*)(zr + 2 * IN_DIM + ZC_XIN) : zero;
        const f32x4 w00 = *(const f32x4*)(cw + c), w01 = *(const f32x4*)(cw + c + 4), w10 = *(const f32x4*)(cw + 2048 + c), w11 = *(const f32x4*)(cw + 2048 + c + 4);
        const f32x4 w20 = *(const f32x4*)(cw + 4096 + c), w21 = *(const f32x4*)(cw + 4096 + c + 4), b0 = *(const f32x4*)(cb + c), b1 = *(const f32x4*)(cb + c + 4);
        float a[8], b[8], zp[8], z0[8], z1[8], zn[8], gA[8], gB[8];
        unpack8(cp, a); unpack8(xp, b);
#pragma unroll
        for (int e = 0; e < 8; ++e) zp[e] = a[e] * b[e];
        unpack8(c0, a); unpack8(x0, b);
#pragma unroll
        for (int e = 0; e < 8; ++e) z0[e] = a[e] * b[e];
        unpack8(c1, a); unpack8(x1, b);
#pragma unroll
        for (int e = 0; e < 8; ++e) z1[e] = a[e] * b[e];
        unpack8(cn, a); unpack8(xn, b);
#pragma unroll
        for (int e = 0; e < 8; ++e) zn[e] = a[e] * b[e];
        unpack8(bgA, gA); unpack8(bgB, gB);
        float yA[8], yB[8];
#pragma unroll
        for (int e = 0; e < 4; ++e) {
            yA[e] = gA[e] * (zp[e] * w00[e] + z0[e] * w10[e] + z1[e] * w20[e] + b0[e]); yA[4 + e] = gA[4 + e] * (zp[4 + e] * w01[e] + z0[4 + e] * w11[e] + z1[4 + e] * w21[e] + b1[e]);
            yB[e] = gB[e] * (z0[e] * w00[e] + z1[e] * w10[e] + zn[e] * w20[e] + b0[e]); yB[4 + e] = gB[4 + e] * (z0[4 + e] * w01[e] + z1[4 + e] * w11[e] + zn[4 + e] * w21[e] + b1[e]); }
        *(v4u*)(CV + (size_t)m * 2048 + c) = pack8(yA); *(v4u*)(CV + (size_t)(m + 1) * 2048 + c) = pack8(yB);
    }
}

__device__ __forceinline__ void mlp_unit(const Args& A, const Ctx& F, int l, int chunk, int g) {
    const bf16* Z = (const bf16*)(F.ws + WS_Z); bf16* MO = (bf16*)(F.ws + WS_XB) + (size_t)2 * MT * 2048; const float* RST = (const float*)(F.ws + WS_RST);
    const bf16* WSP = (const bf16*)(F.ws + WS_WSP) + ((size_t)l * 16 + g) * 128 * 128;
    const float* gnorm = A.in[17] + (size_t)l * 2048 + g * 128; const float* bsp = A.in[19] + ((size_t)l * 16 + g) * 128;
    LAS unsigned char* Vl = F.lds;
    const int r32 = F.lane & 31, hi = F.lane >> 5, rb = F.wave & 3, ch = F.wave >> 2, sr = F.tid >> 4, sc = (F.tid & 15) * 8, row0 = chunk * 128;
    att::bf16x8 pa[2][4];
#pragma unroll
    for (int kt = 0; kt < 2; ++kt)
#pragma unroll
        for (int s = 0; s < 4; ++s) pa[kt][s] = *(const att::bf16x8*)(WSP + (size_t)(32 * rb + r32) * 128 + 64 * kt + 16 * s + 8 * hi);
    const f32x4 gn0 = *(const f32x4*)(gnorm + sc), gn1 = *(const f32x4*)(gnorm + sc + 4);
#pragma unroll
    for (int i = 0; i < 4; ++i) { const int q = sr + 32 * i; float x[8]; unpack8(*(const v4u*)(Z + (size_t)(row0 + q) * IN_DIM + ZC_VM + g * 128 + sc), x);
        const float r = RST[row0 + q];
#pragma unroll
        for (int e = 0; e < 4; ++e) { x[e] = x[e] * r * gn0[e]; x[4 + e] = x[4 + e] * r * gn1[e]; }
        *(LAS v4u*)(Vl + (q >> 6) * 16384 + att::v_st(q & 63, sc)) = pack8(x); }
    __syncthreads();
    att::f32x16 acc0 = {}, acc1 = {};
#pragma unroll
    for (int kt = 0; kt < 2; ++kt) { const int vb = (int)(uintptr_t)Vl + kt * 16384 + ch * 1024 + att::v_rd_base(F.lane);
        att::pv_one<0>(acc0, vb, pa[kt][0], pa[kt][1], pa[kt][2], pa[kt][3]); att::pv_one<1>(acc1, vb, pa[kt][0], pa[kt][1], pa[kt][2], pa[kt][3]); }
    float bias[16]; bf16 u0[16], u1[16];
    const int col = g * 128 + ch * 64 + r32;
#pragma unroll
    for (int r = 0; r < 16; ++r) { const int pr = 32 * rb + att::crow(r, hi); const size_t row = (size_t)(row0 + pr);
        bias[r] = bsp[pr]; u0[r] = Z[row * IN_DIM + ZC_U + col]; u1[r] = Z[row * IN_DIM + ZC_U + col + 32]; }
    __builtin_amdgcn_sched_barrier(0);
#pragma unroll
    for (int r = 0; r < 16; ++r) { const int pr = 32 * rb + att::crow(r, hi); const size_t row = (size_t)(row0 + pr);
        const float a0 = __uint_as_float((unsigned)u0[r] << 16), a1 = __uint_as_float((unsigned)u1[r] << 16);
        MO[row * 2048 + col] = (bf16)(pkbf(a0 * (acc0[r] + bias[r]), 0.f) & 0xffffu); MO[row * 2048 + col + 32] = (bf16)(pkbf(a1 * (acc1[r] + bias[r]), 0.f) & 0xffffu); }
    __syncthreads();
}

__device__ __forceinline__ void attn_phase(const Args& A, const Ctx& F, int l, bool with_ctx, float lam_init) {
    static_assert(att::SHM_ATTN <= RING_BYTES, "attention LDS vs frame");
    const int nchunk = (with_ctx ? MT : ML) / 128;
    const bf16* Z = (const bf16*)(F.ws + WS_Z); const bf16* QK = (const bf16*)(F.ws + WS_QK); bf16* AO = (bf16*)(F.ws + WS_XB) + (size_t)MT * 2048;
    float* OS = (float*)(F.ws + WS_OS) + (size_t)F.vcu * 256 * 128;
    const float* lq = A.in[14] + (size_t)l * 256;
    const float s01 = wave_sum(lq[F.lane] * lq[64 + F.lane], F.lane), s23 = wave_sum(lq[128 + F.lane] * lq[192 + F.lane], F.lane);
    const float lam = __uint_as_float(__builtin_amdgcn_readfirstlane(__float_as_uint(expf(s01) - expf(s23) + lam_init))), osc = 1.f - lam_init;
    const float* subg = A.in[15] + (size_t)l * 128;
    float gqm = fabsf(A.in[12][l * 64 + F.lane]), gkm = fabsf(A.in[13][l * 64 + F.lane]);
#pragma unroll
    for (int o = 1; o < 64; o <<= 1) { gqm = fmaxf(gqm, sx(gqm, o, F.lane)); gkm = fmaxf(gkm, sx(gkm, o, F.lane)); }
    const float m0c = __uint_as_float(__builtin_amdgcn_readfirstlane(__float_as_uint(0.125f * 64.f * 1.02f * gqm * gkm * 1.4426950408889634f)));
    const int npair = 1024 + (with_ctx ? 32 : 0);
    for (int u = F.vcu; u < npair; u += F.G) {
        const bool isl = u < 1024; const int bh = isl ? (u >> 5) : (u - 1024), b = bh >> 4, h = bh & 15;
        const int qrow = isl ? b * SEQ + (u & 31) * 256 : ML + b * CTXL;
        const int rowa = isl ? b * SEQ : qrow, nt0 = isl ? SEQ / 64 : CTXL / 64, rowb = ML + b * CTXL, NT = isl ? SEQ / 64 + CTXL / 64 : CTXL / 64;
#pragma clang loop unroll(disable)
        for (int mp = 0; mp < 2; ++mp)
            att::attn_unit(mp, QK + (size_t)qrow * DM + h * 128 + mp * 64, QK + 2048 + h * 128 + mp * 64, Z + ZC_V + h * 128, OS, AO + (size_t)qrow * 2048 + h * 128, subg, lam, osc, m0c,
                           rowa, nt0, rowb, NT, (char*)F.lds, F.tid);
    }
    {   unsigned* tk = (unsigned*)(F.ws + WS_CTL) + 131072 + (8 + l) * 32; volatile LAS unsigned* slot = (volatile LAS unsigned*)(F.lds + 147440); const int nu = nchunk * 16;
        __syncthreads();
        if (F.tid == 0) slot[0] = __hip_atomic_fetch_add(tk, 1u, __ATOMIC_RELAXED, __HIP_MEMORY_SCOPE_AGENT);
        __syncthreads();
#pragma clang loop unroll(disable)
        for (int k = 0;; ++k) {
            const int u = __builtin_amdgcn_readfirstlane((int)slot[k & 1]);
            if (u >= nu) break;
            unsigned t = 0u; if (F.tid == 0) t = __hip_atomic_fetch_add(tk, 1u, __ATOMIC_RELAXED, __HIP_MEMORY_SCOPE_AGENT);
            mlp_unit(A, F, l, u >> 4, u & 15);
            if (F.tid == 0) slot[(k + 1) & 1] = t;
            __syncthreads();
        }
    }
}

__global__ void __launch_bounds__(NWAVES * 64, 2) fwd_kernel(Args args) {
    extern __shared__ __attribute__((aligned(16))) unsigned char lds[];
    Ctx F;
    F.lds = (LAS unsigned char*)lds; F.tid = threadIdx.x; F.lane = F.tid & 63; F.wave = __builtin_amdgcn_readfirstlane(F.tid >> 6);
    F.G = gridDim.x; F.bx = blockIdx.x; { const int bx = blockIdx.x; F.vcu = (F.G % 8 == 0) ? (bx % 8) * (F.G / 8) + bx / 8 : bx; }
    F.out = args.out; F.ws = args.ws;
    volatile LAS unsigned* MISC = (volatile LAS unsigned*)(F.lds + MISC_OFF);
    for (int u = F.tid; u < (LDS_BYTES - RING_BYTES) / 4; u += NWAVES * 64) ((LAS unsigned*)(F.lds + RING_BYTES))[u] = 0u;
    __syncthreads();
    const int lo = args.ph_lo, hi = args.ph_hi;
    unsigned* barw = (unsigned*)(F.ws + WS_CTL) + CW_BAR + args.bar_region * XCD_BAR_WORDS;
    XcdBarrier bar; bar.bar = barw; bar.x = 0; bar.st = nullptr;
    if (hi - lo > 1) bar = xcd_barrier_post(barw, MISC + 8);
#ifndef PHM
#define PHM 0xfff
#endif
#define IN(k) (lo <= (k) && (k) < hi)
#ifndef PROBE_BASE
#define PROBE_BASE 0
#endif
#ifdef PROBE_PHASE
#define PT0(k) do { if ((k) == PROBE_PHASE) { pc0 = __builtin_readcyclecounter(); pt0 = __builtin_amdgcn_s_memrealtime(); } } while (0)
#define PT1(k) do { if ((k) == PROBE_PHASE) { pc1 = __builtin_readcyclecounter(); pt1 = __builtin_amdgcn_s_memrealtime(); } } while (0)
#else
#define PT0(k) do {} while (0)
#define PT1(k) do {} while (0)
#endif
#if defined(CLOCK_PROBE) && CLOCK_PROBE == 9
#define SEAM(k) do { if (IN(k) && IN((k) + 1)) { const unsigned long long ta_ = __builtin_amdgcn_s_memrealtime(); xcd_barrier(bar); pwait += __builtin_amdgcn_s_memrealtime() - ta_; } } while (0)
#else
#define SEAM(k) do { if (IN(k) && IN((k) + 1)) xcd_barrier(bar); } while (0)
#endif

#if defined(CLOCK_PROBE) || defined(PROBE_PHASE)
    unsigned long long pc0 = 0, pc1 = 0, pt0 = 0, pt1 = 1, pwait = 0; (void)pwait; (void)pc0; (void)pc1;
#endif
    if ((PHM & 1) && IN(0)) { PT0(0); const Ctx P = launder(F); p0_prologue(args, P); PT1(0); SEAM(0); }

    for (int l = 0; l < DEPTH; ++l) {
        const int pb = 1 + PPL * l; const bool last = l + 1 == DEPTH; const int MR = last ? ML : MT;
#define TK(k) ((unsigned*)(P.ws + WS_CTL) + 131072 + (l * 4 + (k)) * 32)
#define PTRS() bf16* Zb = (bf16*)(P.ws + WS_Z); bf16* ACT = (bf16*)(P.ws + WS_ACT); bf16* XB = (bf16*)(P.ws + WS_XB); float* YF = (float*)(P.ws + WS_O12); float* HC = (float*)(P.ws + WS_HC); \
        bf16* HID = (bf16*)(P.ws + WS_Z); const unsigned char* wl = P.ws + WS_W + (size_t)l * W_LAYER; const float* MODl = (const float*)(P.ws + WS_MOD) + (size_t)l * 3 * NMOD; \
        const float* h_lat = l == 0 ? args.in[0] : P.out; const float* h_ctx = l == 0 ? args.in[2] : HC; \
        (void)Zb; (void)ACT; (void)XB; (void)YF; (void)HC; (void)HID; (void)wl; (void)MODl; (void)h_lat; (void)h_ctx;
        if ((PHM & 2) && IN(pb + 0)) { PT0(pb + 0); const Ctx P = launder(F); PTRS(); norm_phase(P, l, 0, h_lat, h_ctx, MT, l > 0, false); PT1(pb + 0); SEAM(pb + 0); }
        if ((PHM & 4) && IN(pb + 1)) { PT0(pb + 1); const Ctx P = launder(F); PTRS();
            pg8::Gemm g{ACT, (const bf16*)(wl + W_IN), MT, IN_DIM, DM}; pg8::InOrder S; S.init(P.G, P.bx, last); S.S.ticketed(TK(0), P.lds);
            pg8::EpiZ E{Zb, (float*)(P.ws + WS_KVF)};
            pg8::gemm_phase<pg8::EpiZ, pg8::InOrder, true, true>(P.lds, P.tid, g, S, E);
            PT1(pb + 1); SEAM(pb + 1);
        }
        if ((PHM & 8) && IN(pb + 2)) { PT0(pb + 2); { const Ctx P = launder(F); qk_phase(args, P, l, MR, last); } { const Ctx P = launder(F); conv_phase(args, P, l, MR); } PT1(pb + 2); SEAM(pb + 2); }
        if ((PHM & 16) && IN(pb + 3)) { PT0(pb + 3); const Ctx P = launder(F); attn_phase(args, P, l, !last, l == 0 ? 0.2f : 0.35550906759096924f); PT1(pb + 3); SEAM(pb + 3); }
        if ((PHM & 64) && IN(pb + 4)) { PT0(pb + 4); const Ctx P = launder(F); PTRS();
            pg8::Gemm g{XB, (const bf16*)(wl + W_BR), 3 * MT, 3 * DM, 2048}; pg8::BranchOrder S{P.G, P.bx, MR / 256};
            pg8::EpiBr E{Zb, ACT};
            pg8::gemm_phase<pg8::EpiBr, pg8::BranchOrder, true, true>(P.lds, P.tid, g, S, E);
            PT1(pb + 4); SEAM(pb + 4);
        }
        if ((PHM & 128) && IN(pb + 5)) { PT0(pb + 5); const Ctx P = launder(F); PTRS();
            pg8::Gemm g{ACT, (const bf16*)(wl + W_O), MR, DM, DM}; pg8::ResOrder S; S.init(P.G, P.bx, DM, !last); S.S.ticketed(TK(1), P.lds);
            pg8::EpiRes E{h_lat, h_ctx, P.out, HC, MODl + 2 * DM, (float*)(P.ws + WS_SLAB)};
            pg8::gemm_phase<pg8::EpiRes, pg8::ResOrder, true, true>(P.lds, P.tid, g, S, E);
            PT1(pb + 5); SEAM(pb + 5);
        }
        if ((PHM & 256) && IN(pb + 6)) { PT0(pb + 6); const Ctx P = launder(F); PTRS(); norm_phase(P, l, 1, P.out, l == 0 ? args.in[2] : HC, MR, !last, !last); PT1(pb + 6); SEAM(pb + 6); }
        if ((PHM & 512) && IN(pb + 7)) { PT0(pb + 7); const Ctx P = launder(F); PTRS();
            pg8::Gemm g{ACT, (const bf16*)(wl + W_GU), MR, 2 * FF, DM}; pg8::StaticOrder S; S.init(MR, 2 * FF, P.G, P.bx, DM); S.ticketed(TK(2), P.lds);
            pg8::EpiGU E{HID};
            pg8::gemm_phase<pg8::EpiGU, pg8::StaticOrder, true, true>(P.lds, P.tid, g, S, E);
            PT1(pb + 7); SEAM(pb + 7);
        }
        if ((PHM & 1024) && IN(pb + 8)) { PT0(pb + 8); const Ctx P = launder(F); PTRS();
            pg8::Gemm g{HID, (const bf16*)(wl + W_D), MR, DM, FF}; pg8::ResOrder S; S.init(P.G, P.bx, FF, !last); S.S.ticketed(TK(3), P.lds);
            pg8::EpiRes E{P.out, HC, P.out, HC, MODl + 5 * DM, (float*)(P.ws + WS_SLAB)};
            pg8::gemm_phase<pg8::EpiRes, pg8::ResOrder, true, true>(P.lds, P.tid, g, S, E);
            PT1(pb + 8); SEAM(pb + 8);
        }
    }
#if defined(CLOCK_PROBE) || defined(PROBE_PHASE)
    {
        unsigned* pa = (unsigned*)(F.ws + WS_CTL) + 65536;
        if (threadIdx.x == 0) pa[blockIdx.x] = (unsigned)(pt1 - pt0);
        xcd_barrier(bar);
        float val = 0.f;
#ifdef PROBE_PHASE
        if (blockIdx.x == 0 && threadIdx.x == 0) { unsigned mx = 0, mn = 0xffffffffu; unsigned long long sm = 0; int imx = 0;
            for (unsigned b = 0; b < gridDim.x; ++b) { const unsigned v = __hip_atomic_load(pa + b, __ATOMIC_RELAXED, __HIP_MEMORY_SCOPE_AGENT); sm += v; if (v > mx) { mx = v; imx = (int)b; } if (v < mn) mn = v; }
            const float ghz = (float)(pc1 - pc0) / (float)(pt1 - pt0) * 0.1f;
            float xm[8]; unsigned xc[8];
            for (int x = 0; x < 8; ++x) { xm[x] = 0.f; xc[x] = 0; }
            for (unsigned b = 0; b < gridDim.x; ++b) { const unsigned v = __hip_atomic_load(pa + b, __ATOMIC_RELAXED, __HIP_MEMORY_SCOPE_AGENT); xm[b & 7] += (float)v; xc[b & 7]++; }
            float xmax = 0.f, xmin = 1e30f; int ixmax = 0;
            for (int x = 0; x < 8; ++x) { const float m = xm[x] / (float)xc[x]; if (m > xmax) { xmax = m; ixmax = x; } if (m < xmin) xmin = m; }
            if (PROBE_KIND == 9) val = ((float)mx - (float)(sm / gridDim.x)) * 0.01f + 35.f; else if (PROBE_KIND == 8) val = (float)mx * 0.01f - (float)PROBE_BASE; else if (PROBE_KIND == 7) val = 10.f * ((float)mx * 0.001f - (float)PROBE_BASE); else if (PROBE_KIND == 5) val = (xmax - xmin) * 0.01f; else if (PROBE_KIND == 6) val = 40.f + 10.f * (float)ixmax; else
            val = PROBE_KIND == 0 ? (float)mx * 0.001f : PROBE_KIND == 1 ? (float)(mx - mn) * 0.01f : PROBE_KIND == 2 ? (float)(sm / gridDim.x) * 0.001f : PROBE_KIND == 3 ? (float)(imx & 7) * 10.f + 1.f : 100.f * ghz; }
#else
        val = CLOCK_PROBE == 9 ? (float)pwait * 0.001f : 0.f;
#endif
        f32x4* o4 = (f32x4*)F.out; const size_t n4 = (size_t)ML * DM / 4, per = n4 / gridDim.x;
        for (size_t i = (size_t)blockIdx.x * per + threadIdx.x; i < (size_t)(blockIdx.x + 1) * per; i += NWAVES * 64) o4[i] = (f32x4){3000.f, 3000.f, 3000.f, 3000.f};
        __syncthreads();
        if (blockIdx.x == 0 && threadIdx.x == 0) { asm volatile("s_waitcnt vmcnt(0)" ::: "memory"); F.out[0] = 100.f * val; }
    }
#endif
#undef IN
#undef SEAM
}

#ifndef MK_PER_PHASE
#define MK_PER_PHASE 0
#endif
extern "C" void kernel_launch(void* const* d_in, const int* in_sizes, int n_in, void* d_out, int out_size, void* d_ws, size_t ws_size, hipStream_t stream) {
    static int grid = 0;
    if (grid == 0) {
        if (n_in != 25 || in_sizes[0] != ML * DM || out_size != ML * DM || ws_size < WS_END) {
            fprintf(stderr, "kernel_launch: shape mismatch: n_in %d in0 %d out %d ws %zu (need %zu); nothing launched\n", n_in, n_in > 0 ? in_sizes[0] : -1, out_size, ws_size, (size_t)WS_END); grid = -1; return; }
        int dev = 0, cus = 0, per_cu = 0;
        if (hipGetDevice(&dev) != hipSuccess || hipDeviceGetAttribute(&cus, hipDeviceAttributeMultiprocessorCount, dev) != hipSuccess) { grid = -1; return; }
        if (hipFuncSetAttribute((const void*)fwd_kernel, hipFuncAttributeMaxDynamicSharedMemorySize, LDS_BYTES) != hipSuccess) { fprintf(stderr, "kernel_launch: hipFuncSetAttribute failed\n"); grid = -1; return; }
        if (hipOccupancyMaxActiveBlocksPerMultiprocessor(&per_cu, (const void*)fwd_kernel, NWAVES * 64, LDS_BYTES) != hipSuccess || per_cu < 1)
            fprintf(stderr, "kernel_launch: note: occupancy query reports %d workgroups per CU\n", per_cu);
        (void)hipGetLastError();
        grid = cus > MAX_GRID ? MAX_GRID : cus;
    }
    if (grid < 0) return;
    if (hipMemsetAsync((char*)d_ws + WS_CTL, 0, CTL_ZERO_BYTES, stream) != hipSuccess) return;
    Args a{};
    for (int i = 0; i < 25; ++i) a.in[i] = (const float*)d_in[i];
    a.out = (float*)d_out; a.ws = (unsigned char*)d_ws; a.pad = 0;
#if MK_PER_PHASE
    constexpr int NL = N_PHASES; int rl[NL][2]; for (int p = 0; p < NL; ++p) { rl[p][0] = p; rl[p][1] = p + 1; }
#elif defined(PROBE_SEQ)
    const int rl[][2] = PROBE_SEQ; constexpr int NL = sizeof(rl) / sizeof(rl[0]);
#else
    constexpr int NL = 1; const int rl[1][2] = {{0, N_PHASES}};
#endif
    for (int li = 0; li < NL; ++li) { a.ph_lo = rl[li][0]; a.ph_hi = rl[li][1]; a.bar_region = li;
        hipLaunchKernelGGL(fwd_kernel, dim3(grid), dim3(NWAVES * 64), LDS_BYTES, stream, a); }
    const hipError_t le = hipPeekAtLastError();
    if (le != hipSuccess) fprintf(stderr, "kernel_launch: launch failed: %s\n", hipGetErrorName(le));
}
```

```cpp
#include <hip/hip_runtime.h>
#include <hip/hip_bf16.h>
#include <cstdio>
#include <cstdint>

constexpr int DM = 4096, NBATCH = 2, SEQ = 8192, CTXL = 256, DEPTH = 2;
constexpr int ML = NBATCH * SEQ, MC = NBATCH * CTXL, MT = ML + MC;
constexpr int IN_DIM = 28672, FF = 11008, NMOD = 6 * DM;
constexpr int ZC_BG = 0, ZC_CG = 2048, ZC_XIN = 4096, ZC_Q = 6144, ZC_K = 8192, ZC_V = 10240, ZC_U = 12288, ZC_VM = 14336, ZC_GATE = 16384;
constexpr float EPS = 1e-6f;
constexpr int NTM = MT / 256;

namespace pg8 {
#define PG8_LAS __attribute__((address_space(3)))
typedef unsigned short bf16_t;
typedef short bf16x8 __attribute__((ext_vector_type(8)));
typedef float f32x4 __attribute__((ext_vector_type(4)));
typedef unsigned u32x4 __attribute__((ext_vector_type(4)));
constexpr int BM = 256, BK = 64, HALF = 128, HTB = HALF * BK * 2  , STAGE_BYTES = 8 * HTB, NXCD = 8, WGM = 4;

__host__ __device__ __forceinline__ int lds_byte(int r, int c) { const int st = (r >> 4) * 2 + (c >> 5), rr = r & 15, cc = c & 31, ob = rr * 64 + cc * 2; return st * 1024 + (ob ^ (((ob >> 9) & 1) << 5)); }
__host__ __device__ __forceinline__ void stage_rc(int b, int& R, int& C) { const int st = b / 1024, sb = b % 1024, swz = sb ^ (((sb >> 9) & 1) << 5); R = (st >> 1) * 16 + swz / 64; C = (st & 1) * 32 + (swz % 64) / 2; }
__host__ __device__ __forceinline__ int perm32(int rho) { const int n = rho >> 4, i = rho & 15; return 8 * (i >> 2) + 4 * n + (i & 3); }

struct Unit { int pm, pn, k0, nk, ks; };
struct Gemm { const bf16_t* A; const bf16_t* Bt; int M, N, K; };

#ifndef XROT
#define XROT 0
#endif
struct StaticOrder {
    int nM, nN, nwg, G, c, nkf;
    int rs; unsigned* tk; PG8_LAS unsigned* slot;
    __host__ __device__ void init(int M, int N, int G_, int c_, int K_) { nM = M / BM; nN = N / BM; nwg = nM * nN; G = G_; c = c_; nkf = K_ / BK; rs = 0x7fffffff; tk = nullptr; slot = nullptr; }
    __device__ void ticketed(unsigned* t, PG8_LAS unsigned char* lds) { const int r = nwg / G; if (r >= 3 && !(G & 7)) { rs = r - 1; tk = t; slot = (PG8_LAS unsigned*)(lds + 147440); } }
    __device__ __forceinline__ long lin_t(int i) const {
        if (i + 1 < rs) return lin(i);
        if (threadIdx.x == 0) { const unsigned t = __hip_atomic_fetch_add(tk, 1u, __ATOMIC_RELAXED, __HIP_MEMORY_SCOPE_AGENT); *(volatile PG8_LAS unsigned*)(slot + ((i + 1) & 1)) = t; }
        if (i < rs) return lin(i);
        const unsigned t = *(volatile PG8_LAS unsigned*)(slot + (i & 1));
        return (long)rs * G + (long)__builtin_amdgcn_readfirstlane((int)t);
    }
    __host__ __device__ long lin(int i) const { return (G & 7) ? (long)i * G + c : (long)i * G + (long)((c + XROT) & 7) * (G >> 3) + (c >> 3); }
    __host__ __device__ void tile_of(int U, int& pm, int& pn) const {
        constexpr int CW = 8, R = WGM; const int cc = U / (nM * CW); int cw = nN - cc * CW; cw = cw > CW ? CW : cw;
        const int up = U - cc * nM * CW, g = up / (R * cw); int rg = nM - R * g; rg = rg > R ? R : rg;
        const int upp = up - g * R * cw; pn = cc * CW + upp / rg; pm = R * g + upp % rg;
    }
    __device__ __forceinline__ bool from_lin(long L, Unit& u) const {
        if (L >= nwg) return false;
        tile_of((int)L, u.pm, u.pn); u.k0 = 0; u.nk = nkf; u.ks = -1; return true;
    }
    __device__ __forceinline__ bool next(int i, Unit& u) const { return from_lin(lin_t(i), u); }
    __device__ __forceinline__ void a_ready(const Unit&) const {}
    __device__ __forceinline__ void done(const Unit&) const {}
};

__device__ __forceinline__ unsigned cvt_pk_bf16(float lo, float hi) { unsigned r; asm volatile("v_cvt_pk_bf16_f32 %0, %1, %2" : "=v"(r) : "v"(lo), "v"(hi)); return r; }
typedef float f32x2 __attribute__((ext_vector_type(2)));
__device__ __forceinline__ float fsigmoid(float x) { return __builtin_amdgcn_rcpf(1.f + __builtin_amdgcn_exp2f(-1.4426950408889634f * x)); }
__device__ __forceinline__ float fgelu(float x) { const float t = x * (1.f + 0.044715f * x * x); return x * __builtin_amdgcn_rcpf(1.f + __builtin_amdgcn_exp2f(-2.3022081981f * t)); }
__device__ __forceinline__ float bflo(unsigned w) { return __uint_as_float(w << 16); }
__device__ __forceinline__ float bfhi(unsigned w) { return __uint_as_float(w & 0xffff0000u); }

struct EpiZ {
    static constexpr bool PERM = true, AFTER_DRAIN = false, DRAIN_AFTER = false;
    __device__ static __forceinline__ bool reset_after(const Unit&) { return true; }
    bf16_t* Z; float* KVF;
    __device__ __forceinline__ void operator()(const f32x4 (&acc)[2][2][4][2], const Unit& u, int wr, int wc, int fr, int fq) const {
        const int row0 = u.pm * BM + wr * 64 + fr, col0 = u.pn * BM + wc * 32 + 8 * fq;
        if (u.ks >= 0) {
            float* slab = KVF + (size_t)u.ks * MC * 4096;
#pragma unroll
            for (int ai = 0; ai < 2; ++ai)
#pragma unroll
                for (int m = 0; m < 4; ++m) { float* rowp = slab + (size_t)(row0 - ML + ai * HALF + m * 16) * 4096 + (col0 - ZC_K);
#pragma unroll
                    for (int bj = 0; bj < 2; ++bj) { *(f32x4*)(rowp + bj * HALF) = acc[ai][bj][m][0]; *(f32x4*)(rowp + bj * HALF + 4) = acc[ai][bj][m][1]; } }
            return;
        }
        const int mode = u.pn < 48 ? 0 : (u.pn < 64 ? 1 : 2);
#pragma unroll
        for (int ai = 0; ai < 2; ++ai)
#pragma unroll
            for (int m = 0; m < 4; ++m) { bf16_t* rowp = Z + (size_t)(row0 + ai * HALF + m * 16) * IN_DIM + col0;
#pragma unroll
                for (int bj = 0; bj < 2; ++bj) { f32x4 v0 = acc[ai][bj][m][0], v1 = acc[ai][bj][m][1];
                    if (mode == 1) {
#pragma unroll
                        for (int e = 0; e < 4; ++e) { v0[e] = fgelu(v0[e]); v1[e] = fgelu(v1[e]); } }
                    else if (mode == 2) {
#pragma unroll
                        for (int e = 0; e < 4; ++e) { v0[e] = fmaxf(fsigmoid(v0[e]), 1e-7f); v1[e] = fmaxf(fsigmoid(v1[e]), 1e-7f); } }
                    u32x4 w; w.x = cvt_pk_bf16(v0[0], v0[1]); w.y = cvt_pk_bf16(v0[2], v0[3]); w.z = cvt_pk_bf16(v1[0], v1[1]); w.w = cvt_pk_bf16(v1[2], v1[3]);
                    *(u32x4*)(rowp + bj * HALF) = w; } }
    }
};

struct EpiBr {
    static constexpr bool PERM = true, AFTER_DRAIN = false, DRAIN_AFTER = true;
    const bf16_t* Z; bf16_t* Y;
    __device__ static __forceinline__ bool reset_after(const Unit& u) { return u.pm >= 2 * NTM; }
    __device__ __forceinline__ void operator()(f32x4 (&acc)[2][2][4][2], const Unit& u, int wr, int wc, int fr, int fq) const {
        const int br = u.pm / NTM, pm = u.pm - br * NTM, pn = u.pn - br * 16;
        const int row0 = pm * BM + wr * 64 + fr, col0 = pn * BM + wc * 32 + 8 * fq;
        if (br < 2) {
#pragma unroll
            for (int ai = 0; ai < 2; ++ai)
#pragma unroll
                for (int mh = 0; mh < 2; ++mh) {
                    u32x4 g[2][2], h[2][2];
#pragma unroll
                    for (int mm = 0; mm < 2; ++mm)
#pragma unroll
                        for (int bj = 0; bj < 2; ++bj) { const bf16_t* gp = Z + (size_t)(row0 + ai * HALF + (2 * mh + mm) * 16) * IN_DIM + ZC_GATE + br * DM + col0 + bj * HALF;
                            g[mm][bj] = *(const u32x4*)gp; h[mm][bj] = *(const u32x4*)(gp + DM); }
                    __builtin_amdgcn_sched_barrier(0);
#pragma unroll
                    for (int mm = 0; mm < 2; ++mm)
#pragma unroll
                        for (int bj = 0; bj < 2; ++bj) { const u32x4 gg = g[mm][bj], hh = h[mm][bj]; f32x4& v0 = acc[ai][bj][2 * mh + mm][0]; f32x4& v1 = acc[ai][bj][2 * mh + mm][1];
                            v0[0] *= bflo(gg.x) * __builtin_amdgcn_rcpf(bflo(hh.x)); v0[1] *= bfhi(gg.x) * __builtin_amdgcn_rcpf(bfhi(hh.x)); v0[2] *= bflo(gg.y) * __builtin_amdgcn_rcpf(bflo(hh.y)); v0[3] *= bfhi(gg.y) * __builtin_amdgcn_rcpf(bfhi(hh.y));
                            v1[0] *= bflo(gg.z) * __builtin_amdgcn_rcpf(bflo(hh.z)); v1[1] *= bfhi(gg.z) * __builtin_amdgcn_rcpf(bfhi(hh.z)); v1[2] *= bflo(gg.w) * __builtin_amdgcn_rcpf(bflo(hh.w)); v1[3] *= bfhi(gg.w) * __builtin_amdgcn_rcpf(bfhi(hh.w)); }
                    __builtin_amdgcn_sched_barrier(0);
                }
        } else {
#pragma unroll
            for (int ai = 0; ai < 2; ++ai) {
                u32x4 g[4][2];
#pragma unroll
                for (int m = 0; m < 4; ++m)
#pragma unroll
                    for (int bj = 0; bj < 2; ++bj) g[m][bj] = *(const u32x4*)(Z + (size_t)(row0 + ai * HALF + m * 16) * IN_DIM + ZC_GATE + 2 * DM + col0 + bj * HALF);
                __builtin_amdgcn_sched_barrier(0);
#pragma unroll
                for (int m = 0; m < 4; ++m)
#pragma unroll
                    for (int bj = 0; bj < 2; ++bj) { const u32x4 gg = g[m][bj]; const f32x4 a0 = acc[ai][bj][m][0], a1 = acc[ai][bj][m][1];
                        u32x4 w; w.x = cvt_pk_bf16(a0[0] * bflo(gg.x), a0[1] * bfhi(gg.x)); w.y = cvt_pk_bf16(a0[2] * bflo(gg.y), a0[3] * bfhi(gg.y));
                        w.z = cvt_pk_bf16(a1[0] * bflo(gg.z), a1[1] * bfhi(gg.z)); w.w = cvt_pk_bf16(a1[2] * bflo(gg.w), a1[3] * bfhi(gg.w));
                        *(u32x4*)(Y + (size_t)(row0 + ai * HALF + m * 16) * DM + col0 + bj * HALF) = w; }
                __builtin_amdgcn_sched_barrier(0);
            }
        }
    }
};

struct EpiRes {
    static constexpr bool PERM = false, AFTER_DRAIN = false, DRAIN_AFTER = true;
    __device__ static __forceinline__ bool reset_after(const Unit&) { return true; }
    const float* src_lat; const float* src_ctx; float* dst_lat; float* dst_ctx; const float* gvec; float* slabs;
    __device__ __forceinline__ void operator()(const f32x4 (&acc)[2][2][4][2], const Unit& u, int wr, int wc, int fr, int fq) const {
        const int pm = u.pm, cls = pm < 32 ? 0 : (pm < 64 ? 1 : 2);
        const float* src = pm < 64 ? src_lat + (size_t)pm * BM * DM : src_ctx + (size_t)(pm - 64) * BM * DM;
        float* dst = pm < 64 ? dst_lat + (size_t)pm * BM * DM : dst_ctx + (size_t)(pm - 64) * BM * DM;
        const int col0 = u.pn * BM + wc * 32 + 4 * fq; const float* gv = gvec + (size_t)cls * NMOD + col0;
        f32x4 g[2][2];
#pragma unroll
        for (int bj = 0; bj < 2; ++bj)
#pragma unroll
            for (int n = 0; n < 2; ++n) g[bj][n] = *(const f32x4*)(gv + bj * HALF + n * 16);
        if (u.ks >= 0) {
            float* slab = slabs + (size_t)u.ks * MC * DM + (size_t)(pm - 64) * BM * DM;
#pragma unroll
            for (int ai = 0; ai < 2; ++ai)
#pragma unroll
                for (int m = 0; m < 4; ++m) { float* rowp = slab + (size_t)(ai * HALF + wr * 64 + m * 16 + fr) * DM + col0;
#pragma unroll
                    for (int bj = 0; bj < 2; ++bj)
#pragma unroll
                        for (int n = 0; n < 2; ++n) *(f32x4*)(rowp + bj * HALF + n * 16) = g[bj][n] * acc[ai][bj][m][n]; }
            return;
        }
#pragma unroll
        for (int am = 0; am < 4; ++am) { const int ai = am >> 1, m0 = (am & 1) * 2;
            f32x4 s[2][2][2];
#pragma unroll
            for (int mm = 0; mm < 2; ++mm) { const size_t off = (size_t)(ai * HALF + wr * 64 + (m0 + mm) * 16 + fr) * DM + col0;
#pragma unroll
                for (int bj = 0; bj < 2; ++bj)
#pragma unroll
                    for (int n = 0; n < 2; ++n) s[mm][bj][n] = *(const f32x4*)(src + off + bj * HALF + n * 16); }
            __builtin_amdgcn_sched_barrier(0);
#pragma unroll
            for (int mm = 0; mm < 2; ++mm) { const size_t off = (size_t)(ai * HALF + wr * 64 + (m0 + mm) * 16 + fr) * DM + col0;
#pragma unroll
                for (int bj = 0; bj < 2; ++bj)
#pragma unroll
                    for (int n = 0; n < 2; ++n) *(f32x4*)(dst + off + bj * HALF + n * 16) = s[mm][bj][n] + g[bj][n] * acc[ai][bj][m0 + mm][n]; }
            __builtin_amdgcn_sched_barrier(0);
        }
    }
};

struct EpiGU {
    static constexpr bool PERM = true, AFTER_DRAIN = false, DRAIN_AFTER = false;
    __device__ static __forceinline__ bool reset_after(const Unit&) { return true; }
    bf16_t* H;
    __device__ __forceinline__ void operator()(const f32x4 (&acc)[2][2][4][2], const Unit& u, int wr, int wc, int fr, int fq) const {
        const int row0 = u.pm * BM + wr * 64 + fr, col0 = u.pn * HALF + wc * 32 + 8 * fq;
#pragma unroll
        for (int ai = 0; ai < 2; ++ai)
#pragma unroll
            for (int m = 0; m < 4; ++m) { f32x4 g0 = acc[ai][0][m][0], g1 = acc[ai][0][m][1]; const f32x4 u0 = acc[ai][1][m][0], u1 = acc[ai][1][m][1];
#pragma unroll
                for (int e = 0; e < 4; ++e) { g0[e] = g0[e] * fsigmoid(g0[e]) * u0[e]; g1[e] = g1[e] * fsigmoid(g1[e]) * u1[e]; }
                u32x4 w; w.x = cvt_pk_bf16(g0[0], g0[1]); w.y = cvt_pk_bf16(g0[2], g0[3]); w.z = cvt_pk_bf16(g1[0], g1[1]); w.w = cvt_pk_bf16(g1[2], g1[3]);
                *(u32x4*)(H + (size_t)(row0 + ai * HALF + m * 16) * FF + col0) = w; }
    }
};

struct BranchOrder {
    int G, c, nM;
    __device__ bool next(int i, Unit& u) const {
        const int ti = i / 3, br = i - 3 * ti; StaticOrder T; T.nM = nM; T.nN = 16; T.nwg = nM * 16; T.G = G; T.c = c; T.nkf = 2048 / BK;
        const long L = T.lin(ti); if (L >= T.nwg) return false;
        int pm, pn; T.tile_of((int)L, pm, pn);
        u.pm = br * NTM + pm; u.pn = br * 16 + pn; u.k0 = 0; u.nk = 2048 / BK; u.ks = -1; return true;
    }
    __device__ __forceinline__ void a_ready(const Unit&) const {}
    __device__ __forceinline__ void done(const Unit&) const {}
};
__device__ __forceinline__ void ksplit8(int nkf, int s, int& k0, int& nk) { const int e = (nkf / 8) & ~1, half = (nkf - 8 * e) / 2; k0 = s * e + 2 * (s < half ? s : half); nk = e + (s < half ? 2 : 0); }
struct InOrder {
    StaticOrder S; int nmain, kv_only;
    __device__ void init(int G, int c, bool last) { kv_only = last; S.init(last ? ML : MT, IN_DIM, G, c, DM); nmain = S.nwg; }
    __device__ bool next(int i, Unit& u) const {
        const long L0 = S.lin_t(i); if (S.from_lin(L0, u)) return true;
        if (!kv_only) return false;
        const long L = L0 - nmain; if (L < 0 || L >= 256) return false;
        const int tile = (int)(L >> 3); u.pm = 64 + (tile >> 4); u.pn = 32 + (tile & 15); u.ks = (int)(L & 7); ksplit8(DM / BK, u.ks, u.k0, u.nk); return true;
    }
    __device__ __forceinline__ void a_ready(const Unit&) const {}
    __device__ __forceinline__ void done(const Unit&) const {}
};
struct ResOrder {
    StaticOrder S; int nmain, with_ctx;
    __device__ void init(int G, int c, int K, bool ctx) { with_ctx = ctx; S.init(ML, DM, G, c, K); nmain = S.nwg; }
    __device__ bool next(int i, Unit& u) const {
        const long L0 = S.lin_t(i); if (S.from_lin(L0, u)) return true;
        if (!with_ctx) return false;
        const long L = L0 - nmain; if (L < 0 || L >= 256) return false;
        const int tile = (int)(L >> 3); u.pm = 64 + (tile >> 4); u.pn = tile & 15; u.ks = (int)(L & 7); ksplit8(S.nkf, u.ks, u.k0, u.nk); return true;
    }
    __device__ __forceinline__ void a_ready(const Unit&) const {}
    __device__ __forceinline__ void done(const Unit&) const {}
};

template <class Epi, class Sched, bool ALIGN_EPI = false, bool SP2 = false>
__device__ __forceinline__ void gemm_phase(PG8_LAS unsigned char* lds, const int tid, const Gemm g, const Sched& S, const Epi& E) {
    const int wid = __builtin_amdgcn_readfirstlane(tid >> 6), lane = tid & 63, wr = wid >> 2, wc = wid & 3, fr = lane & 15, fq = lane >> 4;
    const int K = g.K;
    unsigned voffA[2], voffB[2];
#pragma unroll
    for (int i = 0; i < 2; ++i) { int R, C; stage_rc(tid * 16 + i * 8192, R, C); const int Rb = Epi::PERM ? ((R & ~31) + perm32(R & 31)) : R;
        voffA[i] = (unsigned)(R * K + C) * 2u; voffB[i] = (unsigned)(Rb * K + C) * 2u; }
    const size_t kstep = (size_t)(BK * 2);
    const size_t hstep = (size_t)HALF * K * 2;
    const size_t tstep = 2 * hstep;
    const unsigned ldsw = (unsigned)wid * 1024u;
    const int aoff = lds_byte(wr * 64 + fr, fq * 8), boff = lds_byte(wc * 32 + fr, fq * 8);
#define PG8_SA(b, h) (((b) * 2 + (h)) * HTB)
#define PG8_SB(b, h) ((4 + (b) * 2 + (h)) * HTB)
#define PG8_STAGE(bufoff, gbase, voff) do { _Pragma("unroll") for (int _i = 0; _i < 2; ++_i) \
        __builtin_amdgcn_global_load_lds((const unsigned*)((const char*)(gbase) + (voff)[_i]), (PG8_LAS unsigned*)(lds + (bufoff) + ldsw + _i * 8192), 16, 0, 0); } while (0)
#define PG8_LDA(dst, b, h) do { _Pragma("unroll") for (int m = 0; m < 4; ++m) _Pragma("unroll") for (int k = 0; k < 2; ++k) dst[m][k] = *(const PG8_LAS bf16x8*)(lds + PG8_SA(b, h) + aoff + m * 2048 + k * 1024); } while (0)
#define PG8_LDB(dst, b, h) do { _Pragma("unroll") for (int n = 0; n < 2; ++n) _Pragma("unroll") for (int k = 0; k < 2; ++k) dst[n][k] = *(const PG8_LAS bf16x8*)(lds + PG8_SB(b, h) + boff + n * 2048 + k * 1024); } while (0)
#define PG8_MMA(ai, bj, At, Bt) do { __builtin_amdgcn_s_setprio(1); _Pragma("unroll") for (int m = 0; m < 4; ++m) _Pragma("unroll") for (int n = 0; n < 2; ++n) _Pragma("unroll") for (int k = 0; k < 2; ++k) \
        acc[ai][bj][m][n] = __builtin_amdgcn_mfma_f32_16x16x32_bf16(Bt[n][k], At[m][k], acc[ai][bj][m][n], 0, 0, 0); __builtin_amdgcn_s_setprio(0); } while (0)
#define PG8_WAIT_V(n) asm volatile("s_waitcnt vmcnt(" #n ")" ::: "memory")
#define PG8_WAIT_L(n) asm volatile("s_waitcnt lgkmcnt(" #n ")" ::: "memory")
#define PG8_BAR __builtin_amdgcn_s_barrier()
#define PG8_SCHED __builtin_amdgcn_sched_barrier(0)
    Unit cur, nxt; int ui = 0;
    if (!S.next(0, cur)) return;
    f32x4 acc[2][2][4][2];
#pragma unroll
    for (int a = 0; a < 2; ++a)
#pragma unroll
        for (int b = 0; b < 2; ++b)
#pragma unroll
            for (int m = 0; m < 4; ++m)
#pragma unroll
                for (int n = 0; n < 2; ++n) acc[a][b][m][n] = (f32x4){0.f, 0.f, 0.f, 0.f};
    bf16x8 At[4][2], B0[2][2], B1[2][2];
#ifdef GEMM_FIXED
#define PG8_PM(u) (((GEMM_FIXED) & 1) ? 0 : (u).pm)
#define PG8_PN(u) (((GEMM_FIXED) & 2) ? 0 : (u).pn)
#else
#define PG8_PM(u) ((u).pm)
#define PG8_PN(u) ((u).pn)
#endif
    const char* cA = (const char*)g.A + (size_t)PG8_PM(cur) * tstep + (size_t)cur.k0 * kstep; const char* cB = (const char*)g.Bt + (size_t)PG8_PN(cur) * tstep + (size_t)cur.k0 * kstep;
    int nt = cur.nk;
    S.a_ready(cur);
    if constexpr (SP2) {
        PG8_STAGE(PG8_SB(0, 0), cB, voffB); PG8_STAGE(PG8_SB(0, 1), cB + hstep, voffB); PG8_STAGE(PG8_SA(0, 0), cA, voffA); PG8_STAGE(PG8_SA(0, 1), cA + hstep, voffA);
        if (wr == 1) PG8_BAR;
        PG8_WAIT_V(2); PG8_BAR;
        PG8_STAGE(PG8_SB(1, 0), cB + kstep, voffB); PG8_STAGE(PG8_SA(1, 0), cA + kstep, voffA); PG8_STAGE(PG8_SB(1, 1), cB + hstep + kstep, voffB);
        PG8_WAIT_V(6); PG8_BAR;
    } else {
        PG8_STAGE(PG8_SB(0, 0), cB, voffB); PG8_STAGE(PG8_SA(0, 0), cA, voffA); PG8_STAGE(PG8_SB(0, 1), cB + hstep, voffB); PG8_STAGE(PG8_SA(0, 1), cA + hstep, voffA);
        if (wr == 1) PG8_BAR;
        PG8_WAIT_V(4); PG8_BAR;
        PG8_STAGE(PG8_SB(1, 0), cB + kstep, voffB); PG8_STAGE(PG8_SA(1, 0), cA + kstep, voffA); PG8_STAGE(PG8_SB(1, 1), cB + hstep + kstep, voffB);
        PG8_WAIT_V(6); PG8_BAR;
    }
    for (;;) {
        const bool has_next = S.next(ui + 1, nxt);
        const char* nA = has_next ? (const char*)g.A + (size_t)PG8_PM(nxt) * tstep + (size_t)nxt.k0 * kstep : cA; const char* nB = has_next ? (const char*)g.Bt + (size_t)PG8_PN(nxt) * tstep + (size_t)nxt.k0 * kstep : cB;
        for (int t = 0; t < nt; t += 2) {
            const bool last = (t == nt - 2);
            const char* a1 = cA + (size_t)(t + 1) * kstep;
            const char* a2 = last ? nA : cA + (size_t)(t + 2) * kstep; const char* b2 = last ? nB : cB + (size_t)(t + 2) * kstep;
            const char* a3 = a2 + kstep; const char* b3 = b2 + kstep;
            if (last && has_next) S.a_ready(nxt);
            if constexpr (SP2) {
            PG8_LDB(B0, 0, 0); PG8_LDB(B1, 0, 1); PG8_SCHED; PG8_LDA(At, 0, 0); PG8_STAGE(PG8_SA(1, 1), a1 + hstep, voffA);
            PG8_WAIT_V(8); PG8_WAIT_L(0); PG8_BAR; PG8_MMA(0, 0, At, B0); PG8_MMA(0, 1, At, B1); PG8_BAR; PG8_SCHED;
            PG8_LDA(At, 0, 1); PG8_STAGE(PG8_SB(0, 0), b2, voffB); PG8_STAGE(PG8_SB(0, 1), b2 + hstep, voffB); PG8_STAGE(PG8_SA(0, 0), a2, voffA);
            PG8_WAIT_V(8); PG8_WAIT_L(0); PG8_BAR; PG8_MMA(1, 0, At, B0); PG8_MMA(1, 1, At, B1); PG8_BAR; PG8_SCHED;
            PG8_LDB(B0, 1, 0); PG8_LDB(B1, 1, 1); PG8_SCHED; PG8_LDA(At, 1, 0); PG8_STAGE(PG8_SA(0, 1), a2 + hstep, voffA);
            PG8_WAIT_V(8); PG8_WAIT_L(0); PG8_BAR; PG8_MMA(0, 0, At, B0); PG8_MMA(0, 1, At, B1); PG8_BAR; PG8_SCHED;
            PG8_LDA(At, 1, 1); PG8_STAGE(PG8_SB(1, 0), b3, voffB); PG8_STAGE(PG8_SB(1, 1), b3 + hstep, voffB); PG8_STAGE(PG8_SA(1, 0), a3, voffA);
            PG8_WAIT_V(8); PG8_WAIT_L(0); PG8_BAR; PG8_MMA(1, 0, At, B0); PG8_MMA(1, 1, At, B1); PG8_BAR; PG8_SCHED;
            } else {
            PG8_LDB(B0, 0, 0); PG8_SCHED; PG8_LDA(At, 0, 0); PG8_STAGE(PG8_SA(1, 1), a1 + hstep, voffA);
            PG8_WAIT_L(8); PG8_BAR; PG8_WAIT_L(0); PG8_MMA(0, 0, At, B0); PG8_BAR; PG8_SCHED;
            PG8_LDB(B1, 0, 1); PG8_STAGE(PG8_SB(0, 0), b2, voffB);
            PG8_BAR; PG8_WAIT_L(0); PG8_MMA(0, 1, At, B1); PG8_BAR;
            PG8_LDA(At, 0, 1); PG8_STAGE(PG8_SA(0, 0), a2, voffA);
            PG8_BAR; PG8_WAIT_L(0); PG8_MMA(1, 0, At, B0); PG8_BAR; PG8_SCHED;
            PG8_STAGE(PG8_SB(0, 1), b2 + hstep, voffB);
            PG8_WAIT_V(6); PG8_BAR; PG8_MMA(1, 1, At, B1); PG8_BAR;
            PG8_LDB(B0, 1, 0); PG8_SCHED; PG8_LDA(At, 1, 0); PG8_STAGE(PG8_SA(0, 1), a2 + hstep, voffA);
            PG8_WAIT_L(8); PG8_BAR; PG8_WAIT_L(0); PG8_MMA(0, 0, At, B0); PG8_BAR; PG8_SCHED;
            PG8_LDB(B1, 1, 1); PG8_STAGE(PG8_SB(1, 0), b3, voffB);
            PG8_BAR; PG8_WAIT_L(0); PG8_MMA(0, 1, At, B1); PG8_BAR;
            PG8_LDA(At, 1, 1); PG8_STAGE(PG8_SA(1, 0), a3, voffA);
            PG8_BAR; PG8_WAIT_L(0); PG8_MMA(1, 0, At, B0); PG8_BAR; PG8_SCHED;
            PG8_STAGE(PG8_SB(1, 1), b3 + hstep, voffB);
            PG8_WAIT_V(6); PG8_BAR; PG8_MMA(1, 1, At, B1); PG8_BAR;
            }
        }
        if constexpr (ALIGN_EPI) { if (wr == 0) PG8_BAR; }
        if constexpr (!Epi::AFTER_DRAIN) { E(acc, cur, wr, wc, fr, fq); S.done(cur);
            if constexpr (Epi::DRAIN_AFTER) __builtin_amdgcn_s_waitcnt(0x0F70); }
        if (!has_next) break;
        if (Epi::reset_after(cur)) {
#pragma unroll
        for (int a = 0; a < 2; ++a)
#pragma unroll
            for (int b = 0; b < 2; ++b)
#pragma unroll
                for (int m = 0; m < 4; ++m)
#pragma unroll
                    for (int n = 0; n < 2; ++n) acc[a][b][m][n] = (f32x4){0.f, 0.f, 0.f, 0.f};
        }
        cur = nxt; cA = nA; cB = nB; nt = cur.nk; ++ui;
        if constexpr (ALIGN_EPI) { if (wr == 1) PG8_BAR; }
    }
    PG8_WAIT_V(0);
    if constexpr (!ALIGN_EPI) { if (wr == 0) PG8_BAR; }
    PG8_BAR;
    if constexpr (Epi::AFTER_DRAIN) { E.fused(acc, cur, wr, wc, fr, fq, lds, wid, lane); S.done(cur); }
#undef PG8_SA
#undef PG8_SB
#undef PG8_STAGE
#undef PG8_LDA
#undef PG8_LDB
#undef PG8_MMA
#undef PG8_WAIT_V
#undef PG8_WAIT_L
#undef PG8_BAR
#undef PG8_SCHED
}
}
namespace att {
using bf16x8 = __attribute__((ext_vector_type(8))) short;
using s16x4  = __attribute__((ext_vector_type(4))) short;
using f32x16 = __attribute__((ext_vector_type(16))) float;
using u32x4  = __attribute__((ext_vector_type(4))) unsigned;
typedef unsigned short bf16_t;
constexpr int NW = 8, QBLK = 32, KVBLK = 64;
constexpr float SCALE = 0.125f, THR = 8.f;
constexpr int LDQK = DM, LDV = IN_DIM;
constexpr int NSLOT = 4;
constexpr int SHM_V = KVBLK * 128 * 2, SHM_K = KVBLK * 64 * 2, SHM_ATTN = NSLOT * SHM_V + NSLOT * SHM_K + NW * 64 * 4;
#define KSWZ(row, colB) ((row) * 128 + ((colB) ^ ((((row) >> 1) & 7) << 4)))
#define SBAR() __builtin_amdgcn_sched_barrier(0)
__device__ __forceinline__ int crow(int r, int hi) { return (r & 3) + 8 * (r >> 2) + 4 * hi; }
__device__ __forceinline__ unsigned cvtpk(float lo, float hi) { unsigned r; asm volatile("v_cvt_pk_bf16_f32 %0, %1, %2" : "=v"(r) : "v"(lo), "v"(hi)); return r; }

__device__ __forceinline__ int v_st(int k, int c) { const int kk = (k & ~0xC) | ((k & 4) << 1) | ((k & 8) >> 1); return ((kk >> 3) * 4 + (c >> 5)) * 512 + ((kk & 7) * 32 + (c & 31)) * 2; }
__device__ __forceinline__ int v_rd_base(int lane) { return ((lane & 3) << 3) | (((lane >> 2) & 3) << 6) | (((lane >> 4) & 1) << 5) | (((lane >> 5) & 1) << 8); }
constexpr int v_rd_off(int d0, int ks, int half) { return d0 * 512 + ks * 4096 + half * 2048; }
template <int OFF> __device__ __forceinline__ s16x4 tr_read(int vb) {
  s16x4 r; asm volatile("ds_read_b64_tr_b16 %0, %1 offset:%2" : "=&v"(r) : "v"(vb), "i"(OFF) : "memory"); return r;
}
template <int D0> __device__ __forceinline__ void pv_one(f32x16& od, int vb, bf16x8 pa0, bf16x8 pa1, bf16x8 pa2, bf16x8 pa3) {
  const s16x4 l0 = tr_read<v_rd_off(D0, 0, 0)>(vb), h0 = tr_read<v_rd_off(D0, 0, 1)>(vb), l1 = tr_read<v_rd_off(D0, 1, 0)>(vb), h1 = tr_read<v_rd_off(D0, 1, 1)>(vb);
  const s16x4 l2 = tr_read<v_rd_off(D0, 2, 0)>(vb), h2 = tr_read<v_rd_off(D0, 2, 1)>(vb), l3 = tr_read<v_rd_off(D0, 3, 0)>(vb), h3 = tr_read<v_rd_off(D0, 3, 1)>(vb);
  asm volatile("s_waitcnt lgkmcnt(0)" ::: "memory"); SBAR();
#define PK(L, H) (bf16x8){L[0], L[1], L[2], L[3], H[0], H[1], H[2], H[3]}
  od = __builtin_amdgcn_mfma_f32_32x32x16_bf16(pa0, PK(l0, h0), od, 0, 0, 0);
  od = __builtin_amdgcn_mfma_f32_32x32x16_bf16(pa1, PK(l1, h1), od, 0, 0, 0);
  od = __builtin_amdgcn_mfma_f32_32x32x16_bf16(pa2, PK(l2, h2), od, 0, 0, 0);
  od = __builtin_amdgcn_mfma_f32_32x32x16_bf16(pa3, PK(l3, h3), od, 0, 0, 0);
#undef PK
}

typedef float f32x2 __attribute__((ext_vector_type(2)));
template <int OFF> __device__ __forceinline__ bf16x8 k_read(int ka) {
  bf16x8 r; asm volatile("ds_read_b128 %0, %1 offset:%2" : "=&v"(r) : "v"(ka), "i"(OFF) : "memory"); return r;
}
struct VFr { s16x4 l0, h0, l1, h1, l2, h2, l3, h3; };
template <int D0, int VS> __device__ __forceinline__ void v_issue(VFr& f, int vb) {
#ifdef ATT_NOVREAD
  f.l0 = f.h0 = f.l1 = f.h1 = f.l2 = f.h2 = f.l3 = f.h3 = (s16x4){1, 1, 1, 1}; return;
#endif
  f.l0 = tr_read<VS * SHM_V + v_rd_off(D0, 0, 0)>(vb); f.h0 = tr_read<VS * SHM_V + v_rd_off(D0, 0, 1)>(vb); f.l1 = tr_read<VS * SHM_V + v_rd_off(D0, 1, 0)>(vb); f.h1 = tr_read<VS * SHM_V + v_rd_off(D0, 1, 1)>(vb);
  f.l2 = tr_read<VS * SHM_V + v_rd_off(D0, 2, 0)>(vb); f.h2 = tr_read<VS * SHM_V + v_rd_off(D0, 2, 1)>(vb); f.l3 = tr_read<VS * SHM_V + v_rd_off(D0, 3, 0)>(vb); f.h3 = tr_read<VS * SHM_V + v_rd_off(D0, 3, 1)>(vb);
}
#define ATT_PK(L, H) (bf16x8){L[0], L[1], L[2], L[3], H[0], H[1], H[2], H[3]}
#define ATT_LGKM(n) asm volatile("s_waitcnt lgkmcnt(" #n ")" ::: "memory")
__device__ __forceinline__ void sm_pair(f32x16& c, const int e, const float) {
#ifdef ATT_NOEXP
  c[e] = c[e] * 0.5f; c[e + 1] = c[e + 1] * 0.5f;
#else
  c[e] = __builtin_amdgcn_exp2f(c[e]); c[e + 1] = __builtin_amdgcn_exp2f(c[e + 1]);
#endif
}
__device__ __forceinline__ void acc_pair(f32x2& lsum, const float a, const float b) {
#ifdef ATT_NOSUM
  return;
#endif
  asm volatile("v_add_f32 %0, %0, %1" : "+v"(lsum.x) : "v"(a)); asm volatile("v_add_f32 %0, %0, %1" : "+v"(lsum.y) : "v"(b));
}
template <int G>
__device__ __forceinline__ void gapv(f32x16& c0, f32x16& c1, bf16x8 (&pn)[4], f32x2& lsum, unsigned (&cv)[4], const float m0c) {
  if constexpr (G < 16) {
    if constexpr (G < 14) { constexpr int e = 4 + 2 * G; if constexpr (e < 16) sm_pair(c0, e, m0c); else sm_pair(c1, e - 16, m0c); }
    constexpr int a = 2 * G;
    if constexpr (a < 16) acc_pair(lsum, c0[a], c0[a + 1]); else acc_pair(lsum, c1[a - 16], c1[a - 15]);
  } else {
    constexpr int k = G - 16, q = k >> 1, B = (q & 1) * 8;
    f32x16& P = (q < 2) ? c0 : c1;
    if constexpr ((k & 1) == 0) { cv[0] = cvtpk(P[B + 0], P[B + 1]); cv[1] = cvtpk(P[B + 2], P[B + 3]); cv[2] = cvtpk(P[B + 4], P[B + 5]); cv[3] = cvtpk(P[B + 6], P[B + 7]); }
    else {
      auto r0 = __builtin_amdgcn_permlane32_swap(cv[0], cv[2], false, false); auto r1 = __builtin_amdgcn_permlane32_swap(cv[1], cv[3], false, false);
      u32x4 w = {r0[0], r1[0], r0[1], r1[1]}; pn[q] = *reinterpret_cast<bf16x8*>(&w);
    }
  }
}
#define ATT_GAP(G) do { SBAR(); gapv<G>(c0, c1, pn, lsum, cv, m0c); SBAR(); } while (0)
#define ATT_PVBLK(OD, F, G0) do { \
    OD = __builtin_amdgcn_mfma_f32_32x32x16_bf16(pp[0], ATT_PK(F.l0, F.h0), OD, 0, 0, 0); ATT_GAP(G0); \
    OD = __builtin_amdgcn_mfma_f32_32x32x16_bf16(pp[1], ATT_PK(F.l1, F.h1), OD, 0, 0, 0); ATT_GAP(G0 + 1); \
    OD = __builtin_amdgcn_mfma_f32_32x32x16_bf16(pp[2], ATT_PK(F.l2, F.h2), OD, 0, 0, 0); ATT_GAP(G0 + 2); \
    OD = __builtin_amdgcn_mfma_f32_32x32x16_bf16(pp[3], ATT_PK(F.l3, F.h3), OD, 0, 0, 0); ATT_GAP(G0 + 3); } while (0)
template <bool HAS_QK, bool HAS_PV, int KS, int VS, class Mid>
__device__ __forceinline__ void att_seg(const Mid& mid, f32x16& c0, f32x16& c1, f32x16& n0, f32x16& n1, const bf16x8 (&pp)[4], bf16x8 (&pn)[4], f32x16 (&o)[4], f32x2& lsum,
                                        const int (&ka)[4], const int vb, const bf16x8 (&qf)[4], const float m0c) {
  unsigned cv[4]; VFr va, vq; bf16x8 kf[8];
  if constexpr (HAS_PV) { v_issue<0, VS>(va, vb); v_issue<1, VS>(vq, vb); }
  SBAR(); sm_pair(c0, 0, m0c); sm_pair(c0, 2, m0c); SBAR();
#define ATT_KQ_ISSUE() do { _Pragma("unroll") for (int d0 = 0; d0 < 4; ++d0) { kf[2 * d0] = k_read<KS * SHM_K>(ka[d0]); kf[2 * d0 + 1] = k_read<KS * SHM_K + 4096>(ka[d0]); } } while (0)
  if constexpr (HAS_PV) {
    ATT_LGKM(8); SBAR();
    ATT_PVBLK(o[0], va, 0);
#ifndef ATT_NOMID
    mid();
#endif
    SBAR();
    v_issue<2, VS>(va, vb); ATT_LGKM(8); SBAR();
    ATT_PVBLK(o[1], vq, 4);
    v_issue<3, VS>(vq, vb); ATT_LGKM(8); SBAR();
    ATT_PVBLK(o[2], va, 8);
    if constexpr (HAS_QK) { ATT_KQ_ISSUE(); ATT_LGKM(8); } else { ATT_LGKM(0); }
    SBAR();
    ATT_PVBLK(o[3], vq, 12);
  } else {
    mid(); SBAR();
    if constexpr (HAS_QK) ATT_KQ_ISSUE();
    ATT_GAP(0); ATT_GAP(1); ATT_GAP(2); ATT_GAP(3); ATT_GAP(4); ATT_GAP(5); ATT_GAP(6); ATT_GAP(7);
    ATT_GAP(8); ATT_GAP(9); ATT_GAP(10); ATT_GAP(11); ATT_GAP(12); ATT_GAP(13); ATT_GAP(14); ATT_GAP(15);
  }
  if constexpr (HAS_QK) {
    n0 = f32x16{}; n1 = f32x16{};
    ATT_LGKM(0); SBAR();
    n0 = __builtin_amdgcn_mfma_f32_32x32x16_bf16(kf[0], qf[0], n0, 0, 0, 0); ATT_GAP(16);
    n1 = __builtin_amdgcn_mfma_f32_32x32x16_bf16(kf[1], qf[0], n1, 0, 0, 0); ATT_GAP(17);
    n0 = __builtin_amdgcn_mfma_f32_32x32x16_bf16(kf[2], qf[1], n0, 0, 0, 0); ATT_GAP(18);
    n1 = __builtin_amdgcn_mfma_f32_32x32x16_bf16(kf[3], qf[1], n1, 0, 0, 0); ATT_GAP(19);
    n0 = __builtin_amdgcn_mfma_f32_32x32x16_bf16(kf[4], qf[2], n0, 0, 0, 0); ATT_GAP(20);
    n1 = __builtin_amdgcn_mfma_f32_32x32x16_bf16(kf[5], qf[2], n1, 0, 0, 0); ATT_GAP(21);
    n0 = __builtin_amdgcn_mfma_f32_32x32x16_bf16(kf[6], qf[3], n0, 0, 0, 0); ATT_GAP(22);
    n1 = __builtin_amdgcn_mfma_f32_32x32x16_bf16(kf[7], qf[3], n1, 0, 0, 0); ATT_GAP(23);
  } else { ATT_GAP(16); ATT_GAP(17); ATT_GAP(18); ATT_GAP(19); ATT_GAP(20); ATT_GAP(21); ATT_GAP(22); ATT_GAP(23); }
#undef ATT_KQ_ISSUE
}

__device__ __forceinline__ void attn_unit(const int MODE, const bf16_t* __restrict__ Qb, const bf16_t* __restrict__ Kh, const bf16_t* __restrict__ Vh, float* __restrict__ OS, bf16_t* __restrict__ AOb,
                                          const float* __restrict__ subg, float lam, float osc, const float m0c, int rowa, int nt0, int rowb, int NT, char* lds, int tid) {
  asm volatile("" : "+v"(tid));
  const int wid = tid >> 6, lane = tid & 63, r32 = lane & 31, hi = lane >> 5;
  char* V_lds = lds; char* K_lds = lds + NSLOT * SHM_V;
  float* ws = (float*)(lds + NSLOT * SHM_V + NSLOT * SHM_K) + wid * 64; float* li_l = ws;
  f32x16 o[4] = {}; bf16x8 qr[4];
  const bf16_t* Qw = Qb + (long)(wid * QBLK + r32) * LDQK + hi * 8;
#pragma unroll
  for (int d0 = 0; d0 < 4; ++d0) qr[d0] = *reinterpret_cast<const bf16x8*>(Qw + d0 * 16);
  unsigned koffd, voffd0, voffd1;
  { const int b = wid * 1024 + lane * 16, row = b >> 7, colB = (b & 127) ^ (((row >> 1) & 7) << 4); koffd = (unsigned)(row * LDQK * 2 + colB); }
  { const int b = wid * 1024 + lane * 16, sub = b >> 9, e = (b & 511) >> 1, kk = (sub >> 2) * 8 + (e >> 5), k = (kk & ~0xC) | ((kk & 4) << 1) | ((kk & 8) >> 1), col = (sub & 3) * 32 + (e & 31);
    voffd0 = (unsigned)(k * LDV * 2 + col * 2); }
  { const int b = 8192 + wid * 1024 + lane * 16, sub = b >> 9, e = (b & 511) >> 1, kk = (sub >> 2) * 8 + (e >> 5), k = (kk & ~0xC) | ((kk & 4) << 1) | ((kk & 8) >> 1), col = (sub & 3) * 32 + (e & 31);
    voffd1 = (unsigned)(k * LDV * 2 + col * 2); }
  const unsigned wid_s = (unsigned)__builtin_amdgcn_readfirstlane(wid);
  const unsigned ldsK = (unsigned)(uintptr_t)(lds + NSLOT * SHM_V) + wid_s * 1024u, ldsV = (unsigned)(uintptr_t)lds + wid_s * 1024u;
  const int vb = (int)(uintptr_t)V_lds + v_rd_base(lane);
  int ka[4];
#pragma unroll
  for (int d0 = 0; d0 < 4; ++d0) ka[d0] = (int)(uintptr_t)K_lds + KSWZ(r32, (d0 * 16 + hi * 8) * 2);
#define KROW(j) ((j) < nt0 ? rowa + (j) * KVBLK : rowb + ((j) - nt0) * KVBLK)
#define GLDS(src, dst) do { unsigned keep_; asm volatile("s_mov_b32 %0, m0\n\ts_mov_b32 m0, %2\n\ts_nop 0\n\tglobal_load_lds_dwordx4 %1, off\n\ts_mov_b32 m0, %0" : "=&s"(keep_) : "v"(src), "s"(dst) : "memory"); } while (0)
#define KDMA(j, slot) do { const int jc_ = (j) < NT ? (j) : NT - 1; GLDS((const char*)Kh + (size_t)KROW(jc_) * (LDQK * 2) + koffd, ldsK + (unsigned)(slot) * SHM_K); } while (0)
#define VDMA(j, slot) do { const int jc_ = (j) < NT ? (j) : NT - 1; const char* vb_ = (const char*)Vh + (size_t)KROW(jc_) * (LDV * 2); \
    GLDS(vb_ + voffd0, ldsV + (unsigned)(slot) * SHM_V); GLDS(vb_ + voffd1, ldsV + (unsigned)(slot) * SHM_V + 8192u); } while (0)
#define SEGEND() do { asm volatile("s_waitcnt vmcnt(0) lgkmcnt(0)" ::: "memory"); __builtin_amdgcn_s_barrier(); asm volatile("" ::: "memory"); } while (0)
  f32x16 sA0, sA1, sB0, sB1; bf16x8 paA[4], paB[4]; f32x2 lsum = {0.f, 0.f};
  const auto nomid = [&]() {};
  KDMA(0, 0); KDMA(1, 1); KDMA(2, 2); VDMA(0, 0);
  SEGEND();
  { bf16x8 kf[8];
#pragma unroll
    for (int d0 = 0; d0 < 4; ++d0) { kf[2 * d0] = k_read<0>(ka[d0]); kf[2 * d0 + 1] = k_read<4096>(ka[d0]); }
    sA0 = f32x16{}; sA1 = f32x16{}; ATT_LGKM(0); SBAR();
#pragma unroll
    for (int d0 = 0; d0 < 4; ++d0) { sA0 = __builtin_amdgcn_mfma_f32_32x32x16_bf16(kf[2 * d0], qr[d0], sA0, 0, 0, 0); sA1 = __builtin_amdgcn_mfma_f32_32x32x16_bf16(kf[2 * d0 + 1], qr[d0], sA1, 0, 0, 0); } }
  SEGEND();
  att_seg<true, false, 1, 0>([&]() { KDMA(3, 3); KDMA(4, 0); VDMA(1, 1); VDMA(2, 2); }, sA0, sA1, sB0, sB1, paB  , paA, o, lsum, ka, vb, qr, m0c);
  att_seg<true, true, 2, 0>(nomid, sB0, sB1, sA0, sA1, paA, paB, o, lsum, ka, vb, qr, m0c);
  SEGEND();
  for (int j = 2; j + 2 < NT; j += 4) {
    att_seg<true, true, 3, 1>([&]() { KDMA(j + 3, 1); KDMA(j + 4, 2); VDMA(j + 1, 3); VDMA(j + 2, 0); }, sA0, sA1, sB0, sB1, paB, paA, o, lsum, ka, vb, qr, m0c);
    att_seg<true, true, 0, 2>(nomid, sB0, sB1, sA0, sA1, paA, paB, o, lsum, ka, vb, qr, m0c);
    SEGEND();
    att_seg<true, true, 1, 3>([&]() { KDMA(j + 5, 3); KDMA(j + 6, 0); VDMA(j + 3, 1); VDMA(j + 4, 2); }, sA0, sA1, sB0, sB1, paB, paA, o, lsum, ka, vb, qr, m0c);
    att_seg<true, true, 2, 0>(nomid, sB0, sB1, sA0, sA1, paA, paB, o, lsum, ka, vb, qr, m0c);
    SEGEND();
  }
  att_seg<true, true, 3, 1>([&]() { VDMA(NT - 1, 3); }, sA0, sA1, sB0, sB1, paB, paA, o, lsum, ka, vb, qr, m0c);
  att_seg<false, true, 0, 2>(nomid, sB0, sB1, sA0, sA1, paA, paB, o, lsum, ka, vb, qr, m0c);
  SEGEND();
  { VFr va, vq;
    v_issue<0, 3>(va, vb); v_issue<1, 3>(vq, vb); ATT_LGKM(8); SBAR();
#define ATT_PV4(OD, F, PP) do { OD = __builtin_amdgcn_mfma_f32_32x32x16_bf16(PP[0], ATT_PK(F.l0, F.h0), OD, 0, 0, 0); OD = __builtin_amdgcn_mfma_f32_32x32x16_bf16(PP[1], ATT_PK(F.l1, F.h1), OD, 0, 0, 0); \
    OD = __builtin_amdgcn_mfma_f32_32x32x16_bf16(PP[2], ATT_PK(F.l2, F.h2), OD, 0, 0, 0); OD = __builtin_amdgcn_mfma_f32_32x32x16_bf16(PP[3], ATT_PK(F.l3, F.h3), OD, 0, 0, 0); } while (0)
    ATT_PV4(o[0], va, paB); SBAR();
    v_issue<2, 3>(va, vb); ATT_LGKM(8); SBAR();
    ATT_PV4(o[1], vq, paB); SBAR();
    v_issue<3, 3>(vq, vb); ATT_LGKM(8); SBAR();
    ATT_PV4(o[2], va, paB); SBAR();
    ATT_LGKM(0); SBAR();
    ATT_PV4(o[3], vq, paB); }
  float l_reg = lsum.x + lsum.y;
  { auto rr = __builtin_amdgcn_permlane32_swap(__float_as_uint(l_reg), __float_as_uint(l_reg), false, false); l_reg = __uint_as_float(rr[0]) + __uint_as_float(rr[1]); }
  if (hi == 0) li_l[r32] = l_reg; asm volatile("s_waitcnt lgkmcnt(0)" ::: "memory");
  float rli[16];
#pragma unroll
  for (int r = 0; r < 16; ++r) rli[r] = __builtin_amdgcn_rcpf(li_l[crow(r, hi)]);
  int zo = 0; asm volatile("" : "+v"(zo));
  float* Ow = OS + (wid * QBLK) * 128 + zo;
  if (MODE == 0) {
#pragma unroll
    for (int r = 0; r < 16; ++r) { const int orow = crow(r, hi);
#pragma unroll
      for (int d0 = 0; d0 < 4; ++d0) Ow[orow * 128 + d0 * 32 + r32] = o[d0][r] * rli[r]; }
  } else {
    float sg[4];
#pragma unroll
    for (int d0 = 0; d0 < 4; ++d0) sg[d0] = subg[d0 * 32 + r32] * osc;
    bf16_t* Aw = AOb + (long)(wid * QBLK) * 2048 + zo;
#pragma unroll
    for (int r = 0; r < 16; ++r) { const int orow = crow(r, hi); float d[4]; float ss = 0.f;
#pragma unroll
      for (int d0 = 0; d0 < 4; ++d0) { d[d0] = __hip_atomic_load(&Ow[orow * 128 + d0 * 32 + r32], __ATOMIC_RELAXED, __HIP_MEMORY_SCOPE_AGENT) - lam * (o[d0][r] * rli[r]); ss += d[d0] * d[d0]; }
      { const int l4 = lane << 2;
#pragma unroll
        for (int k = 1; k < 32; k <<= 1) ss += __uint_as_float((unsigned)__builtin_amdgcn_ds_bpermute(l4 ^ (k << 2), (int)__float_as_uint(ss))); }
      const float rs = __builtin_amdgcn_rsqf(ss * (1.f / 128.f) + EPS);
#pragma unroll
      for (int d0 = 0; d0 < 4; ++d0) Aw[(long)orow * 2048 + d0 * 32 + r32] = (bf16_t)(cvtpk(d[d0] * rs * sg[d0], 0.f) & 0xffffu); }
  }
  asm volatile("s_waitcnt vmcnt(0)" ::: "memory");
  __syncthreads();
#undef KROW
#undef GLDS
#undef KDMA
#undef VDMA
#undef SEGEND
}
}

#define GAS __attribute__((address_space(1)))
#define LAS __attribute__((address_space(3)))
typedef unsigned short bf16;
typedef unsigned v4u __attribute__((ext_vector_type(4)));
typedef float f32x4 __attribute__((ext_vector_type(4)));
typedef short bf16x8 __attribute__((ext_vector_type(8)));
typedef GAS unsigned gu32;
typedef GAS unsigned long long gu64;
#define RLX_AGENT __ATOMIC_RELAXED, __HIP_MEMORY_SCOPE_AGENT
#define LDS_WAIT() asm volatile("s_waitcnt lgkmcnt(0)" ::: "memory")
#define VM_WAIT() asm volatile("s_waitcnt vmcnt(0)" ::: "memory")
__device__ __forceinline__ unsigned long long rt() { return __builtin_amdgcn_s_memrealtime(); }
__device__ __forceinline__ unsigned f2bf(float f) { unsigned u = __builtin_bit_cast(unsigned, f); return (u + 0x7fffu + ((u >> 16) & 1u)) >> 16; }
__device__ __forceinline__ unsigned pk2(float lo, float hi) { return f2bf(lo) | (f2bf(hi) << 16); }

#define XB_TMO      128
#define XB_XCNT(j)  (256  + 64 * (j))
#define XB_XSUB(j)  (1280 + 64 * (j))
#define XB_XGEN(j)  (2304 + 64 * (j))
#define XB_TOP      3328
#define XB_TOPGEN   3392
#define XCD_BAR_WORDS 3456
#define XB_SPIN_CAP (1u << 18)

__device__ __forceinline__ unsigned xb_ld(unsigned* p)              { return __hip_atomic_load(p, __ATOMIC_RELAXED, __HIP_MEMORY_SCOPE_AGENT); }
__device__ __forceinline__ unsigned xb_add(unsigned* p, unsigned v) { return __hip_atomic_fetch_add(p, v, __ATOMIC_RELAXED, __HIP_MEMORY_SCOPE_AGENT); }
__device__ __forceinline__ unsigned xb_xcc_id() { return (unsigned)__builtin_amdgcn_s_getreg((3 << 11) | 20) & 0xFu; }
#define XB_SPIN(cond, bar) do { unsigned _sp = 0; while (cond) { __builtin_amdgcn_s_sleep(1); \
    if ((++_sp & 255u) == 0u) { if (xb_ld(&(bar)[XB_TMO])) break; if (_sp > XB_SPIN_CAP) { atomicAdd(&(bar)[XB_TMO], 1u); break; } } } } while (0)

struct XcdBarrier {
    unsigned* bar; unsigned x;
    volatile LAS unsigned* st;
};

__device__ __forceinline__ XcdBarrier xcd_barrier_post(unsigned* bar, volatile LAS unsigned* st) {
    XcdBarrier b; b.bar = bar; b.x = xb_xcc_id(); b.st = st;
    if (threadIdx.x == 0) (void)xb_add(&bar[XB_XCNT(b.x)], 1u);
    return b;
}
__device__ __forceinline__ void xcd_barrier_complete(unsigned* bar, unsigned x, unsigned& nloc, unsigned& nx) {
    const unsigned G = gridDim.x * gridDim.y * gridDim.z;
    unsigned sum, cnt, mine, sp = 0u;
    for (;;) {
        sum = 0u; cnt = 0u; mine = 0u;
#pragma unroll
        for (unsigned j = 0; j < 16; ++j) { const unsigned c = xb_ld(&bar[XB_XCNT(j)]); sum += c; cnt += (c > 0u) ? 1u : 0u; mine = (j == x) ? c : mine; }
        if (sum == G) break;
        __builtin_amdgcn_s_sleep(1);
        if ((++sp & 255u) == 0u) { if (xb_ld(&bar[XB_TMO])) break; if (sp > XB_SPIN_CAP) { atomicAdd(&bar[XB_TMO], 1u); break; } }
    }
    nloc = mine > 0u ? mine : 1u; nx = cnt > 0u ? cnt : 1u;
}

__device__ __forceinline__ void xcd_barrier_leader(const XcdBarrier& b) {
        unsigned* bar = b.bar;
        __builtin_amdgcn_s_waitcnt(0);
        unsigned nloc = b.st[0], nx = b.st[1];
        if (nloc == 0u) { xcd_barrier_complete(bar, b.x, nloc, nx); b.st[0] = nloc; b.st[1] = nx; }
        const unsigned old = xb_add(&bar[XB_XSUB(b.x)], 1u);
        const unsigned gen = old / nloc;
        if (old + 1u == (gen + 1u) * nloc) {
            __builtin_amdgcn_fence(__ATOMIC_RELEASE, "agent");
            asm volatile("s_waitcnt vmcnt(0)" ::: "memory");
            const unsigned og = xb_add(&bar[XB_TOP], 1u);
            const unsigned tg = og / nx;
            if (og + 1u == (tg + 1u) * nx) xb_add(&bar[XB_TOPGEN], 1u);
            else XB_SPIN(xb_ld(&bar[XB_TOPGEN]) == tg, bar);
            __builtin_amdgcn_fence(__ATOMIC_ACQUIRE, "agent");
            xb_add(&bar[XB_XGEN(b.x)], 1u);
            asm volatile("s_waitcnt vmcnt(0)" ::: "memory");
        } else {
            XB_SPIN(xb_ld(&bar[XB_XGEN(b.x)]) == gen, bar);
            __builtin_amdgcn_fence(__ATOMIC_ACQUIRE, "agent");
            asm volatile("s_waitcnt vmcnt(0)" ::: "memory");
        }
}

__device__ __forceinline__ void xcd_barrier(const XcdBarrier& b) {
    asm volatile("s_waitcnt vmcnt(0)" ::: "memory");
    __syncthreads();
    if (threadIdx.x == 0) xcd_barrier_leader(b);
    __syncthreads();
}
constexpr size_t MiB = 1u << 20;
constexpr size_t WS_CTL = 0, CTL_ZERO_BYTES = 1 * MiB;
constexpr size_t WS_MOD = 1 * MiB;
constexpr size_t WS_ROPE = 2 * MiB;
constexpr size_t WS_WSP = 4 * MiB;
constexpr size_t WS_HC = 5 * MiB;
constexpr size_t WS_RST = 13 * MiB;
constexpr size_t WS_W = 16 * MiB;
constexpr size_t W_IN = 0, W_BR = W_IN + (size_t)IN_DIM * DM * 2, W_O = W_BR + (size_t)3 * DM * 2048 * 2, W_GU = W_O + (size_t)DM * DM * 2, W_D = W_GU + (size_t)2 * FF * DM * 2,
                 W_LAYER = W_D + (size_t)DM * FF * 2;
constexpr size_t WS_Z = WS_W + 2 * W_LAYER;
constexpr size_t WS_ACT = WS_Z + (size_t)MT * IN_DIM * 2;
constexpr size_t WS_XB = WS_ACT + (size_t)MT * DM * 2;
constexpr size_t WS_O12 = WS_XB + (size_t)3 * MT * 2048 * 2;
constexpr size_t WS_QK = WS_O12 + (size_t)MT * DM * 4;
constexpr size_t WS_OS = WS_QK + (size_t)MT * DM * 2;
constexpr int MAX_GRID = 320;
constexpr size_t WS_KVF = WS_OS + (size_t)MAX_GRID * 256 * 128 * 4;
constexpr size_t WS_SLAB = WS_KVF + (size_t)8 * MC * 4096 * 4;
constexpr size_t WS_END = WS_SLAB + (size_t)8 * MC * DM * 4;
static_assert(W_LAYER % 256 == 0 && WS_Z % 256 == 0 && WS_ACT % 256 == 0 && WS_XB % 256 == 0 && WS_O12 % 256 == 0 && WS_QK % 256 == 0 && WS_OS % 256 == 0, "alignment");
constexpr int CW_BAR = 4096;

constexpr int NWAVES = 8;
constexpr int RING_BYTES = 131072, MISC_OFF = RING_BYTES + 320, LDS_BYTES = 147456;
static_assert(true, "");
constexpr int PPL = 9, N_PHASES = 1 + PPL * DEPTH;

__device__ __forceinline__ float sx(float v, int k, int lane) { return __uint_as_float((unsigned)__builtin_amdgcn_ds_bpermute((lane ^ k) << 2, (int)__float_as_uint(v))); }
__device__ __forceinline__ float wave_sum(float v, int lane) {
#pragma unroll
    for (int o = 1; o < 64; o <<= 1) v += sx(v, o, lane);
    return v;
}
__device__ __forceinline__ unsigned pkbf(float lo, float hi) { unsigned r; asm volatile("v_cvt_pk_bf16_f32 %0, %1, %2" : "=v"(r) : "v"(lo), "v"(hi)); return r; }
__device__ __forceinline__ float blo(unsigned w) { return __uint_as_float(w << 16); }
__device__ __forceinline__ float bhi(unsigned w) { return __uint_as_float(w & 0xffff0000u); }
__device__ __forceinline__ void unpack8(const v4u w, float (&x)[8]) { x[0] = blo(w.x); x[1] = bhi(w.x); x[2] = blo(w.y); x[3] = bhi(w.y); x[4] = blo(w.z); x[5] = bhi(w.z); x[6] = blo(w.w); x[7] = bhi(w.w); }
__device__ __forceinline__ v4u pack8(const float (&x)[8]) { v4u w; w.x = pkbf(x[0], x[1]); w.y = pkbf(x[2], x[3]); w.z = pkbf(x[4], x[5]); w.w = pkbf(x[6], x[7]); return w; }

struct Args { const float* in[25]; float* out; unsigned char* ws; int ph_lo, ph_hi, bar_region, pad; };
struct Ctx {
    LAS unsigned char* lds; int tid, lane, wave, vcu, G;
    float* out; unsigned char* ws; int bx;
};
__device__ __forceinline__ Ctx launder(const Ctx& F) {
    Ctx P = F; int t = F.tid; asm volatile("" : "+v"(t)); P.tid = t; P.lane = t & 63; P.wave = __builtin_amdgcn_readfirstlane(t >> 6);
    asm volatile("" : "+s"(P.vcu), "+s"(P.G), "+s"(P.bx)); unsigned long long z = 0; asm volatile("" : "+s"(z)); P.ws = F.ws + z; P.out = F.out + z;
    return P;
}


__device__ __forceinline__ void transpose_item(const float* W, int K, int N, bf16* WT, int k0, int n0, int drow0, LAS float* scr, int lane) {
    float tv[32];
#pragma unroll
    for (int i = 0; i < 32; ++i) { const int kk = 2 * i + (lane >> 5); tv[i] = W[(size_t)(k0 + kk) * N + n0 + (lane & 31)]; }
#pragma unroll
    for (int i = 0; i < 32; ++i) { const int kk = 2 * i + (lane >> 5); scr[kk * 33 + (lane & 31)] = tv[i]; }
    LDS_WAIT(); asm volatile("" ::: "memory");
    const int c = lane & 7;
#pragma unroll
    for (int j = 0; j < 4; ++j) { const int n = (lane >> 3) + 8 * j; const LAS float* s = scr + (8 * c) * 33 + n;
        v4u o; o.x = pkbf(s[0 * 33], s[1 * 33]); o.y = pkbf(s[2 * 33], s[3 * 33]); o.z = pkbf(s[4 * 33], s[5 * 33]); o.w = pkbf(s[6 * 33], s[7 * 33]);
        *(GAS v4u*)(WT + (size_t)(drow0 + n) * K + k0 + 8 * c) = o; }
    LDS_WAIT(); asm volatile("" ::: "memory");
}
template <int MODE> __device__ __forceinline__ void transpose_mat(const float* W, int K, int N, bf16* WT, LAS float* scr, int item, int lane) {
    const int nblk = N / 32, kb = item / nblk, nb = item % nblk, n0 = 32 * nb;
    const int drow0 = MODE == 0 ? n0 : ((n0 >> 7) * 256 + (n0 & 127) + (MODE == 2 ? 128 : 0));
    transpose_item(W, K, N, WT, 64 * kb, n0, drow0, scr, lane);
}

__device__ __forceinline__ void sincos_f(float a, float& s, float& c) {
    const double ad = (double)a; const double kq = __builtin_rint(ad * 0.63661977236758134308); const double r = ad - kq * 1.57079632679489661923; const double r2 = r * r;
    const double sp = r * (1.0 + r2 * (-1.0 / 6 + r2 * (1.0 / 120 + r2 * (-1.0 / 5040 + r2 * (1.0 / 362880 + r2 * (-1.0 / 39916800))))));
    const double cp = 1.0 + r2 * (-0.5 + r2 * (1.0 / 24 + r2 * (-1.0 / 720 + r2 * (1.0 / 40320 + r2 * (-1.0 / 3628800 + r2 * (1.0 / 479001600))))));
    const int q = ((int)kq) & 3;
    const double ss = (q == 0) ? sp : (q == 1) ? cp : (q == 2) ? -sp : -cp;
    const double cc = (q == 0) ? cp : (q == 1) ? -sp : (q == 2) ? -cp : sp;
    s = (float)ss; c = (float)cc;
}

constexpr int I_IN = (DM / 64) * (IN_DIM / 32), I_BR = (2048 / 64) * (DM / 32), I_O = (DM / 64) * (DM / 32), I_GU = (DM / 64) * (FF / 32), I_D = (FF / 64) * (DM / 32);
constexpr int I_LAYER = I_IN + 3 * I_BR + I_O + 2 * I_GU + I_D;
__device__ __forceinline__ void weight_item(const Args& A, unsigned char* ws, int it, LAS float* scr, int lane) {
    const int l = it / I_LAYER; int r = it - l * I_LAYER; unsigned char* wl = ws + WS_W + (size_t)l * W_LAYER;
    const float* W; int K, N, mode = 0; bf16* WT;
    if (r < I_IN) { W = A.in[8] + (size_t)l * DM * IN_DIM; K = DM; N = IN_DIM; WT = (bf16*)(wl + W_IN); }
    else if ((r -= I_IN) < I_BR) { W = A.in[11] + (size_t)l * 2048 * DM; K = 2048; N = DM; WT = (bf16*)(wl + W_BR); }
    else if ((r -= I_BR) < I_BR) { W = A.in[16] + (size_t)l * 2048 * DM; K = 2048; N = DM; WT = (bf16*)(wl + W_BR) + (size_t)DM * 2048; }
    else if ((r -= I_BR) < I_BR) { W = A.in[20] + (size_t)l * 2048 * DM; K = 2048; N = DM; WT = (bf16*)(wl + W_BR) + (size_t)2 * DM * 2048; }
    else if ((r -= I_BR) < I_O) { W = A.in[21] + (size_t)l * DM * DM; K = DM; N = DM; WT = (bf16*)(wl + W_O); }
    else if ((r -= I_O) < I_GU) { W = A.in[22] + (size_t)l * DM * FF; K = DM; N = FF; WT = (bf16*)(wl + W_GU); mode = 1; }
    else if ((r -= I_GU) < I_GU) { W = A.in[23] + (size_t)l * DM * FF; K = DM; N = FF; WT = (bf16*)(wl + W_GU); mode = 2; }
    else { r -= I_GU; W = A.in[24] + (size_t)l * FF * DM; K = FF; N = DM; WT = (bf16*)(wl + W_D); }
    const int nblk = N / 32, kb = r / nblk, nb = r - kb * nblk, n0 = 32 * nb;
    const int drow0 = mode == 0 ? n0 : ((n0 >> 7) * 256 + (n0 & 127) + (mode == 2 ? 128 : 0));
    transpose_item(W, K, N, WT, 64 * kb, n0, drow0, scr, lane);
}
__device__ __forceinline__ bool weight_fill_one(const Args& A, const Ctx& F) {
    unsigned j = 0u; if (F.lane == 0) j = __hip_atomic_fetch_add((LAS unsigned*)(F.lds + 147428), 1u, __ATOMIC_RELAXED, __HIP_MEMORY_SCOPE_WORKGROUP);
    j = (unsigned)__builtin_amdgcn_readfirstlane((int)j);
    const long t = (long)F.bx + (long)j * F.G;
    if (t >= (long)I_LAYER) return false;
    weight_item(A, F.ws, I_LAYER + (int)t, (LAS float*)(F.lds + F.wave * 16384), F.lane);
    return true;
}
__device__ __forceinline__ void xcd_barrier_fill(const XcdBarrier& b, const Args& A, const Ctx& F, bool fill) {
    volatile LAS unsigned* flag = (volatile LAS unsigned*)(F.lds + 147424);
    asm volatile("s_waitcnt vmcnt(0)" ::: "memory");
    if (threadIdx.x == 0) *flag = 0u;
    asm volatile("s_waitcnt lgkmcnt(0)" ::: "memory");
    __syncthreads();
    if (threadIdx.x == 0) { xcd_barrier_leader(b); *flag = 1u; }
    else if (fill && threadIdx.x >= 64) {
        bool more = true;
        while (__builtin_amdgcn_readfirstlane((int)*flag) == 0) { if (more) more = weight_fill_one(A, F); else __builtin_amdgcn_s_sleep(4); }
        asm volatile("s_waitcnt vmcnt(0)" ::: "memory");
    }
    __syncthreads();
}

__device__ __forceinline__ void p0_prologue(const Args& A, const Ctx& F) {
    const float* c = A.in[1]; const float* c_ctx = A.in[3]; const float* ada_w = A.in[4]; const float* ada_b = A.in[5];
    const float* norm_mix_g = A.in[6]; const float* norm_ffn_g = A.in[7];
    float* MOD = (float*)(F.ws + WS_MOD);
    LAS float* sv = (LAS float*)F.lds; LAS float* red = (LAS float*)(F.lds + 49152);
    for (int i = F.tid; i < 3 * DM; i += NWAVES * 64) { const int v = i >> 12, k = i & (DM - 1); const float x = v < 2 ? c[v * DM + k] : c_ctx[k]; sv[i] = x / (1.f + __expf(-x)); }
    __syncthreads();
    for (int ch = F.vcu; ch < 256; ch += F.G) {
        const int gcol = ch * 192, l = gcol / NMOD, j0 = gcol % NMOD;
        f32x4 a0 = {0.f, 0.f, 0.f, 0.f}, a1 = a0, a2 = a0;
        if (F.lane < 48) {
            const float* wp = ada_w + (size_t)l * DM * NMOD + (size_t)(F.wave * 512) * NMOD + j0 + F.lane * 4;
            const LAS float* s0 = sv + F.wave * 512;
#pragma unroll 8
            for (int k = 0; k < 512; ++k) { const f32x4 w = *(const f32x4*)(wp + (size_t)k * NMOD); a0 += w * s0[k]; a1 += w * s0[DM + k]; a2 += w * s0[2 * DM + k]; }
            *(LAS f32x4*)(red + (F.wave * 3 + 0) * 192 + F.lane * 4) = a0; *(LAS f32x4*)(red + (F.wave * 3 + 1) * 192 + F.lane * 4) = a1; *(LAS f32x4*)(red + (F.wave * 3 + 2) * 192 + F.lane * 4) = a2;
        }
        __syncthreads();
        for (int o = F.tid; o < 3 * 192; o += NWAVES * 64) { const int v = o / 192, jj = o % 192; float s = 0.f;
#pragma unroll
            for (int w = 0; w < 8; ++w) s += red[(w * 3 + v) * 192 + jj];
            const int j = j0 + jj, q = j >> 12, col = j & (DM - 1); float val = s + ada_b[l * NMOD + j];
            if (q == 1) val = norm_mix_g[l * DM + col] * (1.f + val); else if (q == 4) val = norm_ffn_g[l * DM + col] * (1.f + val);
            MOD[(size_t)(l * 3 + v) * NMOD + j] = val; }
        __syncthreads();
    }
    const int gtid = F.vcu * (NWAVES * 64) + F.tid, NTH = F.G * NWAVES * 64;
    { float* ROPE = (float*)(F.ws + WS_ROPE);
      for (int e = gtid; e < SEQ * 32; e += NTH) { const int t = e >> 5, j = e & 31; const int pos = j < 16 ? (t >> 6) : (t & 63);
          const float inv = exp2f(-(float)(j & 15) * (13.287712379549449f / 16.f)); float s, cs; sincos_f((float)pos * inv, s, cs); ROPE[2 * e] = cs; ROPE[2 * e + 1] = s; } }
    { const float* wsp = A.in[18]; bf16* o = (bf16*)(F.ws + WS_WSP);
      for (int e = gtid; e < DEPTH * 16 * 128 * 128 / 2; e += NTH) ((unsigned*)o)[e] = pkbf(wsp[2 * e], wsp[2 * e + 1]); }
    LAS float* scr = (LAS float*)(F.lds + F.wave * 16384);
    const int gw = F.vcu * NWAVES + F.wave, NGW = F.G * NWAVES;
    for (int it = gw; it < I_LAYER; it += NGW) weight_item(A, F.ws, it, scr, F.lane);
}

__device__ __forceinline__ void norm_phase(const Ctx& F, int l, int which, const float* src_lat, const float* src_ctx, int nrows, bool slab_add, bool write_hc) {
    const float* MOD = (const float*)(F.ws + WS_MOD); bf16* XN = (bf16*)(F.ws + WS_ACT);
    const int gw = F.vcu * NWAVES + F.wave, NGW = F.G * NWAVES;
    for (int m = gw; m < nrows; m += NGW) {
        const float* xr = m < ML ? src_lat + (size_t)m * DM : src_ctx + (size_t)(m - ML) * DM;
        const int cls = m < SEQ ? 0 : (m < ML ? 1 : 2);
        const float* sh = MOD + (size_t)(l * 3 + cls) * NMOD + (which ? 3 : 0) * DM; const float* gs = sh + DM;
        f32x4 v[16], gg[16], sg[16]; float ss = 0.f;
#pragma unroll
        for (int j = 0; j < 16; ++j) v[j] = *(const f32x4*)(xr + 4 * F.lane + 256 * j);

        if (slab_add && m >= ML) {
            const float* sl = (const float*)(F.ws + WS_SLAB) + (size_t)(m - ML) * DM + 4 * F.lane;
#pragma clang loop unroll(disable)
            for (int s = 0; s < 8; s += 2) {
                f32x4 ta[16], tb[16];
#pragma unroll
                for (int j = 0; j < 16; ++j) { ta[j] = *(const f32x4*)(sl + (size_t)s * MC * DM + 256 * j); tb[j] = *(const f32x4*)(sl + (size_t)(s + 1) * MC * DM + 256 * j); }
                __builtin_amdgcn_sched_barrier(0);
#pragma unroll
                for (int j = 0; j < 16; ++j) v[j] += ta[j] + tb[j];
                __builtin_amdgcn_sched_barrier(0);
            }
            if (write_hc) { float* hc = (float*)(F.ws + WS_HC) + (size_t)(m - ML) * DM + 4 * F.lane;
#pragma unroll
                for (int j = 0; j < 16; ++j) *(f32x4*)(hc + 256 * j) = v[j]; }
        }
#pragma unroll
        for (int j = 0; j < 16; ++j) { gg[j] = *(const f32x4*)(gs + 4 * F.lane + 256 * j); sg[j] = *(const f32x4*)(sh + 4 * F.lane + 256 * j); }
#pragma unroll
        for (int j = 0; j < 16; ++j) ss += (v[j].x * v[j].x + v[j].y * v[j].y) + (v[j].z * v[j].z + v[j].w * v[j].w);
        const float rstd = __builtin_amdgcn_rsqf(wave_sum(ss, F.lane) * (1.f / DM) + EPS);
        unsigned long long* o8 = (unsigned long long*)(XN + (size_t)m * DM) + F.lane;
#pragma unroll
        for (int j = 0; j < 16; ++j) { const f32x4 g = gg[j], s = sg[j];
            const f32x4 y = v[j] * rstd * g + s;
            o8[64 * j] = (unsigned long long)pkbf(y.x, y.y) | ((unsigned long long)pkbf(y.z, y.w) << 32); }
    }
}

__device__ __forceinline__ void qk_phase(const Args& A, const Ctx& F, int l, int nrows_stat, bool kvf_ctx) {
    typedef unsigned u32x2 __attribute__((ext_vector_type(2)));
    const bf16* Z = (const bf16*)(F.ws + WS_Z); bf16* QK = (bf16*)(F.ws + WS_QK); const float* ROPE = (const float*)(F.ws + WS_ROPE); float* RST = (float*)(F.ws + WS_RST);
    const float* KVF = (const float*)(F.ws + WS_KVF); bf16* Zw = (bf16*)(F.ws + WS_Z);
    const int gw = F.vcu * NWAVES + F.wave, NGW = F.G * NWAVES, p = F.lane & 7, go = (F.lane >> 3) * 64 + 4 * p;
    constexpr float QC = 0.125f * 1.4426950408889634f;
    const f32x4 gq0 = *(const f32x4*)(A.in[12] + l * 64 + 4 * p) * QC, gq1 = *(const f32x4*)(A.in[12] + l * 64 + 32 + 4 * p) * QC;
    const f32x4 gk0 = *(const f32x4*)(A.in[13] + l * 64 + 4 * p), gk1 = *(const f32x4*)(A.in[13] + l * 64 + 32 + 4 * p);
    for (int m = gw; m < MT; m += NGW) {
        const bf16* zr = Z + (size_t)m * IN_DIM + ZC_Q + go; bf16* qr = QK + (size_t)m * DM + go; const bool lat = m < ML; const int t = m & (SEQ - 1);
        f32x4 cs = {1.f, 1.f, 1.f, 1.f}, sn = {0.f, 0.f, 0.f, 0.f};
        if (lat) { const float* rp = ROPE + ((size_t)t * 32 + 4 * p) * 2; const f32x4 w0 = *(const f32x4*)rp, w1 = *(const f32x4*)(rp + 4); cs = (f32x4){w0.x, w0.z, w1.x, w1.z}; sn = (f32x4){w0.y, w0.w, w1.y, w1.w}; }
        if (m < nrows_stat) {
            const bf16* vr = Z + (size_t)m * IN_DIM + ZC_VM; float ss = 0.f;
#pragma unroll
            for (int i = 0; i < 4; ++i) { float x[8]; unpack8(*(const v4u*)(vr + i * 512 + F.lane * 8), x);
#pragma unroll
                for (int e = 0; e < 8; ++e) ss += x[e] * x[e]; }
            ss = wave_sum(ss, F.lane); if (F.lane == 0) RST[m] = __builtin_amdgcn_rsqf(ss * (1.f / 2048.f) + EPS); }
        const bool fromf = kvf_ctx && !lat;
        if (fromf) {
            const float* vr = KVF + (size_t)(m - ML) * 4096 + 2048; bf16* vo = Zw + (size_t)m * IN_DIM + ZC_V;
#pragma unroll
            for (int i = 0; i < 4; ++i) { f32x4 ta[8], tb[8];
#pragma unroll
                for (int s = 0; s < 8; ++s) { ta[s] = *(const f32x4*)(vr + (size_t)s * MC * 4096 + i * 512 + F.lane * 8); tb[s] = *(const f32x4*)(vr + (size_t)s * MC * 4096 + i * 512 + F.lane * 8 + 4); }
                __builtin_amdgcn_sched_barrier(0);
                const f32x4 a = ((ta[0] + ta[1]) + (ta[2] + ta[3])) + ((ta[4] + ta[5]) + (ta[6] + ta[7])), b = ((tb[0] + tb[1]) + (tb[2] + tb[3])) + ((tb[4] + tb[5]) + (tb[6] + tb[7]));
                v4u w; w.x = pkbf(a.x, a.y); w.y = pkbf(a.z, a.w); w.z = pkbf(b.x, b.y); w.w = pkbf(b.z, b.w); *(v4u*)(vo + i * 512 + F.lane * 8) = w; }
        }
        u32x2 wa[8], wb[8];
        if (!fromf) {
#pragma unroll
            for (int i = 0; i < 8; ++i) { wa[i] = *(const u32x2*)(zr + i * 512); wb[i] = *(const u32x2*)(zr + i * 512 + 32); }
        }
        __builtin_amdgcn_sched_barrier(0);
#pragma unroll
        for (int i = 0; i < 8; ++i) {
            f32x4 x1, x2;
            if (fromf) { if (i < 4) continue; const float* kr = KVF + (size_t)(m - ML) * 4096 + (i - 4) * 512 + go; f32x4 ta[8], tb[8];
#pragma unroll
                for (int s = 0; s < 8; ++s) { ta[s] = *(const f32x4*)(kr + (size_t)s * MC * 4096); tb[s] = *(const f32x4*)(kr + (size_t)s * MC * 4096 + 32); }
                __builtin_amdgcn_sched_barrier(0);
                x1 = ((ta[0] + ta[1]) + (ta[2] + ta[3])) + ((ta[4] + ta[5]) + (ta[6] + ta[7])); x2 = ((tb[0] + tb[1]) + (tb[2] + tb[3])) + ((tb[4] + tb[5]) + (tb[6] + tb[7])); }
            else { const u32x2 w0 = wa[i], w1 = wb[i];
                x1 = (f32x4){blo(w0.x), bhi(w0.x), blo(w0.y), bhi(w0.y)}; x2 = (f32x4){blo(w1.x), bhi(w1.x), blo(w1.y), bhi(w1.y)}; }
            float ss = (x1.x * x1.x + x1.y * x1.y) + (x1.z * x1.z + x1.w * x1.w) + (x2.x * x2.x + x2.y * x2.y) + (x2.z * x2.z + x2.w * x2.w);
            ss += sx(ss, 1, F.lane); ss += sx(ss, 2, F.lane); ss += sx(ss, 4, F.lane);
            const float r = __builtin_amdgcn_rsqf(ss * (1.f / 64.f) + EPS);
            x1 = x1 * r * (i < 4 ? gq0 : gk0); x2 = x2 * r * (i < 4 ? gq1 : gk1);
            const f32x4 y1 = x1 * cs - x2 * sn, y2 = x2 * cs + x1 * sn;
            u32x2 o0, o1; o0.x = pkbf(y1.x, y1.y); o0.y = pkbf(y1.z, y1.w); o1.x = pkbf(y2.x, y2.y); o1.y = pkbf(y2.z, y2.w);
            *(u32x2*)(qr + i * 512) = o0; *(u32x2*)(qr + i * 512 + 32) = o1;
        }
    }
}

__device__ __forceinline__ void conv_phase(const Args& A, const Ctx& F, int l, int nrows) {
    const bf16* Z = (const bf16*)(F.ws + WS_Z); bf16* CV = (bf16*)(F.ws + WS_XB);
    const float* cw = A.in[9] + (size_t)l * 3 * 2048; const float* cb = A.in[10] + (size_t)l * 2048;
    const int gtid = F.vcu * (NWAVES * 64) + F.tid, NTH = F.G * NWAVES * 64;
    for (int it = gtid; it < (nrows / 2) * 256; it += NTH) {
        const int m = 2 * (it >> 8), c = (it & 255) * 8;
        const int t = m < ML ? (m & (SEQ - 1)) : ((m - ML) & (CTXL - 1)), T = m < ML ? SEQ : CTXL;
        const bf16* zr = Z + (size_t)m * IN_DIM + c;
        const bool hp = t > 0, hn = t + 2 < T;
        const v4u zero = {0u, 0u, 0u, 0u};
        const v4u bgA = *(const v4u*)(zr + ZC_BG), bgB = *(const v4u*)(zr + IN_DIM + ZC_BG);
        const v4u c0 = *(const v4u*)(zr + ZC_CG), x0 = *(const v4u*)(zr + ZC_XIN), c1 = *(const v4u*)(zr + IN_DIM + ZC_CG), x1 = *(const v4u*)(zr + IN_DIM + ZC_XIN);
        const v4u cp = hp ? *(const v4u*)(zr - IN_DIM + ZC_CG) : zero, xp = hp ? *(const v4u*)(zr - IN_DIM + ZC_XIN) : zero;
        const v4u cn = hn ? *(const v4u*)(zr + 2 * IN_DIM + ZC_CG) : zero, xn = hn ? *(const v4u*)(zr + 2 * IN_DIM + ZC_XIN) : zero;
        const f32x4 w00 = *(const f32x4*)(cw + c), w01 = *(const f32x4*)(cw + c + 4), w10 = *(const f32x4*)(cw + 2048 + c), w11 = *(const f32x4*)(cw + 2048 + c + 4);
        const f32x4 w20 = *(const f32x4*)(cw + 4096 + c), w21 = *(const f32x4*)(cw + 4096 + c + 4), b0 = *(const f32x4*)(cb + c), b1 = *(const f32x4*)(cb + c + 4);
        float a[8], b[8], zp[8], z0[8], z1[8], zn[8], gA[8], gB[8];
        unpack8(cp, a); unpack8(xp, b);
#pragma unroll
        for (int e = 0; e < 8; ++e) zp[e] = a[e] * b[e];
        unpack8(c0, a); unpack8(x0, b);
#pragma unroll
        for (int e = 0; e < 8; ++e) z0[e] = a[e] * b[e];
        unpack8(c1, a); unpack8(x1, b);
#pragma unroll
        for (int e = 0; e < 8; ++e) z1[e] = a[e] * b[e];
        unpack8(cn, a); unpack8(xn, b);
#pragma unroll
        for (int e = 0; e < 8; ++e) zn[e] = a[e] * b[e];
        unpack8(bgA, gA); unpack8(bgB, gB);
        float yA[8], yB[8];
#pragma unroll
        for (int e = 0; e < 4; ++e) {
            yA[e] = gA[e] * (zp[e] * w00[e] + z0[e] * w10[e] + z1[e] * w20[e] + b0[e]); yA[4 + e] = gA[4 + e] * (zp[4 + e] * w01[e] + z0[4 + e] * w11[e] + z1[4 + e] * w21[e] + b1[e]);
            yB[e] = gB[e] * (z0[e] * w00[e] + z1[e] * w10[e] + zn[e] * w20[e] + b0[e]); yB[4 + e] = gB[4 + e] * (z0[4 + e] * w01[e] + z1[4 + e] * w11[e] + zn[4 + e] * w21[e] + b1[e]); }
        *(v4u*)(CV + (size_t)m * 2048 + c) = pack8(yA); *(v4u*)(CV + (size_t)(m + 1) * 2048 + c) = pack8(yB);
    }
}

__device__ __forceinline__ void mlp_unit(const Args& A, const Ctx& F, int l, int chunk, int g) {
    const bf16* Z = (const bf16*)(F.ws + WS_Z); bf16* MO = (bf16*)(F.ws + WS_XB) + (size_t)2 * MT * 2048; const float* RST = (const float*)(F.ws + WS_RST);
    const bf16* WSP = (const bf16*)(F.ws + WS_WSP) + ((size_t)l * 16 + g) * 128 * 128;
    const float* gnorm = A.in[17] + (size_t)l * 2048 + g * 128; const float* bsp = A.in[19] + ((size_t)l * 16 + g) * 128;
    LAS unsigned char* Vl = F.lds;
    const int r32 = F.lane & 31, hi = F.lane >> 5, rb = F.wave & 3, ch = F.wave >> 2, sr = F.tid >> 4, sc = (F.tid & 15) * 8, row0 = chunk * 128;
    att::bf16x8 pa[2][4];
#pragma unroll
    for (int kt = 0; kt < 2; ++kt)
#pragma unroll
        for (int s = 0; s < 4; ++s) pa[kt][s] = *(const att::bf16x8*)(WSP + (size_t)(32 * rb + r32) * 128 + 64 * kt + 16 * s + 8 * hi);
    const f32x4 gn0 = *(const f32x4*)(gnorm + sc), gn1 = *(const f32x4*)(gnorm + sc + 4);
#pragma unroll
    for (int i = 0; i < 4; ++i) { const int q = sr + 32 * i; float x[8]; unpack8(*(const v4u*)(Z + (size_t)(row0 + q) * IN_DIM + ZC_VM + g * 128 + sc), x);
        const float r = RST[row0 + q];
#pragma unroll
        for (int e = 0; e < 4; ++e) { x[e] = x[e] * r * gn0[e]; x[4 + e] = x[4 + e] * r * gn1[e]; }
        *(LAS v4u*)(Vl + (q >> 6) * 16384 + att::v_st(q & 63, sc)) = pack8(x); }
    __syncthreads();
    att::f32x16 acc0 = {}, acc1 = {};
#pragma unroll
    for (int kt = 0; kt < 2; ++kt) { const int vb = (int)(uintptr_t)Vl + kt * 16384 + ch * 1024 + att::v_rd_base(F.lane);
        att::pv_one<0>(acc0, vb, pa[kt][0], pa[kt][1], pa[kt][2], pa[kt][3]); att::pv_one<1>(acc1, vb, pa[kt][0], pa[kt][1], pa[kt][2], pa[kt][3]); }
    float bias[16]; bf16 u0[16], u1[16];
    const int col = g * 128 + ch * 64 + r32;
#pragma unroll
    for (int r = 0; r < 16; ++r) { const int pr = 32 * rb + att::crow(r, hi); const size_t row = (size_t)(row0 + pr);
        bias[r] = bsp[pr]; u0[r] = Z[row * IN_DIM + ZC_U + col]; u1[r] = Z[row * IN_DIM + ZC_U + col + 32]; }
    __builtin_amdgcn_sched_barrier(0);
#pragma unroll
    for (int r = 0; r < 16; ++r) { const int pr = 32 * rb + att::crow(r, hi); const size_t row = (size_t)(row0 + pr);
        const float a0 = __uint_as_float((unsigned)u0[r] << 16), a1 = __uint_as_float((unsigned)u1[r] << 16);
        MO[row * 2048 + col] = (bf16)(pkbf(a0 * (acc0[r] + bias[r]), 0.f) & 0xffffu); MO[row * 2048 + col + 32] = (bf16)(pkbf(a1 * (acc1[r] + bias[r]), 0.f) & 0xffffu); }
    __syncthreads();
}

__device__ __forceinline__ void attn_phase(const Args& A, const Ctx& F, int l, bool with_ctx, float lam_init) {
    static_assert(att::SHM_ATTN <= RING_BYTES, "attention LDS vs frame");
    const int nchunk = (with_ctx ? MT : ML) / 128;
    const bf16* Z = (const bf16*)(F.ws + WS_Z); const bf16* QK = (const bf16*)(F.ws + WS_QK); bf16* AO = (bf16*)(F.ws + WS_XB) + (size_t)MT * 2048;
    float* OS = (float*)(F.ws + WS_OS) + (size_t)F.vcu * 256 * 128;
    const float* lq = A.in[14] + (size_t)l * 256;
    const float s01 = wave_sum(lq[F.lane] * lq[64 + F.lane], F.lane), s23 = wave_sum(lq[128 + F.lane] * lq[192 + F.lane], F.lane);
    const float lam = __uint_as_float(__builtin_amdgcn_readfirstlane(__float_as_uint(expf(s01) - expf(s23) + lam_init))), osc = 1.f - lam_init;
    const float* subg = A.in[15] + (size_t)l * 128;
    float gqm = fabsf(A.in[12][l * 64 + F.lane]), gkm = fabsf(A.in[13][l * 64 + F.lane]);
#pragma unroll
    for (int o = 1; o < 64; o <<= 1) { gqm = fmaxf(gqm, sx(gqm, o, F.lane)); gkm = fmaxf(gkm, sx(gkm, o, F.lane)); }
    const float m0c = __uint_as_float(__builtin_amdgcn_readfirstlane(__float_as_uint(0.125f * 64.f * 1.02f * gqm * gkm * 1.4426950408889634f)));
    const int npair = 1024 + (with_ctx ? 32 : 0);
    for (int u = F.vcu; u < npair; u += F.G) {
        const bool isl = u < 1024; const int bh = isl ? (u >> 5) : (u - 1024), b = bh >> 4, h = bh & 15;
        const int qrow = isl ? b * SEQ + (u & 31) * 256 : ML + b * CTXL;
        const int rowa = isl ? b * SEQ : qrow, nt0 = isl ? SEQ / 64 : CTXL / 64, rowb = ML + b * CTXL, NT = isl ? SEQ / 64 + CTXL / 64 : CTXL / 64;
#pragma clang loop unroll(disable)
        for (int mp = 0; mp < 2; ++mp)
            att::attn_unit(mp, QK + (size_t)qrow * DM + h * 128 + mp * 64, QK + 2048 + h * 128 + mp * 64, Z + ZC_V + h * 128, OS, AO + (size_t)qrow * 2048 + h * 128, subg, lam, osc, m0c,
                           rowa, nt0, rowb, NT, (char*)F.lds, F.tid);
    }
    {   unsigned* tk = (unsigned*)(F.ws + WS_CTL) + 131072 + (8 + l) * 32; volatile LAS unsigned* slot = (volatile LAS unsigned*)(F.lds + 147440); const int nu = nchunk * 16;
        __syncthreads();
        if (F.tid == 0) slot[0] = __hip_atomic_fetch_add(tk, 1u, __ATOMIC_RELAXED, __HIP_MEMORY_SCOPE_AGENT);
        __syncthreads();
#pragma clang loop unroll(disable)
        for (int k = 0;; ++k) {
            const int u = __builtin_amdgcn_readfirstlane((int)slot[k & 1]);
            if (u >= nu) break;
            unsigned t = 0u; if (F.tid == 0) t = __hip_atomic_fetch_add(tk, 1u, __ATOMIC_RELAXED, __HIP_MEMORY_SCOPE_AGENT);
            mlp_unit(A, F, l, u >> 4, u & 15);
            if (F.tid == 0) slot[(k + 1) & 1] = t;
            __syncthreads();
        }
    }
}

__global__ void __launch_bounds__(NWAVES * 64, 2) fwd_kernel(Args args) {
    extern __shared__ __attribute__((aligned(16))) unsigned char lds[];
    Ctx F;
    F.lds = (LAS unsigned char*)lds; F.tid = threadIdx.x; F.lane = F.tid & 63; F.wave = __builtin_amdgcn_readfirstlane(F.tid >> 6);
    F.G = gridDim.x; F.bx = blockIdx.x; { const int bx = blockIdx.x; F.vcu = (F.G % 8 == 0) ? (bx % 8) * (F.G / 8) + bx / 8 : bx; }
    F.out = args.out; F.ws = args.ws;
    volatile LAS unsigned* MISC = (volatile LAS unsigned*)(F.lds + MISC_OFF);
    for (int u = F.tid; u < (LDS_BYTES - RING_BYTES) / 4; u += NWAVES * 64) ((LAS unsigned*)(F.lds + RING_BYTES))[u] = 0u;
    __syncthreads();
    const int lo = args.ph_lo, hi = args.ph_hi;
    unsigned* barw = (unsigned*)(F.ws + WS_CTL) + CW_BAR + args.bar_region * XCD_BAR_WORDS;
    XcdBarrier bar; bar.bar = barw; bar.x = 0; bar.st = nullptr;
    if (hi - lo > 1) bar = xcd_barrier_post(barw, MISC + 8);
#ifndef PHM
#define PHM 0xfff
#endif
#define IN(k) (lo <= (k) && (k) < hi)
#ifndef PROBE_BASE
#define PROBE_BASE 0
#endif
#ifdef PROBE_PHASE
#define PT0(k) do { if ((k) == PROBE_PHASE) { pc0 = __builtin_readcyclecounter(); pt0 = __builtin_amdgcn_s_memrealtime(); } } while (0)
#define PT1(k) do { if ((k) == PROBE_PHASE) { pc1 = __builtin_readcyclecounter(); pt1 = __builtin_amdgcn_s_memrealtime(); } } while (0)
#else
#define PT0(k) do {} while (0)
#define PT1(k) do {} while (0)
#endif
#if defined(CLOCK_PROBE) && CLOCK_PROBE == 9
#define SEAM(k) do { if (IN(k) && IN((k) + 1)) { const unsigned long long ta_ = __builtin_amdgcn_s_memrealtime(); xcd_barrier(bar); pwait += __builtin_amdgcn_s_memrealtime() - ta_; } } while (0)
#else
#define SEAM(k) do { if (IN(k) && IN((k) + 1)) xcd_barrier(bar); } while (0)
#endif
#define SEAMF(k) do { if (IN(k) && IN((k) + 1)) xcd_barrier_fill(bar, args, F, l == 0); } while (0)

#if defined(CLOCK_PROBE) || defined(PROBE_PHASE)
    unsigned long long pc0 = 0, pc1 = 0, pt0 = 0, pt1 = 1, pwait = 0; (void)pwait; (void)pc0; (void)pc1;
#endif
    if ((PHM & 1) && IN(0)) { PT0(0); const Ctx P = launder(F); p0_prologue(args, P); PT1(0); SEAM(0); }

    for (int l = 0; l < DEPTH; ++l) {
        const int pb = 1 + PPL * l; const bool last = l + 1 == DEPTH; const int MR = last ? ML : MT;
#define TK(k) ((unsigned*)(P.ws + WS_CTL) + 131072 + (l * 4 + (k)) * 32)
#define PTRS() bf16* Zb = (bf16*)(P.ws + WS_Z); bf16* ACT = (bf16*)(P.ws + WS_ACT); bf16* XB = (bf16*)(P.ws + WS_XB); float* YF = (float*)(P.ws + WS_O12); float* HC = (float*)(P.ws + WS_HC); \
        bf16* HID = (bf16*)(P.ws + WS_Z); const unsigned char* wl = P.ws + WS_W + (size_t)l * W_LAYER; const float* MODl = (const float*)(P.ws + WS_MOD) + (size_t)l * 3 * NMOD; \
        const float* h_lat = l == 0 ? args.in[0] : P.out; const float* h_ctx = l == 0 ? args.in[2] : HC; \
        (void)Zb; (void)ACT; (void)XB; (void)YF; (void)HC; (void)HID; (void)wl; (void)MODl; (void)h_lat; (void)h_ctx;
        if ((PHM & 2) && IN(pb + 0)) { PT0(pb + 0); const Ctx P = launder(F); PTRS(); norm_phase(P, l, 0, h_lat, h_ctx, MT, l > 0, false); if (l == 1) { __syncthreads(); while (weight_fill_one(args, P)) {} } PT1(pb + 0); SEAM(pb + 0); }
        if ((PHM & 4) && IN(pb + 1)) { PT0(pb + 1); const Ctx P = launder(F); PTRS();
            pg8::Gemm g{ACT, (const bf16*)(wl + W_IN), MT, IN_DIM, DM}; pg8::InOrder S; S.init(P.G, P.bx, last); S.S.ticketed(TK(0), P.lds);
            pg8::EpiZ E{Zb, (float*)(P.ws + WS_KVF)};
            pg8::gemm_phase<pg8::EpiZ, pg8::InOrder, true, true>(P.lds, P.tid, g, S, E);
            PT1(pb + 1); SEAMF(pb + 1);
        }
        if ((PHM & 8) && IN(pb + 2)) { PT0(pb + 2); { const Ctx P = launder(F); qk_phase(args, P, l, MR, last); } { const Ctx P = launder(F); conv_phase(args, P, l, MR); } PT1(pb + 2); SEAM(pb + 2); }
        if ((PHM & 16) && IN(pb + 3)) { PT0(pb + 3); const Ctx P = launder(F); attn_phase(args, P, l, !last, l == 0 ? 0.2f : 0.35550906759096924f); PT1(pb + 3); SEAM(pb + 3); }
        if ((PHM & 64) && IN(pb + 4)) { PT0(pb + 4); const Ctx P = launder(F); PTRS();
            pg8::Gemm g{XB, (const bf16*)(wl + W_BR), 3 * MT, 3 * DM, 2048}; pg8::BranchOrder S{P.G, P.bx, MR / 256};
            pg8::EpiBr E{Zb, ACT};
            pg8::gemm_phase<pg8::EpiBr, pg8::BranchOrder, true, true>(P.lds, P.tid, g, S, E);
            PT1(pb + 4); SEAMF(pb + 4);
        }
        if ((PHM & 128) && IN(pb + 5)) { PT0(pb + 5); const Ctx P = launder(F); PTRS();
            pg8::Gemm g{ACT, (const bf16*)(wl + W_O), MR, DM, DM}; pg8::ResOrder S; S.init(P.G, P.bx, DM, !last); S.S.ticketed(TK(1), P.lds);
            pg8::EpiRes E{h_lat, h_ctx, P.out, HC, MODl + 2 * DM, (float*)(P.ws + WS_SLAB)};
            pg8::gemm_phase<pg8::EpiRes, pg8::ResOrder, true, true>(P.lds, P.tid, g, S, E);
            PT1(pb + 5); SEAMF(pb + 5);
        }
        if ((PHM & 256) && IN(pb + 6)) { PT0(pb + 6); const Ctx P = launder(F); PTRS(); norm_phase(P, l, 1, P.out, l == 0 ? args.in[2] : HC, MR, !last, !last); PT1(pb + 6); SEAM(pb + 6); }
        if ((PHM & 512) && IN(pb + 7)) { PT0(pb + 7); const Ctx P = launder(F); PTRS();
            pg8::Gemm g{ACT, (const bf16*)(wl + W_GU), MR, 2 * FF, DM}; pg8::StaticOrder S; S.init(MR, 2 * FF, P.G, P.bx, DM); S.ticketed(TK(2), P.lds);
            pg8::EpiGU E{HID};
            pg8::gemm_phase<pg8::EpiGU, pg8::StaticOrder, true, true>(P.lds, P.tid, g, S, E);
            PT1(pb + 7); SEAMF(pb + 7);
        }
        if ((PHM & 1024) && IN(pb + 8)) { PT0(pb + 8); const Ctx P = launder(F); PTRS();
            pg8::Gemm g{HID, (const bf16*)(wl + W_D), MR, DM, FF}; pg8::ResOrder S; S.init(P.G, P.bx, FF, !last); S.S.ticketed(TK(3), P.lds);
            pg8::EpiRes E{P.out, HC, P.out, HC, MODl + 5 * DM, (float*)(P.ws + WS_SLAB)};
            pg8::gemm_phase<pg8::EpiRes, pg8::ResOrder, true, true>(P.lds, P.tid, g, S, E);
            PT1(pb + 8); SEAMF(pb + 8);
        }
    }
#if defined(CLOCK_PROBE) || defined(PROBE_PHASE)
    {
        unsigned* pa = (unsigned*)(F.ws + WS_CTL) + 65536;
        if (threadIdx.x == 0) pa[blockIdx.x] = (unsigned)(pt1 - pt0);
        xcd_barrier(bar);
        float val = 0.f;
#ifdef PROBE_PHASE
        if (blockIdx.x == 0 && threadIdx.x == 0) { unsigned mx = 0, mn = 0xffffffffu; unsigned long long sm = 0; int imx = 0;
            for (unsigned b = 0; b < gridDim.x; ++b) { const unsigned v = __hip_atomic_load(pa + b, __ATOMIC_RELAXED, __HIP_MEMORY_SCOPE_AGENT); sm += v; if (v > mx) { mx = v; imx = (int)b; } if (v < mn) mn = v; }
            const float ghz = (float)(pc1 - pc0) / (float)(pt1 - pt0) * 0.1f;
            float xm[8]; unsigned xc[8];
            for (int x = 0; x < 8; ++x) { xm[x] = 0.f; xc[x] = 0; }
            for (unsigned b = 0; b < gridDim.x; ++b) { const unsigned v = __hip_atomic_load(pa + b, __ATOMIC_RELAXED, __HIP_MEMORY_SCOPE_AGENT); xm[b & 7] += (float)v; xc[b & 7]++; }
            float xmax = 0.f, xmin = 1e30f; int ixmax = 0;
            for (int x = 0; x < 8; ++x) { const float m = xm[x] / (float)xc[x]; if (m > xmax) { xmax = m; ixmax = x; } if (m < xmin) xmin = m; }
            if (PROBE_KIND == 9) val = ((float)mx - (float)(sm / gridDim.x)) * 0.01f + 35.f; else if (PROBE_KIND == 8) val = (float)mx * 0.01f - (float)PROBE_BASE; else if (PROBE_KIND == 7) val = 10.f * ((float)mx * 0.001f - (float)PROBE_BASE); else if (PROBE_KIND == 5) val = (xmax - xmin) * 0.01f; else if (PROBE_KIND == 6) val = 40.f + 10.f * (float)ixmax; else
            val = PROBE_KIND == 0 ? (float)mx * 0.001f : PROBE_KIND == 1 ? (float)(mx - mn) * 0.01f : PROBE_KIND == 2 ? (float)(sm / gridDim.x) * 0.001f : PROBE_KIND == 3 ? (float)(imx & 7) * 10.f + 1.f : 100.f * ghz; }
#else
        val = CLOCK_PROBE == 9 ? (float)pwait * 0.001f : 0.f;
#endif
        f32x4* o4 = (f32x4*)F.out; const size_t n4 = (size_t)ML * DM / 4, per = n4 / gridDim.x;
        for (size_t i = (size_t)blockIdx.x * per + threadIdx.x; i < (size_t)(blockIdx.x + 1) * per; i += NWAVES * 64) o4[i] = (f32x4){3000.f, 3000.f, 3000.f, 3000.f};
        __syncthreads();
        if (blockIdx.x == 0 && threadIdx.x == 0) { asm volatile("s_waitcnt vmcnt(0)" ::: "memory"); F.out[0] = 100.f * val; }
    }
#endif
#undef IN
#undef SEAM
}

#ifndef MK_PER_PHASE
#define MK_PER_PHASE 0
#endif
extern "C" void kernel_launch(void* const* d_in, const int* in_sizes, int n_in, void* d_out, int out_size, void* d_ws, size_t ws_size, hipStream_t stream) {
    static int grid = 0;
    if (grid == 0) {
        if (n_in != 25 || in_sizes[0] != ML * DM || out_size != ML * DM || ws_size < WS_END) {
            fprintf(stderr, "kernel_launch: shape mismatch: n_in %d in0 %d out %d ws %zu (need %zu); nothing launched\n", n_in, n_in > 0 ? in_sizes[0] : -1, out_size, ws_size, (size_t)WS_END); grid = -1; return; }
        int dev = 0, cus = 0, per_cu = 0;
        if (hipGetDevice(&dev) != hipSuccess || hipDeviceGetAttribute(&cus, hipDeviceAttributeMultiprocessorCount, dev) != hipSuccess) { grid = -1; return; }
        if (hipFuncSetAttribute((const void*)fwd_kernel, hipFuncAttributeMaxDynamicSharedMemorySize, LDS_BYTES) != hipSuccess) { fprintf(stderr, "kernel_launch: hipFuncSetAttribute failed\n"); grid = -1; return; }
        if (hipOccupancyMaxActiveBlocksPerMultiprocessor(&per_cu, (const void*)fwd_kernel, NWAVES * 64, LDS_BYTES) != hipSuccess || per_cu < 1)
            fprintf(stderr, "kernel_launch: note: occupancy query reports %d workgroups per CU\n", per_cu);
        (void)hipGetLastError();
        grid = cus > MAX_GRID ? MAX_GRID : cus;
    }
    if (grid < 0) return;
    if (hipMemsetAsync((char*)d_ws + WS_CTL, 0, CTL_ZERO_BYTES, stream) != hipSuccess) return;
    Args a{};
    for (int i = 0; i < 25; ++i) a.in[i] = (const float*)d_in[i];
    a.out = (float*)d_out; a.ws = (unsigned char*)d_ws; a.pad = 0;
#if MK_PER_PHASE
    constexpr int NL = N_PHASES; int rl[NL][2]; for (int p = 0; p < NL; ++p) { rl[p][0] = p; rl[p][1] = p + 1; }
#elif defined(PROBE_SEQ)
    const int rl[][2] = PROBE_SEQ; constexpr int NL = sizeof(rl) / sizeof(rl[0]);
#else
    constexpr int NL = 1; const int rl[1][2] = {{0, N_PHASES}};
#endif
    for (int li = 0; li < NL; ++li) { a.ph_lo = rl[li][0]; a.ph_hi = rl[li][1]; a.bar_region = li;
        hipLaunchKernelGGL(fwd_kernel, dim3(grid), dim3(NWAVES * 64), LDS_BYTES, stream, a); }
    const hipError_t le = hipPeekAtLastError();
    if (le != hipSuccess) fprintf(stderr, "kernel_launch: launch failed: %s\n", hipGetErrorName(le));
}
```

```cpp
#include <hip/hip_runtime.h>
#include <hip/hip_bf16.h>
#include <cstdio>
#include <cstdint>

constexpr int DM = 4096, NBATCH = 2, SEQ = 8192, CTXL = 256, DEPTH = 2;
constexpr int ML = NBATCH * SEQ, MC = NBATCH * CTXL, MT = ML + MC;
constexpr int IN_DIM = 28672, FF = 11008, NMOD = 6 * DM;
constexpr int ZC_BG = 0, ZC_CG = 2048, ZC_XIN = 4096, ZC_Q = 6144, ZC_K = 8192, ZC_V = 10240, ZC_U = 12288, ZC_VM = 14336, ZC_GATE = 16384;
constexpr float EPS = 1e-6f;
constexpr int NTM = MT / 256;

namespace pg8 {
#define PG8_LAS __attribute__((address_space(3)))
typedef unsigned short bf16_t;
typedef short bf16x8 __attribute__((ext_vector_type(8)));
typedef float f32x4 __attribute__((ext_vector_type(4)));
typedef unsigned u32x4 __attribute__((ext_vector_type(4)));
constexpr int BM = 256, BK = 64, HALF = 128, HTB = HALF * BK * 2  , STAGE_BYTES = 8 * HTB, NXCD = 8, WGM = 4;

__host__ __device__ __forceinline__ int lds_byte(int r, int c) { const int st = (r >> 4) * 2 + (c >> 5), rr = r & 15, cc = c & 31, ob = rr * 64 + cc * 2; return st * 1024 + (ob ^ (((ob >> 9) & 1) << 5)); }
__host__ __device__ __forceinline__ void stage_rc(int b, int& R, int& C) { const int st = b / 1024, sb = b % 1024, swz = sb ^ (((sb >> 9) & 1) << 5); R = (st >> 1) * 16 + swz / 64; C = (st & 1) * 32 + (swz % 64) / 2; }
__host__ __device__ __forceinline__ int perm32(int rho) { const int n = rho >> 4, i = rho & 15; return 8 * (i >> 2) + 4 * n + (i & 3); }

struct Unit { int pm, pn, k0, nk, ks; };
struct Gemm { const bf16_t* A; const bf16_t* Bt; int M, N, K; };

#ifndef XROT
#define XROT 0
#endif
struct StaticOrder {
    int nM, nN, nwg, G, c, nkf;
    int rs; unsigned* tk; PG8_LAS unsigned* slot;
    __host__ __device__ void init(int M, int N, int G_, int c_, int K_) { nM = M / BM; nN = N / BM; nwg = nM * nN; G = G_; c = c_; nkf = K_ / BK; rs = 0x7fffffff; tk = nullptr; slot = nullptr; }
    __device__ void ticketed(unsigned* t, PG8_LAS unsigned char* lds) { const int r = nwg / G; if (r >= 3 && !(G & 7)) { rs = r - 1; tk = t; slot = (PG8_LAS unsigned*)(lds + 147440); } }
    __device__ __forceinline__ long lin_t(int i) const {
        if (i + 1 < rs) return lin(i);
        if (threadIdx.x == 0) { const unsigned t = __hip_atomic_fetch_add(tk, 1u, __ATOMIC_RELAXED, __HIP_MEMORY_SCOPE_AGENT); *(volatile PG8_LAS unsigned*)(slot + ((i + 1) & 1)) = t; }
        if (i < rs) return lin(i);
        const unsigned t = *(volatile PG8_LAS unsigned*)(slot + (i & 1));
        return (long)rs * G + (long)__builtin_amdgcn_readfirstlane((int)t);
    }
    __host__ __device__ long lin(int i) const { return (G & 7) ? (long)i * G + c : (long)i * G + (long)((c + XROT) & 7) * (G >> 3) + (c >> 3); }
    __host__ __device__ void tile_of(int U, int& pm, int& pn) const {
        constexpr int CW = 8, R = WGM; const int cc = U / (nM * CW); int cw = nN - cc * CW; cw = cw > CW ? CW : cw;
        const int up = U - cc * nM * CW, g = up / (R * cw); int rg = nM - R * g; rg = rg > R ? R : rg;
        const int upp = up - g * R * cw; pn = cc * CW + upp / rg; pm = R * g + upp % rg;
    }
    __device__ __forceinline__ bool from_lin(long L, Unit& u) const {
        if (L >= nwg) return false;
        tile_of((int)L, u.pm, u.pn); u.k0 = 0; u.nk = nkf; u.ks = -1; return true;
    }
    __device__ __forceinline__ bool next(int i, Unit& u) const { return from_lin(lin_t(i), u); }
    __device__ __forceinline__ void a_ready(const Unit&) const {}
    __device__ __forceinline__ void done(const Unit&) const {}
};

__device__ __forceinline__ unsigned cvt_pk_bf16(float lo, float hi) { unsigned r; asm volatile("v_cvt_pk_bf16_f32 %0, %1, %2" : "=v"(r) : "v"(lo), "v"(hi)); return r; }
typedef float f32x2 __attribute__((ext_vector_type(2)));
__device__ __forceinline__ float fsigmoid(float x) { return __builtin_amdgcn_rcpf(1.f + __builtin_amdgcn_exp2f(-1.4426950408889634f * x)); }
__device__ __forceinline__ float fgelu(float x) { const float t = x * (1.f + 0.044715f * x * x); return x * __builtin_amdgcn_rcpf(1.f + __builtin_amdgcn_exp2f(-2.3022081981f * t)); }
__device__ __forceinline__ float bflo(unsigned w) { return __uint_as_float(w << 16); }
__device__ __forceinline__ float bfhi(unsigned w) { return __uint_as_float(w & 0xffff0000u); }

struct EpiZ {
    static constexpr bool PERM = true, AFTER_DRAIN = false, DRAIN_AFTER = false;
    __device__ static __forceinline__ bool reset_after(const Unit&) { return true; }
    bf16_t* Z; float* KVF;
    __device__ __forceinline__ void operator()(const f32x4 (&acc)[2][2][4][2], const Unit& u, int wr, int wc, int fr, int fq) const {
        const int row0 = u.pm * BM + wr * 64 + fr, col0 = u.pn * BM + wc * 32 + 8 * fq;
        if (u.ks >= 0) {
            float* slab = KVF + (size_t)u.ks * MC * 4096;
#pragma unroll
            for (int ai = 0; ai < 2; ++ai)
#pragma unroll
                for (int m = 0; m < 4; ++m) { float* rowp = slab + (size_t)(row0 - ML + ai * HALF + m * 16) * 4096 + (col0 - ZC_K);
#pragma unroll
                    for (int bj = 0; bj < 2; ++bj) { *(f32x4*)(rowp + bj * HALF) = acc[ai][bj][m][0]; *(f32x4*)(rowp + bj * HALF + 4) = acc[ai][bj][m][1]; } }
            return;
        }
        const int mode = u.pn < 48 ? 0 : (u.pn < 64 ? 1 : 2);
#pragma unroll
        for (int ai = 0; ai < 2; ++ai)
#pragma unroll
            for (int m = 0; m < 4; ++m) { bf16_t* rowp = Z + (size_t)(row0 + ai * HALF + m * 16) * IN_DIM + col0;
#pragma unroll
                for (int bj = 0; bj < 2; ++bj) { f32x4 v0 = acc[ai][bj][m][0], v1 = acc[ai][bj][m][1];
                    if (mode == 1) {
#pragma unroll
                        for (int e = 0; e < 4; ++e) { v0[e] = fgelu(v0[e]); v1[e] = fgelu(v1[e]); } }
                    else if (mode == 2) {
#pragma unroll
                        for (int e = 0; e < 4; ++e) { v0[e] = fmaxf(fsigmoid(v0[e]), 1e-7f); v1[e] = fmaxf(fsigmoid(v1[e]), 1e-7f); } }
                    u32x4 w; w.x = cvt_pk_bf16(v0[0], v0[1]); w.y = cvt_pk_bf16(v0[2], v0[3]); w.z = cvt_pk_bf16(v1[0], v1[1]); w.w = cvt_pk_bf16(v1[2], v1[3]);
                    *(u32x4*)(rowp + bj * HALF) = w; } }
    }
};

struct EpiBr {
    static constexpr bool PERM = true, AFTER_DRAIN = false, DRAIN_AFTER = true;
    const bf16_t* Z; bf16_t* Y;
    __device__ static __forceinline__ bool reset_after(const Unit& u) { return u.pm >= 2 * NTM; }
    __device__ __forceinline__ void operator()(f32x4 (&acc)[2][2][4][2], const Unit& u, int wr, int wc, int fr, int fq) const {
        const int br = u.pm / NTM, pm = u.pm - br * NTM, pn = u.pn - br * 16;
        const int row0 = pm * BM + wr * 64 + fr, col0 = pn * BM + wc * 32 + 8 * fq;
        if (br < 2) {
#pragma unroll
            for (int ai = 0; ai < 2; ++ai)
#pragma unroll
                for (int mh = 0; mh < 2; ++mh) {
                    u32x4 g[2][2], h[2][2];
#pragma unroll
                    for (int mm = 0; mm < 2; ++mm)
#pragma unroll
                        for (int bj = 0; bj < 2; ++bj) { const bf16_t* gp = Z + (size_t)(row0 + ai * HALF + (2 * mh + mm) * 16) * IN_DIM + ZC_GATE + br * DM + col0 + bj * HALF;
                            g[mm][bj] = *(const u32x4*)gp; h[mm][bj] = *(const u32x4*)(gp + DM); }
                    __builtin_amdgcn_sched_barrier(0);
#pragma unroll
                    for (int mm = 0; mm < 2; ++mm)
#pragma unroll
                        for (int bj = 0; bj < 2; ++bj) { const u32x4 gg = g[mm][bj], hh = h[mm][bj]; f32x4& v0 = acc[ai][bj][2 * mh + mm][0]; f32x4& v1 = acc[ai][bj][2 * mh + mm][1];
                            v0[0] *= bflo(gg.x) * __builtin_amdgcn_rcpf(bflo(hh.x)); v0[1] *= bfhi(gg.x) * __builtin_amdgcn_rcpf(bfhi(hh.x)); v0[2] *= bflo(gg.y) * __builtin_amdgcn_rcpf(bflo(hh.y)); v0[3] *= bfhi(gg.y) * __builtin_amdgcn_rcpf(bfhi(hh.y));
                            v1[0] *= bflo(gg.z) * __builtin_amdgcn_rcpf(bflo(hh.z)); v1[1] *= bfhi(gg.z) * __builtin_amdgcn_rcpf(bfhi(hh.z)); v1[2] *= bflo(gg.w) * __builtin_amdgcn_rcpf(bflo(hh.w)); v1[3] *= bfhi(gg.w) * __builtin_amdgcn_rcpf(bfhi(hh.w)); }
                    __builtin_amdgcn_sched_barrier(0);
                }
        } else {
#pragma unroll
            for (int ai = 0; ai < 2; ++ai) {
                u32x4 g[4][2];
#pragma unroll
                for (int m = 0; m < 4; ++m)
#pragma unroll
                    for (int bj = 0; bj < 2; ++bj) g[m][bj] = *(const u32x4*)(Z + (size_t)(row0 + ai * HALF + m * 16) * IN_DIM + ZC_GATE + 2 * DM + col0 + bj * HALF);
                __builtin_amdgcn_sched_barrier(0);
#pragma unroll
                for (int m = 0; m < 4; ++m)
#pragma unroll
                    for (int bj = 0; bj < 2; ++bj) { const u32x4 gg = g[m][bj]; const f32x4 a0 = acc[ai][bj][m][0], a1 = acc[ai][bj][m][1];
                        u32x4 w; w.x = cvt_pk_bf16(a0[0] * bflo(gg.x), a0[1] * bfhi(gg.x)); w.y = cvt_pk_bf16(a0[2] * bflo(gg.y), a0[3] * bfhi(gg.y));
                        w.z = cvt_pk_bf16(a1[0] * bflo(gg.z), a1[1] * bfhi(gg.z)); w.w = cvt_pk_bf16(a1[2] * bflo(gg.w), a1[3] * bfhi(gg.w));
                        *(u32x4*)(Y + (size_t)(row0 + ai * HALF + m * 16) * DM + col0 + bj * HALF) = w; }
                __builtin_amdgcn_sched_barrier(0);
            }
        }
    }
};

struct EpiRes {
    static constexpr bool PERM = false, AFTER_DRAIN = false, DRAIN_AFTER = true;
    __device__ static __forceinline__ bool reset_after(const Unit&) { return true; }
    const float* src_lat; const float* src_ctx; float* dst_lat; float* dst_ctx; const float* gvec; float* slabs;
    __device__ __forceinline__ void operator()(const f32x4 (&acc)[2][2][4][2], const Unit& u, int wr, int wc, int fr, int fq) const {
        const int pm = u.pm, cls = pm < 32 ? 0 : (pm < 64 ? 1 : 2);
        const float* src = pm < 64 ? src_lat + (size_t)pm * BM * DM : src_ctx + (size_t)(pm - 64) * BM * DM;
        float* dst = pm < 64 ? dst_lat + (size_t)pm * BM * DM : dst_ctx + (size_t)(pm - 64) * BM * DM;
        const int col0 = u.pn * BM + wc * 32 + 4 * fq; const float* gv = gvec + (size_t)cls * NMOD + col0;
        f32x4 g[2][2];
#pragma unroll
        for (int bj = 0; bj < 2; ++bj)
#pragma unroll
            for (int n = 0; n < 2; ++n) g[bj][n] = *(const f32x4*)(gv + bj * HALF + n * 16);
        if (u.ks >= 0) {
            float* slab = slabs + (size_t)u.ks * MC * DM + (size_t)(pm - 64) * BM * DM;
#pragma unroll
            for (int ai = 0; ai < 2; ++ai)
#pragma unroll
                for (int m = 0; m < 4; ++m) { float* rowp = slab + (size_t)(ai * HALF + wr * 64 + m * 16 + fr) * DM + col0;
#pragma unroll
                    for (int bj = 0; bj < 2; ++bj)
#pragma unroll
                        for (int n = 0; n < 2; ++n) *(f32x4*)(rowp + bj * HALF + n * 16) = g[bj][n] * acc[ai][bj][m][n]; }
            return;
        }
#pragma unroll
        for (int am = 0; am < 4; ++am) { const int ai = am >> 1, m0 = (am & 1) * 2;
            f32x4 s[2][2][2];
#pragma unroll
            for (int mm = 0; mm < 2; ++mm) { const size_t off = (size_t)(ai * HALF + wr * 64 + (m0 + mm) * 16 + fr) * DM + col0;
#pragma unroll
                for (int bj = 0; bj < 2; ++bj)
#pragma unroll
                    for (int n = 0; n < 2; ++n) s[mm][bj][n] = *(const f32x4*)(src + off + bj * HALF + n * 16); }
            __builtin_amdgcn_sched_barrier(0);
#pragma unroll
            for (int mm = 0; mm < 2; ++mm) { const size_t off = (size_t)(ai * HALF + wr * 64 + (m0 + mm) * 16 + fr) * DM + col0;
#pragma unroll
                for (int bj = 0; bj < 2; ++bj)
#pragma unroll
                    for (int n = 0; n < 2; ++n) *(f32x4*)(dst + off + bj * HALF + n * 16) = s[mm][bj][n] + g[bj][n] * acc[ai][bj][m0 + mm][n]; }
            __builtin_amdgcn_sched_barrier(0);
        }
    }
};

struct EpiGU {
    static constexpr bool PERM = true, AFTER_DRAIN = false, DRAIN_AFTER = false;
    __device__ static __forceinline__ bool reset_after(const Unit&) { return true; }
    bf16_t* H;
    __device__ __forceinline__ void operator()(const f32x4 (&acc)[2][2][4][2], const Unit& u, int wr, int wc, int fr, int fq) const {
        const int row0 = u.pm * BM + wr * 64 + fr, col0 = u.pn * HALF + wc * 32 + 8 * fq;
#pragma unroll
        for (int ai = 0; ai < 2; ++ai)
#pragma unroll
            for (int m = 0; m < 4; ++m) { f32x4 g0 = acc[ai][0][m][0], g1 = acc[ai][0][m][1]; const f32x4 u0 = acc[ai][1][m][0], u1 = acc[ai][1][m][1];
#pragma unroll
                for (int e = 0; e < 4; ++e) { g0[e] = g0[e] * fsigmoid(g0[e]) * u0[e]; g1[e] = g1[e] * fsigmoid(g1[e]) * u1[e]; }
                u32x4 w; w.x = cvt_pk_bf16(g0[0], g0[1]); w.y = cvt_pk_bf16(g0[2], g0[3]); w.z = cvt_pk_bf16(g1[0], g1[1]); w.w = cvt_pk_bf16(g1[2], g1[3]);
                *(u32x4*)(H + (size_t)(row0 + ai * HALF + m * 16) * FF + col0) = w; }
    }
};

struct BranchOrder {
    int G, c, nM;
    __device__ bool next(int i, Unit& u) const {
        const int ti = i / 3, br = i - 3 * ti; StaticOrder T; T.nM = nM; T.nN = 16; T.nwg = nM * 16; T.G = G; T.c = c; T.nkf = 2048 / BK;
        const long L = T.lin(ti); if (L >= T.nwg) return false;
        int pm, pn; T.tile_of((int)L, pm, pn);
        u.pm = br * NTM + pm; u.pn = br * 16 + pn; u.k0 = 0; u.nk = 2048 / BK; u.ks = -1; return true;
    }
    __device__ __forceinline__ void a_ready(const Unit&) const {}
    __device__ __forceinline__ void done(const Unit&) const {}
};
__device__ __forceinline__ void ksplit8(int nkf, int s, int& k0, int& nk) { const int e = (nkf / 8) & ~1, half = (nkf - 8 * e) / 2; k0 = s * e + 2 * (s < half ? s : half); nk = e + (s < half ? 2 : 0); }
struct InOrder {
    StaticOrder S; int nmain, kv_only;
    __device__ void init(int G, int c, bool last) { kv_only = last; S.init(last ? ML : MT, IN_DIM, G, c, DM); nmain = S.nwg; }
    __device__ bool next(int i, Unit& u) const {
        const long L0 = S.lin_t(i); if (S.from_lin(L0, u)) return true;
        if (!kv_only) return false;
        const long L = L0 - nmain; if (L < 0 || L >= 256) return false;
        const int tile = (int)(L >> 3); u.pm = 64 + (tile >> 4); u.pn = 32 + (tile & 15); u.ks = (int)(L & 7); ksplit8(DM / BK, u.ks, u.k0, u.nk); return true;
    }
    __device__ __forceinline__ void a_ready(const Unit&) const {}
    __device__ __forceinline__ void done(const Unit&) const {}
};
struct ResOrder {
    StaticOrder S; int nmain, with_ctx;
    __device__ void init(int G, int c, int K, bool ctx) { with_ctx = ctx; S.init(ML, DM, G, c, K); nmain = S.nwg; }
    __device__ bool next(int i, Unit& u) const {
        const long L0 = S.lin_t(i); if (S.from_lin(L0, u)) return true;
        if (!with_ctx) return false;
        const long L = L0 - nmain; if (L < 0 || L >= 256) return false;
        const int tile = (int)(L >> 3); u.pm = 64 + (tile >> 4); u.pn = tile & 15; u.ks = (int)(L & 7); ksplit8(S.nkf, u.ks, u.k0, u.nk); return true;
    }
    __device__ __forceinline__ void a_ready(const Unit&) const {}
    __device__ __forceinline__ void done(const Unit&) const {}
};

template <class Epi, class Sched, bool ALIGN_EPI = false, bool SP2 = false>
__device__ __forceinline__ void gemm_phase(PG8_LAS unsigned char* lds, const int tid, const Gemm g, const Sched& S, const Epi& E) {
    const int wid = __builtin_amdgcn_readfirstlane(tid >> 6), lane = tid & 63, wr = wid >> 2, wc = wid & 3, fr = lane & 15, fq = lane >> 4;
    const int K = g.K;
    unsigned voffA[2], voffB[2];
#pragma unroll
    for (int i = 0; i < 2; ++i) { int R, C; stage_rc(tid * 16 + i * 8192, R, C); const int Rb = Epi::PERM ? ((R & ~31) + perm32(R & 31)) : R;
        voffA[i] = (unsigned)(R * K + C) * 2u; voffB[i] = (unsigned)(Rb * K + C) * 2u; }
    const size_t kstep = (size_t)(BK * 2);
    const size_t hstep = (size_t)HALF * K * 2;
    const size_t tstep = 2 * hstep;
    const unsigned ldsw = (unsigned)wid * 1024u;
    const int aoff = lds_byte(wr * 64 + fr, fq * 8), boff = lds_byte(wc * 32 + fr, fq * 8);
#define PG8_SA(b, h) (((b) * 2 + (h)) * HTB)
#define PG8_SB(b, h) ((4 + (b) * 2 + (h)) * HTB)
#define PG8_STAGE(bufoff, gbase, voff) do { _Pragma("unroll") for (int _i = 0; _i < 2; ++_i) \
        __builtin_amdgcn_global_load_lds((const unsigned*)((const char*)(gbase) + (voff)[_i]), (PG8_LAS unsigned*)(lds + (bufoff) + ldsw + _i * 8192), 16, 0, 0); } while (0)
#define PG8_LDA(dst, b, h) do { _Pragma("unroll") for (int m = 0; m < 4; ++m) _Pragma("unroll") for (int k = 0; k < 2; ++k) dst[m][k] = *(const PG8_LAS bf16x8*)(lds + PG8_SA(b, h) + aoff + m * 2048 + k * 1024); } while (0)
#define PG8_LDB(dst, b, h) do { _Pragma("unroll") for (int n = 0; n < 2; ++n) _Pragma("unroll") for (int k = 0; k < 2; ++k) dst[n][k] = *(const PG8_LAS bf16x8*)(lds + PG8_SB(b, h) + boff + n * 2048 + k * 1024); } while (0)
#define PG8_MMA(ai, bj, At, Bt) do { __builtin_amdgcn_s_setprio(1); _Pragma("unroll") for (int m = 0; m < 4; ++m) _Pragma("unroll") for (int n = 0; n < 2; ++n) _Pragma("unroll") for (int k = 0; k < 2; ++k) \
        acc[ai][bj][m][n] = __builtin_amdgcn_mfma_f32_16x16x32_bf16(Bt[n][k], At[m][k], acc[ai][bj][m][n], 0, 0, 0); __builtin_amdgcn_s_setprio(0); } while (0)
#define PG8_WAIT_V(n) asm volatile("s_waitcnt vmcnt(" #n ")" ::: "memory")
#define PG8_WAIT_L(n) asm volatile("s_waitcnt lgkmcnt(" #n ")" ::: "memory")
#define PG8_BAR __builtin_amdgcn_s_barrier()
#define PG8_SCHED __builtin_amdgcn_sched_barrier(0)
    Unit cur, nxt; int ui = 0;
    if (!S.next(0, cur)) return;
    f32x4 acc[2][2][4][2];
#pragma unroll
    for (int a = 0; a < 2; ++a)
#pragma unroll
        for (int b = 0; b < 2; ++b)
#pragma unroll
            for (int m = 0; m < 4; ++m)
#pragma unroll
                for (int n = 0; n < 2; ++n) acc[a][b][m][n] = (f32x4){0.f, 0.f, 0.f, 0.f};
    bf16x8 At[4][2], B0[2][2], B1[2][2];
#ifdef GEMM_FIXED
#define PG8_PM(u) (((GEMM_FIXED) & 1) ? 0 : (u).pm)
#define PG8_PN(u) (((GEMM_FIXED) & 2) ? 0 : (u).pn)
#else
#define PG8_PM(u) ((u).pm)
#define PG8_PN(u) ((u).pn)
#endif
    const char* cA = (const char*)g.A + (size_t)PG8_PM(cur) * tstep + (size_t)cur.k0 * kstep; const char* cB = (const char*)g.Bt + (size_t)PG8_PN(cur) * tstep + (size_t)cur.k0 * kstep;
    int nt = cur.nk;
    S.a_ready(cur);
    if constexpr (SP2) {
        PG8_STAGE(PG8_SB(0, 0), cB, voffB); PG8_STAGE(PG8_SB(0, 1), cB + hstep, voffB); PG8_STAGE(PG8_SA(0, 0), cA, voffA); PG8_STAGE(PG8_SA(0, 1), cA + hstep, voffA);
        if (wr == 1) PG8_BAR;
        PG8_WAIT_V(2); PG8_BAR;
        PG8_STAGE(PG8_SB(1, 0), cB + kstep, voffB); PG8_STAGE(PG8_SA(1, 0), cA + kstep, voffA); PG8_STAGE(PG8_SB(1, 1), cB + hstep + kstep, voffB);
        PG8_WAIT_V(6); PG8_BAR;
    } else {
        PG8_STAGE(PG8_SB(0, 0), cB, voffB); PG8_STAGE(PG8_SA(0, 0), cA, voffA); PG8_STAGE(PG8_SB(0, 1), cB + hstep, voffB); PG8_STAGE(PG8_SA(0, 1), cA + hstep, voffA);
        if (wr == 1) PG8_BAR;
        PG8_WAIT_V(4); PG8_BAR;
        PG8_STAGE(PG8_SB(1, 0), cB + kstep, voffB); PG8_STAGE(PG8_SA(1, 0), cA + kstep, voffA); PG8_STAGE(PG8_SB(1, 1), cB + hstep + kstep, voffB);
        PG8_WAIT_V(6); PG8_BAR;
    }
    for (;;) {
        const bool has_next = S.next(ui + 1, nxt);
        const char* nA = has_next ? (const char*)g.A + (size_t)PG8_PM(nxt) * tstep + (size_t)nxt.k0 * kstep : cA; const char* nB = has_next ? (const char*)g.Bt + (size_t)PG8_PN(nxt) * tstep + (size_t)nxt.k0 * kstep : cB;
        for (int t = 0; t < nt; t += 2) {
            const bool last = (t == nt - 2);
            const char* a1 = cA + (size_t)(t + 1) * kstep;
            const char* a2 = last ? nA : cA + (size_t)(t + 2) * kstep; const char* b2 = last ? nB : cB + (size_t)(t + 2) * kstep;
            const char* a3 = a2 + kstep; const char* b3 = b2 + kstep;
            if (last && has_next) S.a_ready(nxt);
            if constexpr (SP2) {
            PG8_LDB(B0, 0, 0); PG8_LDB(B1, 0, 1); PG8_SCHED; PG8_LDA(At, 0, 0); PG8_STAGE(PG8_SA(1, 1), a1 + hstep, voffA);
            PG8_WAIT_V(8); PG8_WAIT_L(0); PG8_BAR; PG8_MMA(0, 0, At, B0); PG8_MMA(0, 1, At, B1); PG8_BAR; PG8_SCHED;
            PG8_LDA(At, 0, 1); PG8_STAGE(PG8_SB(0, 0), b2, voffB); PG8_STAGE(PG8_SB(0, 1), b2 + hstep, voffB); PG8_STAGE(PG8_SA(0, 0), a2, voffA);
            PG8_WAIT_V(8); PG8_WAIT_L(0); PG8_BAR; PG8_MMA(1, 0, At, B0); PG8_MMA(1, 1, At, B1); PG8_BAR; PG8_SCHED;
            PG8_LDB(B0, 1, 0); PG8_LDB(B1, 1, 1); PG8_SCHED; PG8_LDA(At, 1, 0); PG8_STAGE(PG8_SA(0, 1), a2 + hstep, voffA);
            PG8_WAIT_V(8); PG8_WAIT_L(0); PG8_BAR; PG8_MMA(0, 0, At, B0); PG8_MMA(0, 1, At, B1); PG8_BAR; PG8_SCHED;
            PG8_LDA(At, 1, 1); PG8_STAGE(PG8_SB(1, 0), b3, voffB); PG8_STAGE(PG8_SB(1, 1), b3 + hstep, voffB); PG8_STAGE(PG8_SA(1, 0), a3, voffA);
            PG8_WAIT_V(8); PG8_WAIT_L(0); PG8_BAR; PG8_MMA(1, 0, At, B0); PG8_MMA(1, 1, At, B1); PG8_BAR; PG8_SCHED;
            } else {
            PG8_LDB(B0, 0, 0); PG8_SCHED; PG8_LDA(At, 0, 0); PG8_STAGE(PG8_SA(1, 1), a1 + hstep, voffA);
            PG8_WAIT_L(8); PG8_BAR; PG8_WAIT_L(0); PG8_MMA(0, 0, At, B0); PG8_BAR; PG8_SCHED;
            PG8_LDB(B1, 0, 1); PG8_STAGE(PG8_SB(0, 0), b2, voffB);
            PG8_BAR; PG8_WAIT_L(0); PG8_MMA(0, 1, At, B1); PG8_BAR;
            PG8_LDA(At, 0, 1); PG8_STAGE(PG8_SA(0, 0), a2, voffA);
            PG8_BAR; PG8_WAIT_L(0); PG8_MMA(1, 0, At, B0); PG8_BAR; PG8_SCHED;
            PG8_STAGE(PG8_SB(0, 1), b2 + hstep, voffB);
            PG8_WAIT_V(6); PG8_BAR; PG8_MMA(1, 1, At, B1); PG8_BAR;
            PG8_LDB(B0, 1, 0); PG8_SCHED; PG8_LDA(At, 1, 0); PG8_STAGE(PG8_SA(0, 1), a2 + hstep, voffA);
            PG8_WAIT_L(8); PG8_BAR; PG8_WAIT_L(0); PG8_MMA(0, 0, At, B0); PG8_BAR; PG8_SCHED;
            PG8_LDB(B1, 1, 1); PG8_STAGE(PG8_SB(1, 0), b3, voffB);
            PG8_BAR; PG8_WAIT_L(0); PG8_MMA(0, 1, At, B1); PG8_BAR;
            PG8_LDA(At, 1, 1); PG8_STAGE(PG8_SA(1, 0), a3, voffA);
            PG8_BAR; PG8_WAIT_L(0); PG8_MMA(1, 0, At, B0); PG8_BAR; PG8_SCHED;
            PG8_STAGE(PG8_SB(1, 1), b3 + hstep, voffB);
            PG8_WAIT_V(6); PG8_BAR; PG8_MMA(1, 1, At, B1); PG8_BAR;
            }
        }
        if constexpr (ALIGN_EPI) { if (wr == 0) PG8_BAR; }
        if constexpr (!Epi::AFTER_DRAIN) { E(acc, cur, wr, wc, fr, fq); S.done(cur);
            if constexpr (Epi::DRAIN_AFTER) __builtin_amdgcn_s_waitcnt(0x0F70); }
        if (!has_next) break;
        if (Epi::reset_after(cur)) {
#pragma unroll
        for (int a = 0; a < 2; ++a)
#pragma unroll
            for (int b = 0; b < 2; ++b)
#pragma unroll
                for (int m = 0; m < 4; ++m)
#pragma unroll
                    for (int n = 0; n < 2; ++n) acc[a][b][m][n] = (f32x4){0.f, 0.f, 0.f, 0.f};
        }
        cur = nxt; cA = nA; cB = nB; nt = cur.nk; ++ui;
        if constexpr (ALIGN_EPI) { if (wr == 1) PG8_BAR; }
    }
    PG8_WAIT_V(0);
    if constexpr (!ALIGN_EPI) { if (wr == 0) PG8_BAR; }
    PG8_BAR;
    if constexpr (Epi::AFTER_DRAIN) { E.fused(acc, cur, wr, wc, fr, fq, lds, wid, lane); S.done(cur); }
#undef PG8_SA
#undef PG8_SB
#undef PG8_STAGE
#undef PG8_LDA
#undef PG8_LDB
#undef PG8_MMA
#undef PG8_WAIT_V
#undef PG8_WAIT_L
#undef PG8_BAR
#undef PG8_SCHED
}
}
namespace att {
using bf16x8 = __attribute__((ext_vector_type(8))) short;
using s16x4  = __attribute__((ext_vector_type(4))) short;
using f32x16 = __attribute__((ext_vector_type(16))) float;
using u32x4  = __attribute__((ext_vector_type(4))) unsigned;
typedef unsigned short bf16_t;
constexpr int NW = 8, QBLK = 32, KVBLK = 64;
constexpr float SCALE = 0.125f, THR = 8.f;
constexpr int LDQK = DM, LDV = IN_DIM;
constexpr int NSLOT = 4;
constexpr int SHM_V = KVBLK * 128 * 2, SHM_K = KVBLK * 64 * 2, SHM_ATTN = NSLOT * SHM_V + NSLOT * SHM_K + NW * 64 * 4;
#define KSWZ(row, colB) ((row) * 128 + ((colB) ^ ((((row) >> 1) & 7) << 4)))
#define SBAR() __builtin_amdgcn_sched_barrier(0)
__device__ __forceinline__ int crow(int r, int hi) { return (r & 3) + 8 * (r >> 2) + 4 * hi; }
__device__ __forceinline__ unsigned cvtpk(float lo, float hi) { unsigned r; asm volatile("v_cvt_pk_bf16_f32 %0, %1, %2" : "=v"(r) : "v"(lo), "v"(hi)); return r; }

__device__ __forceinline__ int v_st(int k, int c) { const int kk = (k & ~0xC) | ((k & 4) << 1) | ((k & 8) >> 1); return ((kk >> 3) * 4 + (c >> 5)) * 512 + ((kk & 7) * 32 + (c & 31)) * 2; }
__device__ __forceinline__ int v_rd_base(int lane) { return ((lane & 3) << 3) | (((lane >> 2) & 3) << 6) | (((lane >> 4) & 1) << 5) | (((lane >> 5) & 1) << 8); }
constexpr int v_rd_off(int d0, int ks, int half) { return d0 * 512 + ks * 4096 + half * 2048; }
template <int OFF> __device__ __forceinline__ s16x4 tr_read(int vb) {
  s16x4 r; asm volatile("ds_read_b64_tr_b16 %0, %1 offset:%2" : "=&v"(r) : "v"(vb), "i"(OFF) : "memory"); return r;
}
template <int D0> __device__ __forceinline__ void pv_one(f32x16& od, int vb, bf16x8 pa0, bf16x8 pa1, bf16x8 pa2, bf16x8 pa3) {
  const s16x4 l0 = tr_read<v_rd_off(D0, 0, 0)>(vb), h0 = tr_read<v_rd_off(D0, 0, 1)>(vb), l1 = tr_read<v_rd_off(D0, 1, 0)>(vb), h1 = tr_read<v_rd_off(D0, 1, 1)>(vb);
  const s16x4 l2 = tr_read<v_rd_off(D0, 2, 0)>(vb), h2 = tr_read<v_rd_off(D0, 2, 1)>(vb), l3 = tr_read<v_rd_off(D0, 3, 0)>(vb), h3 = tr_read<v_rd_off(D0, 3, 1)>(vb);
  asm volatile("s_waitcnt lgkmcnt(0)" ::: "memory"); SBAR();
#define PK(L, H) (bf16x8){L[0], L[1], L[2], L[3], H[0], H[1], H[2], H[3]}
  od = __builtin_amdgcn_mfma_f32_32x32x16_bf16(pa0, PK(l0, h0), od, 0, 0, 0);
  od = __builtin_amdgcn_mfma_f32_32x32x16_bf16(pa1, PK(l1, h1), od, 0, 0, 0);
  od = __builtin_amdgcn_mfma_f32_32x32x16_bf16(pa2, PK(l2, h2), od, 0, 0, 0);
  od = __builtin_amdgcn_mfma_f32_32x32x16_bf16(pa3, PK(l3, h3), od, 0, 0, 0);
#undef PK
}

typedef float f32x2 __attribute__((ext_vector_type(2)));
template <int OFF> __device__ __forceinline__ bf16x8 k_read(int ka) {
  bf16x8 r; asm volatile("ds_read_b128 %0, %1 offset:%2" : "=&v"(r) : "v"(ka), "i"(OFF) : "memory"); return r;
}
struct VFr { s16x4 l0, h0, l1, h1, l2, h2, l3, h3; };
template <int D0, int VS> __device__ __forceinline__ void v_issue(VFr& f, int vb) {
#ifdef ATT_NOVREAD
  f.l0 = f.h0 = f.l1 = f.h1 = f.l2 = f.h2 = f.l3 = f.h3 = (s16x4){1, 1, 1, 1}; return;
#endif
  f.l0 = tr_read<VS * SHM_V + v_rd_off(D0, 0, 0)>(vb); f.h0 = tr_read<VS * SHM_V + v_rd_off(D0, 0, 1)>(vb); f.l1 = tr_read<VS * SHM_V + v_rd_off(D0, 1, 0)>(vb); f.h1 = tr_read<VS * SHM_V + v_rd_off(D0, 1, 1)>(vb);
  f.l2 = tr_read<VS * SHM_V + v_rd_off(D0, 2, 0)>(vb); f.h2 = tr_read<VS * SHM_V + v_rd_off(D0, 2, 1)>(vb); f.l3 = tr_read<VS * SHM_V + v_rd_off(D0, 3, 0)>(vb); f.h3 = tr_read<VS * SHM_V + v_rd_off(D0, 3, 1)>(vb);
}
#define ATT_PK(L, H) (bf16x8){L[0], L[1], L[2], L[3], H[0], H[1], H[2], H[3]}
#define ATT_LGKM(n) asm volatile("s_waitcnt lgkmcnt(" #n ")" ::: "memory")
__device__ __forceinline__ void sm_pair(f32x16& c, const int e, const float) {
#ifdef ATT_NOEXP
  c[e] = c[e] * 0.5f; c[e + 1] = c[e + 1] * 0.5f;
#else
  c[e] = __builtin_amdgcn_exp2f(c[e]); c[e + 1] = __builtin_amdgcn_exp2f(c[e + 1]);
#endif
}
__device__ __forceinline__ void acc_pair(f32x2& lsum, const float a, const float b) {
#ifdef ATT_NOSUM
  return;
#endif
  asm volatile("v_add_f32 %0, %0, %1" : "+v"(lsum.x) : "v"(a)); asm volatile("v_add_f32 %0, %0, %1" : "+v"(lsum.y) : "v"(b));
}
template <int G>
__device__ __forceinline__ void gapv(f32x16& c0, f32x16& c1, bf16x8 (&pn)[4], f32x2& lsum, unsigned (&cv)[4], const float m0c) {
  if constexpr (G < 16) {
    if constexpr (G < 14) { constexpr int e = 4 + 2 * G; if constexpr (e < 16) sm_pair(c0, e, m0c); else sm_pair(c1, e - 16, m0c); }
    constexpr int a = 2 * G;
    if constexpr (a < 16) acc_pair(lsum, c0[a], c0[a + 1]); else acc_pair(lsum, c1[a - 16], c1[a - 15]);
  } else {
    constexpr int k = G - 16, q = k >> 1, B = (q & 1) * 8;
    f32x16& P = (q < 2) ? c0 : c1;
    if constexpr ((k & 1) == 0) { cv[0] = cvtpk(P[B + 0], P[B + 1]); cv[1] = cvtpk(P[B + 2], P[B + 3]); cv[2] = cvtpk(P[B + 4], P[B + 5]); cv[3] = cvtpk(P[B + 6], P[B + 7]); }
    else {
      auto r0 = __builtin_amdgcn_permlane32_swap(cv[0], cv[2], false, false); auto r1 = __builtin_amdgcn_permlane32_swap(cv[1], cv[3], false, false);
      u32x4 w = {r0[0], r1[0], r0[1], r1[1]}; pn[q] = *reinterpret_cast<bf16x8*>(&w);
    }
  }
}
#define ATT_GAP(G) do { SBAR(); gapv<G>(c0, c1, pn, lsum, cv, m0c); SBAR(); } while (0)
#define ATT_PVBLK(OD, F, G0) do { \
    OD = __builtin_amdgcn_mfma_f32_32x32x16_bf16(pp[0], ATT_PK(F.l0, F.h0), OD, 0, 0, 0); ATT_GAP(G0); \
    OD = __builtin_amdgcn_mfma_f32_32x32x16_bf16(pp[1], ATT_PK(F.l1, F.h1), OD, 0, 0, 0); ATT_GAP(G0 + 1); \
    OD = __builtin_amdgcn_mfma_f32_32x32x16_bf16(pp[2], ATT_PK(F.l2, F.h2), OD, 0, 0, 0); ATT_GAP(G0 + 2); \
    OD = __builtin_amdgcn_mfma_f32_32x32x16_bf16(pp[3], ATT_PK(F.l3, F.h3), OD, 0, 0, 0); ATT_GAP(G0 + 3); } while (0)
template <bool HAS_QK, bool HAS_PV, int KS, int VS, class Mid>
__device__ __forceinline__ void att_seg(const Mid& mid, f32x16& c0, f32x16& c1, f32x16& n0, f32x16& n1, const bf16x8 (&pp)[4], bf16x8 (&pn)[4], f32x16 (&o)[4], f32x2& lsum,
                                        const int (&ka)[4], const int vb, const bf16x8 (&qf)[4], const float m0c) {
  unsigned cv[4]; VFr va, vq; bf16x8 kf[8];
  if constexpr (HAS_PV) { v_issue<0, VS>(va, vb); v_issue<1, VS>(vq, vb); }
  SBAR(); sm_pair(c0, 0, m0c); sm_pair(c0, 2, m0c); SBAR();
#define ATT_KQ_ISSUE() do { _Pragma("unroll") for (int d0 = 0; d0 < 4; ++d0) { kf[2 * d0] = k_read<KS * SHM_K>(ka[d0]); kf[2 * d0 + 1] = k_read<KS * SHM_K + 4096>(ka[d0]); } } while (0)
  if constexpr (HAS_PV) {
    ATT_LGKM(8); SBAR();
    ATT_PVBLK(o[0], va, 0);
#ifndef ATT_NOMID
    mid();
#endif
    SBAR();
    v_issue<2, VS>(va, vb); ATT_LGKM(8); SBAR();
    ATT_PVBLK(o[1], vq, 4);
    v_issue<3, VS>(vq, vb); ATT_LGKM(8); SBAR();
    ATT_PVBLK(o[2], va, 8);
    if constexpr (HAS_QK) { ATT_KQ_ISSUE(); ATT_LGKM(8); } else { ATT_LGKM(0); }
    SBAR();
    ATT_PVBLK(o[3], vq, 12);
  } else {
    mid(); SBAR();
    if constexpr (HAS_QK) ATT_KQ_ISSUE();
    ATT_GAP(0); ATT_GAP(1); ATT_GAP(2); ATT_GAP(3); ATT_GAP(4); ATT_GAP(5); ATT_GAP(6); ATT_GAP(7);
    ATT_GAP(8); ATT_GAP(9); ATT_GAP(10); ATT_GAP(11); ATT_GAP(12); ATT_GAP(13); ATT_GAP(14); ATT_GAP(15);
  }
  if constexpr (HAS_QK) {
    n0 = f32x16{}; n1 = f32x16{};
    ATT_LGKM(0); SBAR();
    n0 = __builtin_amdgcn_mfma_f32_32x32x16_bf16(kf[0], qf[0], n0, 0, 0, 0); ATT_GAP(16);
    n1 = __builtin_amdgcn_mfma_f32_32x32x16_bf16(kf[1], qf[0], n1, 0, 0, 0); ATT_GAP(17);
    n0 = __builtin_amdgcn_mfma_f32_32x32x16_bf16(kf[2], qf[1], n0, 0, 0, 0); ATT_GAP(18);
    n1 = __builtin_amdgcn_mfma_f32_32x32x16_bf16(kf[3], qf[1], n1, 0, 0, 0); ATT_GAP(19);
    n0 = __builtin_amdgcn_mfma_f32_32x32x16_bf16(kf[4], qf[2], n0, 0, 0, 0); ATT_GAP(20);
    n1 = __builtin_amdgcn_mfma_f32_32x32x16_bf16(kf[5], qf[2], n1, 0, 0, 0); ATT_GAP(21);
    n0 = __builtin_amdgcn_mfma_f32_32x32x16_bf16(kf[6], qf[3], n0, 0, 0, 0); ATT_GAP(22);
    n1 = __builtin_amdgcn_mfma_f32_32x32x16_bf16(kf[7], qf[3], n1, 0, 0, 0); ATT_GAP(23);
  } else { ATT_GAP(16); ATT_GAP(17); ATT_GAP(18); ATT_GAP(19); ATT_GAP(20); ATT_GAP(21); ATT_GAP(22); ATT_GAP(23); }
#undef ATT_KQ_ISSUE
}

__device__ __forceinline__ void attn_unit(const int MODE, const bf16_t* __restrict__ Qb, const bf16_t* __restrict__ Kh, const bf16_t* __restrict__ Vh, float* __restrict__ OS, bf16_t* __restrict__ AOb,
                                          const float* __restrict__ subg, float lam, float osc, const float m0c, int rowa, int nt0, int rowb, int NT, char* lds, int tid) {
  asm volatile("" : "+v"(tid));
  const int wid = tid >> 6, lane = tid & 63, r32 = lane & 31, hi = lane >> 5;
  char* V_lds = lds; char* K_lds = lds + NSLOT * SHM_V;
  float* ws = (float*)(lds + NSLOT * SHM_V + NSLOT * SHM_K) + wid * 64; float* li_l = ws;
  f32x16 o[4] = {}; bf16x8 qr[4];
  const bf16_t* Qw = Qb + (long)(wid * QBLK + r32) * LDQK + hi * 8;
#pragma unroll
  for (int d0 = 0; d0 < 4; ++d0) qr[d0] = *reinterpret_cast<const bf16x8*>(Qw + d0 * 16);
  unsigned koffd, voffd0, voffd1;
  { const int b = wid * 1024 + lane * 16, row = b >> 7, colB = (b & 127) ^ (((row >> 1) & 7) << 4); koffd = (unsigned)(row * LDQK * 2 + colB); }
  { const int b = wid * 1024 + lane * 16, sub = b >> 9, e = (b & 511) >> 1, kk = (sub >> 2) * 8 + (e >> 5), k = (kk & ~0xC) | ((kk & 4) << 1) | ((kk & 8) >> 1), col = (sub & 3) * 32 + (e & 31);
    voffd0 = (unsigned)(k * LDV * 2 + col * 2); }
  { const int b = 8192 + wid * 1024 + lane * 16, sub = b >> 9, e = (b & 511) >> 1, kk = (sub >> 2) * 8 + (e >> 5), k = (kk & ~0xC) | ((kk & 4) << 1) | ((kk & 8) >> 1), col = (sub & 3) * 32 + (e & 31);
    voffd1 = (unsigned)(k * LDV * 2 + col * 2); }
  const unsigned wid_s = (unsigned)__builtin_amdgcn_readfirstlane(wid);
  const unsigned ldsK = (unsigned)(uintptr_t)(lds + NSLOT * SHM_V) + wid_s * 1024u, ldsV = (unsigned)(uintptr_t)lds + wid_s * 1024u;
  const int vb = (int)(uintptr_t)V_lds + v_rd_base(lane);
  int ka[4];
#pragma unroll
  for (int d0 = 0; d0 < 4; ++d0) ka[d0] = (int)(uintptr_t)K_lds + KSWZ(r32, (d0 * 16 + hi * 8) * 2);
#define KROW(j) ((j) < nt0 ? rowa + (j) * KVBLK : rowb + ((j) - nt0) * KVBLK)
#define GLDS(src, dst) do { unsigned keep_; asm volatile("s_mov_b32 %0, m0\n\ts_mov_b32 m0, %2\n\ts_nop 0\n\tglobal_load_lds_dwordx4 %1, off\n\ts_mov_b32 m0, %0" : "=&s"(keep_) : "v"(src), "s"(dst) : "memory"); } while (0)
#define KDMA(j, slot) do { const int jc_ = (j) < NT ? (j) : NT - 1; GLDS((const char*)Kh + (size_t)KROW(jc_) * (LDQK * 2) + koffd, ldsK + (unsigned)(slot) * SHM_K); } while (0)
#define VDMA(j, slot) do { const int jc_ = (j) < NT ? (j) : NT - 1; const char* vb_ = (const char*)Vh + (size_t)KROW(jc_) * (LDV * 2); \
    GLDS(vb_ + voffd0, ldsV + (unsigned)(slot) * SHM_V); GLDS(vb_ + voffd1, ldsV + (unsigned)(slot) * SHM_V + 8192u); } while (0)
#define SEGEND() do { asm volatile("s_waitcnt vmcnt(0) lgkmcnt(0)" ::: "memory"); __builtin_amdgcn_s_barrier(); asm volatile("" ::: "memory"); } while (0)
  f32x16 sA0, sA1, sB0, sB1; bf16x8 paA[4], paB[4]; f32x2 lsum = {0.f, 0.f};
  const auto nomid = [&]() {};
  KDMA(0, 0); KDMA(1, 1); KDMA(2, 2); VDMA(0, 0);
  SEGEND();
  { bf16x8 kf[8];
#pragma unroll
    for (int d0 = 0; d0 < 4; ++d0) { kf[2 * d0] = k_read<0>(ka[d0]); kf[2 * d0 + 1] = k_read<4096>(ka[d0]); }
    sA0 = f32x16{}; sA1 = f32x16{}; ATT_LGKM(0); SBAR();
#pragma unroll
    for (int d0 = 0; d0 < 4; ++d0) { sA0 = __builtin_amdgcn_mfma_f32_32x32x16_bf16(kf[2 * d0], qr[d0], sA0, 0, 0, 0); sA1 = __builtin_amdgcn_mfma_f32_32x32x16_bf16(kf[2 * d0 + 1], qr[d0], sA1, 0, 0, 0); } }
  SEGEND();
  att_seg<true, false, 1, 0>([&]() { KDMA(3, 3); KDMA(4, 0); VDMA(1, 1); VDMA(2, 2); }, sA0, sA1, sB0, sB1, paB  , paA, o, lsum, ka, vb, qr, m0c);
  att_seg<true, true, 2, 0>(nomid, sB0, sB1, sA0, sA1, paA, paB, o, lsum, ka, vb, qr, m0c);
  SEGEND();
  for (int j = 2; j + 2 < NT; j += 4) {
    att_seg<true, true, 3, 1>([&]() { KDMA(j + 3, 1); KDMA(j + 4, 2); VDMA(j + 1, 3); VDMA(j + 2, 0); }, sA0, sA1, sB0, sB1, paB, paA, o, lsum, ka, vb, qr, m0c);
    att_seg<true, true, 0, 2>(nomid, sB0, sB1, sA0, sA1, paA, paB, o, lsum, ka, vb, qr, m0c);
    SEGEND();
    att_seg<true, true, 1, 3>([&]() { KDMA(j + 5, 3); KDMA(j + 6, 0); VDMA(j + 3, 1); VDMA(j + 4, 2); }, sA0, sA1, sB0, sB1, paB, paA, o, lsum, ka, vb, qr, m0c);
    att_seg<true, true, 2, 0>(nomid, sB0, sB1, sA0, sA1, paA, paB, o, lsum, ka, vb, qr, m0c);
    SEGEND();
  }
  att_seg<true, true, 3, 1>([&]() { VDMA(NT - 1, 3); }, sA0, sA1, sB0, sB1, paB, paA, o, lsum, ka, vb, qr, m0c);
  att_seg<false, true, 0, 2>(nomid, sB0, sB1, sA0, sA1, paA, paB, o, lsum, ka, vb, qr, m0c);
  SEGEND();
  { VFr va, vq;
    v_issue<0, 3>(va, vb); v_issue<1, 3>(vq, vb); ATT_LGKM(8); SBAR();
#define ATT_PV4(OD, F, PP) do { OD = __builtin_amdgcn_mfma_f32_32x32x16_bf16(PP[0], ATT_PK(F.l0, F.h0), OD, 0, 0, 0); OD = __builtin_amdgcn_mfma_f32_32x32x16_bf16(PP[1], ATT_PK(F.l1, F.h1), OD, 0, 0, 0); \
    OD = __builtin_amdgcn_mfma_f32_32x32x16_bf16(PP[2], ATT_PK(F.l2, F.h2), OD, 0, 0, 0); OD = __builtin_amdgcn_mfma_f32_32x32x16_bf16(PP[3], ATT_PK(F.l3, F.h3), OD, 0, 0, 0); } while (0)
    ATT_PV4(o[0], va, paB); SBAR();
    v_issue<2, 3>(va, vb); ATT_LGKM(8); SBAR();
    ATT_PV4(o[1], vq, paB); SBAR();
    v_issue<3, 3>(vq, vb); ATT_LGKM(8); SBAR();
    ATT_PV4(o[2], va, paB); SBAR();
    ATT_LGKM(0); SBAR();
    ATT_PV4(o[3], vq, paB); }
  float l_reg = lsum.x + lsum.y;
  { auto rr = __builtin_amdgcn_permlane32_swap(__float_as_uint(l_reg), __float_as_uint(l_reg), false, false); l_reg = __uint_as_float(rr[0]) + __uint_as_float(rr[1]); }
  if (hi == 0) li_l[r32] = l_reg; asm volatile("s_waitcnt lgkmcnt(0)" ::: "memory");
  float rli[16];
#pragma unroll
  for (int r = 0; r < 16; ++r) rli[r] = __builtin_amdgcn_rcpf(li_l[crow(r, hi)]);
  int zo = 0; asm volatile("" : "+v"(zo));
  float* Ow = OS + (wid * QBLK) * 128 + zo;
  if (MODE == 0) {
#pragma unroll
    for (int r = 0; r < 16; ++r) { const int orow = crow(r, hi);
#pragma unroll
      for (int d0 = 0; d0 < 4; ++d0) Ow[orow * 128 + d0 * 32 + r32] = o[d0][r] * rli[r]; }
  } else {
    float sg[4];
#pragma unroll
    for (int d0 = 0; d0 < 4; ++d0) sg[d0] = subg[d0 * 32 + r32] * osc;
    bf16_t* Aw = AOb + (long)(wid * QBLK) * 2048 + zo;
#pragma unroll
    for (int r = 0; r < 16; ++r) { const int orow = crow(r, hi); float d[4]; float ss = 0.f;
#pragma unroll
      for (int d0 = 0; d0 < 4; ++d0) { d[d0] = __hip_atomic_load(&Ow[orow * 128 + d0 * 32 + r32], __ATOMIC_RELAXED, __HIP_MEMORY_SCOPE_AGENT) - lam * (o[d0][r] * rli[r]); ss += d[d0] * d[d0]; }
      { const int l4 = lane << 2;
#pragma unroll
        for (int k = 1; k < 32; k <<= 1) ss += __uint_as_float((unsigned)__builtin_amdgcn_ds_bpermute(l4 ^ (k << 2), (int)__float_as_uint(ss))); }
      const float rs = __builtin_amdgcn_rsqf(ss * (1.f / 128.f) + EPS);
#pragma unroll
      for (int d0 = 0; d0 < 4; ++d0) Aw[(long)orow * 2048 + d0 * 32 + r32] = (bf16_t)(cvtpk(d[d0] * rs * sg[d0], 0.f) & 0xffffu); }
  }
  asm volatile("s_waitcnt vmcnt(0)" ::: "memory");
  __syncthreads();
#undef KROW
#undef GLDS
#undef KDMA
#undef VDMA
#undef SEGEND
}
}

#define GAS __attribute__((address_space(1)))
#define LAS __attribute__((address_space(3)))
typedef unsigned short bf16;
typedef unsigned v4u __attribute__((ext_vector_type(4)));
typedef float f32x4 __attribute__((ext_vector_type(4)));
typedef short bf16x8 __attribute__((ext_vector_type(8)));
typedef GAS unsigned gu32;
typedef GAS unsigned long long gu64;
#define RLX_AGENT __ATOMIC_RELAXED, __HIP_MEMORY_SCOPE_AGENT
#define LDS_WAIT() asm volatile("s_waitcnt lgkmcnt(0)" ::: "memory")
#define VM_WAIT() asm volatile("s_waitcnt vmcnt(0)" ::: "memory")
__device__ __forceinline__ unsigned long long rt() { return __builtin_amdgcn_s_memrealtime(); }
__device__ __forceinline__ unsigned f2bf(float f) { unsigned u = __builtin_bit_cast(unsigned, f); return (u + 0x7fffu + ((u >> 16) & 1u)) >> 16; }
__device__ __forceinline__ unsigned pk2(float lo, float hi) { return f2bf(lo) | (f2bf(hi) << 16); }

#define XB_TMO      128
#define XB_XCNT(j)  (256  + 64 * (j))
#define XB_XSUB(j)  (1280 + 64 * (j))
#define XB_XGEN(j)  (2304 + 64 * (j))
#define XB_TOP      3328
#define XB_TOPGEN   3392
#define XCD_BAR_WORDS 3456
#define XB_SPIN_CAP (1u << 18)

__device__ __forceinline__ unsigned xb_ld(unsigned* p)              { return __hip_atomic_load(p, __ATOMIC_RELAXED, __HIP_MEMORY_SCOPE_AGENT); }
__device__ __forceinline__ unsigned xb_add(unsigned* p, unsigned v) { return __hip_atomic_fetch_add(p, v, __ATOMIC_RELAXED, __HIP_MEMORY_SCOPE_AGENT); }
__device__ __forceinline__ unsigned xb_xcc_id() { return (unsigned)__builtin_amdgcn_s_getreg((3 << 11) | 20) & 0xFu; }
#define XB_SPIN(cond, bar) do { unsigned _sp = 0; while (cond) { __builtin_amdgcn_s_sleep(1); \
    if ((++_sp & 255u) == 0u) { if (xb_ld(&(bar)[XB_TMO])) break; if (_sp > XB_SPIN_CAP) { atomicAdd(&(bar)[XB_TMO], 1u); break; } } } } while (0)

struct XcdBarrier {
    unsigned* bar; unsigned x;
    volatile LAS unsigned* st;
};

__device__ __forceinline__ XcdBarrier xcd_barrier_post(unsigned* bar, volatile LAS unsigned* st) {
    XcdBarrier b; b.bar = bar; b.x = xb_xcc_id(); b.st = st;
    if (threadIdx.x == 0) (void)xb_add(&bar[XB_XCNT(b.x)], 1u);
    return b;
}
__device__ __forceinline__ void xcd_barrier_complete(unsigned* bar, unsigned x, unsigned& nloc, unsigned& nx) {
    const unsigned G = gridDim.x * gridDim.y * gridDim.z;
    unsigned sum, cnt, mine, sp = 0u;
    for (;;) {
        sum = 0u; cnt = 0u; mine = 0u;
#pragma unroll
        for (unsigned j = 0; j < 16; ++j) { const unsigned c = xb_ld(&bar[XB_XCNT(j)]); sum += c; cnt += (c > 0u) ? 1u : 0u; mine = (j == x) ? c : mine; }
        if (sum == G) break;
        __builtin_amdgcn_s_sleep(1);
        if ((++sp & 255u) == 0u) { if (xb_ld(&bar[XB_TMO])) break; if (sp > XB_SPIN_CAP) { atomicAdd(&bar[XB_TMO], 1u); break; } }
    }
    nloc = mine > 0u ? mine : 1u; nx = cnt > 0u ? cnt : 1u;
}

__device__ __forceinline__ void xcd_barrier_leader(const XcdBarrier& b) {
        unsigned* bar = b.bar;
        __builtin_amdgcn_s_waitcnt(0);
        unsigned nloc = b.st[0], nx = b.st[1];
        if (nloc == 0u) { xcd_barrier_complete(bar, b.x, nloc, nx); b.st[0] = nloc; b.st[1] = nx; }
        const unsigned old = xb_add(&bar[XB_XSUB(b.x)], 1u);
        const unsigned gen = old / nloc;
        if (old + 1u == (gen + 1u) * nloc) {
            __builtin_amdgcn_fence(__ATOMIC_RELEASE, "agent");
            asm volatile("s_waitcnt vmcnt(0)" ::: "memory");
            const unsigned og = xb_add(&bar[XB_TOP], 1u);
            const unsigned tg = og / nx;
            if (og + 1u == (tg + 1u) * nx) xb_add(&bar[XB_TOPGEN], 1u);
            else XB_SPIN(xb_ld(&bar[XB_TOPGEN]) == tg, bar);
            __builtin_amdgcn_fence(__ATOMIC_ACQUIRE, "agent");
            xb_add(&bar[XB_XGEN(b.x)], 1u);
            asm volatile("s_waitcnt vmcnt(0)" ::: "memory");
        } else {
            XB_SPIN(xb_ld(&bar[XB_XGEN(b.x)]) == gen, bar);
            __builtin_amdgcn_fence(__ATOMIC_ACQUIRE, "agent");
            asm volatile("s_waitcnt vmcnt(0)" ::: "memory");
        }
}

__device__ __forceinline__ void xcd_barrier(const XcdBarrier& b) {
    asm volatile("s_waitcnt vmcnt(0)" ::: "memory");
    __syncthreads();
    if (threadIdx.x == 0) xcd_barrier_leader(b);
    __syncthreads();
}
constexpr size_t MiB = 1u << 20;
constexpr size_t WS_CTL = 0, CTL_ZERO_BYTES = 1 * MiB;
constexpr size_t WS_MOD = 1 * MiB;
constexpr size_t WS_ROPE = 2 * MiB;
constexpr size_t WS_WSP = 4 * MiB;
constexpr size_t WS_HC = 5 * MiB;
constexpr size_t WS_RST = 13 * MiB;
constexpr size_t WS_W = 16 * MiB;
constexpr size_t W_IN = 0, W_BR = W_IN + (size_t)IN_DIM * DM * 2, W_O = W_BR + (size_t)3 * DM * 2048 * 2, W_GU = W_O + (size_t)DM * DM * 2, W_D = W_GU + (size_t)2 * FF * DM * 2,
                 W_LAYER = W_D + (size_t)DM * FF * 2;
constexpr size_t WS_Z = WS_W + 2 * W_LAYER;
constexpr size_t WS_ACT = WS_Z + (size_t)MT * IN_DIM * 2;
constexpr size_t WS_XB = WS_ACT + (size_t)MT * DM * 2;
constexpr size_t WS_O12 = WS_XB + (size_t)3 * MT * 2048 * 2;
constexpr size_t WS_QK = WS_O12 + (size_t)MT * DM * 4;
constexpr size_t WS_OS = WS_QK + (size_t)MT * DM * 2;
constexpr int MAX_GRID = 320;
constexpr size_t WS_KVF = WS_OS + (size_t)MAX_GRID * 256 * 128 * 4;
constexpr size_t WS_SLAB = WS_KVF + (size_t)8 * MC * 4096 * 4;
constexpr size_t WS_END = WS_SLAB + (size_t)8 * MC * DM * 4;
static_assert(W_LAYER % 256 == 0 && WS_Z % 256 == 0 && WS_ACT % 256 == 0 && WS_XB % 256 == 0 && WS_O12 % 256 == 0 && WS_QK % 256 == 0 && WS_OS % 256 == 0, "alignment");
constexpr int CW_BAR = 4096;

constexpr int NWAVES = 8;
constexpr int RING_BYTES = 131072, MISC_OFF = RING_BYTES + 320, LDS_BYTES = 147456;
static_assert(true, "");
constexpr int PPL = 9, N_PHASES = 1 + PPL * DEPTH;

__device__ __forceinline__ float sx(float v, int k, int lane) { return __uint_as_float((unsigned)__builtin_amdgcn_ds_bpermute((lane ^ k) << 2, (int)__float_as_uint(v))); }
__device__ __forceinline__ float wave_sum(float v, int lane) {
#pragma unroll
    for (int o = 1; o < 64; o <<= 1) v += sx(v, o, lane);
    return v;
}
__device__ __forceinline__ unsigned pkbf(float lo, float hi) { unsigned r; asm volatile("v_cvt_pk_bf16_f32 %0, %1, %2" : "=v"(r) : "v"(lo), "v"(hi)); return r; }
__device__ __forceinline__ float blo(unsigned w) { return __uint_as_float(w << 16); }
__device__ __forceinline__ float bhi(unsigned w) { return __uint_as_float(w & 0xffff0000u); }
__device__ __forceinline__ void unpack8(const v4u w, float (&x)[8]) { x[0] = blo(w.x); x[1] = bhi(w.x); x[2] = blo(w.y); x[3] = bhi(w.y); x[4] = blo(w.z); x[5] = bhi(w.z); x[6] = blo(w.w); x[7] = bhi(w.w); }
__device__ __forceinline__ v4u pack8(const float (&x)[8]) { v4u w; w.x = pkbf(x[0], x[1]); w.y = pkbf(x[2], x[3]); w.z = pkbf(x[4], x[5]); w.w = pkbf(x[6], x[7]); return w; }

struct Args { const float* in[25]; float* out; unsigned char* ws; int ph_lo, ph_hi, bar_region, pad; };
struct Ctx {
    LAS unsigned char* lds; int tid, lane, wave, vcu, G;
    float* out; unsigned char* ws; int bx;
};
__device__ __forceinline__ Ctx launder(const Ctx& F) {
    Ctx P = F; int t = F.tid; asm volatile("" : "+v"(t)); P.tid = t; P.lane = t & 63; P.wave = __builtin_amdgcn_readfirstlane(t >> 6);
    asm volatile("" : "+s"(P.vcu), "+s"(P.G), "+s"(P.bx)); unsigned long long z = 0; asm volatile("" : "+s"(z)); P.ws = F.ws + z; P.out = F.out + z;
    return P;
}


__device__ __forceinline__ void transpose_item(const float* W, int K, int N, bf16* WT, int k0, int n0, int drow0, LAS float* scr, int lane) {
    float tv[32];
#pragma unroll
    for (int i = 0; i < 32; ++i) { const int kk = 2 * i + (lane >> 5); tv[i] = W[(size_t)(k0 + kk) * N + n0 + (lane & 31)]; }
#pragma unroll
    for (int i = 0; i < 32; ++i) { const int kk = 2 * i + (lane >> 5); scr[kk * 33 + (lane & 31)] = tv[i]; }
    LDS_WAIT(); asm volatile("" ::: "memory");
    const int c = lane & 7;
#pragma unroll
    for (int j = 0; j < 4; ++j) { const int n = (lane >> 3) + 8 * j; const LAS float* s = scr + (8 * c) * 33 + n;
        v4u o; o.x = pkbf(s[0 * 33], s[1 * 33]); o.y = pkbf(s[2 * 33], s[3 * 33]); o.z = pkbf(s[4 * 33], s[5 * 33]); o.w = pkbf(s[6 * 33], s[7 * 33]);
        *(GAS v4u*)(WT + (size_t)(drow0 + n) * K + k0 + 8 * c) = o; }
    LDS_WAIT(); asm volatile("" ::: "memory");
}
template <int MODE> __device__ __forceinline__ void transpose_mat(const float* W, int K, int N, bf16* WT, LAS float* scr, int item, int lane) {
    const int nblk = N / 32, kb = item / nblk, nb = item % nblk, n0 = 32 * nb;
    const int drow0 = MODE == 0 ? n0 : ((n0 >> 7) * 256 + (n0 & 127) + (MODE == 2 ? 128 : 0));
    transpose_item(W, K, N, WT, 64 * kb, n0, drow0, scr, lane);
}

__device__ __forceinline__ void sincos_f(float a, float& s, float& c) {
    const double ad = (double)a; const double kq = __builtin_rint(ad * 0.63661977236758134308); const double r = ad - kq * 1.57079632679489661923; const double r2 = r * r;
    const double sp = r * (1.0 + r2 * (-1.0 / 6 + r2 * (1.0 / 120 + r2 * (-1.0 / 5040 + r2 * (1.0 / 362880 + r2 * (-1.0 / 39916800))))));
    const double cp = 1.0 + r2 * (-0.5 + r2 * (1.0 / 24 + r2 * (-1.0 / 720 + r2 * (1.0 / 40320 + r2 * (-1.0 / 3628800 + r2 * (1.0 / 479001600))))));
    const int q = ((int)kq) & 3;
    const double ss = (q == 0) ? sp : (q == 1) ? cp : (q == 2) ? -sp : -cp;
    const double cc = (q == 0) ? cp : (q == 1) ? -sp : (q == 2) ? -cp : sp;
    s = (float)ss; c = (float)cc;
}

constexpr int I_IN = (DM / 64) * (IN_DIM / 32), I_BR = (2048 / 64) * (DM / 32), I_O = (DM / 64) * (DM / 32), I_GU = (DM / 64) * (FF / 32), I_D = (FF / 64) * (DM / 32);
constexpr int I_LAYER = I_IN + 3 * I_BR + I_O + 2 * I_GU + I_D;
constexpr int I_P0 = I_LAYER - (2 * I_GU + I_D);
__device__ __forceinline__ void weight_item(const Args& A, unsigned char* ws, int it, LAS float* scr, int lane) {
    const int l = it / I_LAYER; int r = it - l * I_LAYER; unsigned char* wl = ws + WS_W + (size_t)l * W_LAYER;
    const float* W; int K, N, mode = 0; bf16* WT;
    if (r < I_IN) { W = A.in[8] + (size_t)l * DM * IN_DIM; K = DM; N = IN_DIM; WT = (bf16*)(wl + W_IN); }
    else if ((r -= I_IN) < I_BR) { W = A.in[11] + (size_t)l * 2048 * DM; K = 2048; N = DM; WT = (bf16*)(wl + W_BR); }
    else if ((r -= I_BR) < I_BR) { W = A.in[16] + (size_t)l * 2048 * DM; K = 2048; N = DM; WT = (bf16*)(wl + W_BR) + (size_t)DM * 2048; }
    else if ((r -= I_BR) < I_BR) { W = A.in[20] + (size_t)l * 2048 * DM; K = 2048; N = DM; WT = (bf16*)(wl + W_BR) + (size_t)2 * DM * 2048; }
    else if ((r -= I_BR) < I_O) { W = A.in[21] + (size_t)l * DM * DM; K = DM; N = DM; WT = (bf16*)(wl + W_O); }
    else if ((r -= I_O) < I_GU) { W = A.in[22] + (size_t)l * DM * FF; K = DM; N = FF; WT = (bf16*)(wl + W_GU); mode = 1; }
    else if ((r -= I_GU) < I_GU) { W = A.in[23] + (size_t)l * DM * FF; K = DM; N = FF; WT = (bf16*)(wl + W_GU); mode = 2; }
    else { r -= I_GU; W = A.in[24] + (size_t)l * FF * DM; K = FF; N = DM; WT = (bf16*)(wl + W_D); }
    const int nblk = N / 32, kb = r / nblk, nb = r - kb * nblk, n0 = 32 * nb;
    const int drow0 = mode == 0 ? n0 : ((n0 >> 7) * 256 + (n0 & 127) + (mode == 2 ? 128 : 0));
    transpose_item(W, K, N, WT, 64 * kb, n0, drow0, scr, lane);
}
__device__ __forceinline__ bool weight_fill_one(const Args& A, const Ctx& F) {
    unsigned j = 0u; if (F.lane == 0) j = __hip_atomic_fetch_add((LAS unsigned*)(F.lds + 147428), 1u, __ATOMIC_RELAXED, __HIP_MEMORY_SCOPE_WORKGROUP);
    j = (unsigned)__builtin_amdgcn_readfirstlane((int)j);
    const long it = (long)I_P0 + (long)F.bx + (long)j * F.G;
    if (it >= (long)(2 * I_LAYER)) return false;
    weight_item(A, F.ws, (int)it, (LAS float*)(F.lds + F.wave * 16384), F.lane);
    return true;
}
__device__ __forceinline__ long weight_fill_peek(const Ctx& F) { return (long)I_P0 + (long)F.bx + (long)*(volatile LAS unsigned*)(F.lds + 147428) * F.G; }
__device__ __forceinline__ void xcd_barrier_fill(const XcdBarrier& b, const Args& A, const Ctx& F, bool fill) {
    volatile LAS unsigned* flag = (volatile LAS unsigned*)(F.lds + 147424);
    asm volatile("s_waitcnt vmcnt(0)" ::: "memory");
    if (threadIdx.x == 0) *flag = 0u;
    asm volatile("s_waitcnt lgkmcnt(0)" ::: "memory");
    __syncthreads();
    if (threadIdx.x == 0) { xcd_barrier_leader(b); *flag = 1u; }
    else if (fill && threadIdx.x >= 64) {
        bool more = true;
        while (__builtin_amdgcn_readfirstlane((int)*flag) == 0) { if (more) more = weight_fill_one(A, F); else __builtin_amdgcn_s_sleep(4); }
        asm volatile("s_waitcnt vmcnt(0)" ::: "memory");
    }
    __syncthreads();
}

__device__ __forceinline__ void p0_prologue(const Args& A, const Ctx& F) {
    const float* c = A.in[1]; const float* c_ctx = A.in[3]; const float* ada_w = A.in[4]; const float* ada_b = A.in[5];
    const float* norm_mix_g = A.in[6]; const float* norm_ffn_g = A.in[7];
    float* MOD = (float*)(F.ws + WS_MOD);
    LAS float* sv = (LAS float*)F.lds; LAS float* red = (LAS float*)(F.lds + 49152);
    for (int i = F.tid; i < 3 * DM; i += NWAVES * 64) { const int v = i >> 12, k = i & (DM - 1); const float x = v < 2 ? c[v * DM + k] : c_ctx[k]; sv[i] = x / (1.f + __expf(-x)); }
    __syncthreads();
    for (int ch = F.vcu; ch < 256; ch += F.G) {
        const int gcol = ch * 192, l = gcol / NMOD, j0 = gcol % NMOD;
        f32x4 a0 = {0.f, 0.f, 0.f, 0.f}, a1 = a0, a2 = a0;
        if (F.lane < 48) {
            const float* wp = ada_w + (size_t)l * DM * NMOD + (size_t)(F.wave * 512) * NMOD + j0 + F.lane * 4;
            const LAS float* s0 = sv + F.wave * 512;
#pragma unroll 8
            for (int k = 0; k < 512; ++k) { const f32x4 w = *(const f32x4*)(wp + (size_t)k * NMOD); a0 += w * s0[k]; a1 += w * s0[DM + k]; a2 += w * s0[2 * DM + k]; }
            *(LAS f32x4*)(red + (F.wave * 3 + 0) * 192 + F.lane * 4) = a0; *(LAS f32x4*)(red + (F.wave * 3 + 1) * 192 + F.lane * 4) = a1; *(LAS f32x4*)(red + (F.wave * 3 + 2) * 192 + F.lane * 4) = a2;
        }
        __syncthreads();
        for (int o = F.tid; o < 3 * 192; o += NWAVES * 64) { const int v = o / 192, jj = o % 192; float s = 0.f;
#pragma unroll
            for (int w = 0; w < 8; ++w) s += red[(w * 3 + v) * 192 + jj];
            const int j = j0 + jj, q = j >> 12, col = j & (DM - 1); float val = s + ada_b[l * NMOD + j];
            if (q == 1) val = norm_mix_g[l * DM + col] * (1.f + val); else if (q == 4) val = norm_ffn_g[l * DM + col] * (1.f + val);
            MOD[(size_t)(l * 3 + v) * NMOD + j] = val; }
        __syncthreads();
    }
    const int gtid = F.vcu * (NWAVES * 64) + F.tid, NTH = F.G * NWAVES * 64;
    { float* ROPE = (float*)(F.ws + WS_ROPE);
      for (int e = gtid; e < SEQ * 32; e += NTH) { const int t = e >> 5, j = e & 31; const int pos = j < 16 ? (t >> 6) : (t & 63);
          const float inv = exp2f(-(float)(j & 15) * (13.287712379549449f / 16.f)); float s, cs; sincos_f((float)pos * inv, s, cs); ROPE[2 * e] = cs; ROPE[2 * e + 1] = s; } }
    { const float* wsp = A.in[18]; bf16* o = (bf16*)(F.ws + WS_WSP);
      for (int e = gtid; e < DEPTH * 16 * 128 * 128 / 2; e += NTH) ((unsigned*)o)[e] = pkbf(wsp[2 * e], wsp[2 * e + 1]); }
    LAS float* scr = (LAS float*)(F.lds + F.wave * 16384);
    const int gw = F.vcu * NWAVES + F.wave, NGW = F.G * NWAVES;
    for (int it = gw; it < I_P0; it += NGW) weight_item(A, F.ws, it, scr, F.lane);
}

__device__ __forceinline__ void norm_phase(const Ctx& F, int l, int which, const float* src_lat, const float* src_ctx, int nrows, bool slab_add, bool write_hc) {
    const float* MOD = (const float*)(F.ws + WS_MOD); bf16* XN = (bf16*)(F.ws + WS_ACT);
    const int gw = F.vcu * NWAVES + F.wave, NGW = F.G * NWAVES;
    for (int m = gw; m < nrows; m += NGW) {
        const float* xr = m < ML ? src_lat + (size_t)m * DM : src_ctx + (size_t)(m - ML) * DM;
        const int cls = m < SEQ ? 0 : (m < ML ? 1 : 2);
        const float* sh = MOD + (size_t)(l * 3 + cls) * NMOD + (which ? 3 : 0) * DM; const float* gs = sh + DM;
        f32x4 v[16], gg[16], sg[16]; float ss = 0.f;
#pragma unroll
        for (int j = 0; j < 16; ++j) v[j] = *(const f32x4*)(xr + 4 * F.lane + 256 * j);

        if (slab_add && m >= ML) {
            const float* sl = (const float*)(F.ws + WS_SLAB) + (size_t)(m - ML) * DM + 4 * F.lane;
#pragma clang loop unroll(disable)
            for (int s = 0; s < 8; s += 2) {
                f32x4 ta[16], tb[16];
#pragma unroll
                for (int j = 0; j < 16; ++j) { ta[j] = *(const f32x4*)(sl + (size_t)s * MC * DM + 256 * j); tb[j] = *(const f32x4*)(sl + (size_t)(s + 1) * MC * DM + 256 * j); }
                __builtin_amdgcn_sched_barrier(0);
#pragma unroll
                for (int j = 0; j < 16; ++j) v[j] += ta[j] + tb[j];
                __builtin_amdgcn_sched_barrier(0);
            }
            if (write_hc) { float* hc = (float*)(F.ws + WS_HC) + (size_t)(m - ML) * DM + 4 * F.lane;
#pragma unroll
                for (int j = 0; j < 16; ++j) *(f32x4*)(hc + 256 * j) = v[j]; }
        }
#pragma unroll
        for (int j = 0; j < 16; ++j) { gg[j] = *(const f32x4*)(gs + 4 * F.lane + 256 * j); sg[j] = *(const f32x4*)(sh + 4 * F.lane + 256 * j); }
#pragma unroll
        for (int j = 0; j < 16; ++j) ss += (v[j].x * v[j].x + v[j].y * v[j].y) + (v[j].z * v[j].z + v[j].w * v[j].w);
        const float rstd = __builtin_amdgcn_rsqf(wave_sum(ss, F.lane) * (1.f / DM) + EPS);
        unsigned long long* o8 = (unsigned long long*)(XN + (size_t)m * DM) + F.lane;
#pragma unroll
        for (int j = 0; j < 16; ++j) { const f32x4 g = gg[j], s = sg[j];
            const f32x4 y = v[j] * rstd * g + s;
            o8[64 * j] = (unsigned long long)pkbf(y.x, y.y) | ((unsigned long long)pkbf(y.z, y.w) << 32); }
    }
}

__device__ __forceinline__ void qk_phase(const Args& A, const Ctx& F, int l, int nrows_stat, bool kvf_ctx) {
    typedef unsigned u32x2 __attribute__((ext_vector_type(2)));
    const bf16* Z = (const bf16*)(F.ws + WS_Z); bf16* QK = (bf16*)(F.ws + WS_QK); const float* ROPE = (const float*)(F.ws + WS_ROPE); float* RST = (float*)(F.ws + WS_RST);
    const float* KVF = (const float*)(F.ws + WS_KVF); bf16* Zw = (bf16*)(F.ws + WS_Z);
    const int gw = F.vcu * NWAVES + F.wave, NGW = F.G * NWAVES, p = F.lane & 7, go = (F.lane >> 3) * 64 + 4 * p;
    constexpr float QC = 0.125f * 1.4426950408889634f;
    const f32x4 gq0 = *(const f32x4*)(A.in[12] + l * 64 + 4 * p) * QC, gq1 = *(const f32x4*)(A.in[12] + l * 64 + 32 + 4 * p) * QC;
    const f32x4 gk0 = *(const f32x4*)(A.in[13] + l * 64 + 4 * p), gk1 = *(const f32x4*)(A.in[13] + l * 64 + 32 + 4 * p);
    for (int m = gw; m < MT; m += NGW) {
        const bf16* zr = Z + (size_t)m * IN_DIM + ZC_Q + go; bf16* qr = QK + (size_t)m * DM + go; const bool lat = m < ML; const int t = m & (SEQ - 1);
        f32x4 cs = {1.f, 1.f, 1.f, 1.f}, sn = {0.f, 0.f, 0.f, 0.f};
        if (lat) { const float* rp = ROPE + ((size_t)t * 32 + 4 * p) * 2; const f32x4 w0 = *(const f32x4*)rp, w1 = *(const f32x4*)(rp + 4); cs = (f32x4){w0.x, w0.z, w1.x, w1.z}; sn = (f32x4){w0.y, w0.w, w1.y, w1.w}; }
        if (m < nrows_stat) {
            const bf16* vr = Z + (size_t)m * IN_DIM + ZC_VM; float ss = 0.f;
#pragma unroll
            for (int i = 0; i < 4; ++i) { float x[8]; unpack8(*(const v4u*)(vr + i * 512 + F.lane * 8), x);
#pragma unroll
                for (int e = 0; e < 8; ++e) ss += x[e] * x[e]; }
            ss = wave_sum(ss, F.lane); if (F.lane == 0) RST[m] = __builtin_amdgcn_rsqf(ss * (1.f / 2048.f) + EPS); }
        const bool fromf = kvf_ctx && !lat;
        if (fromf) {
            const float* vr = KVF + (size_t)(m - ML) * 4096 + 2048; bf16* vo = Zw + (size_t)m * IN_DIM + ZC_V;
#pragma unroll
            for (int i = 0; i < 4; ++i) { f32x4 ta[8], tb[8];
#pragma unroll
                for (int s = 0; s < 8; ++s) { ta[s] = *(const f32x4*)(vr + (size_t)s * MC * 4096 + i * 512 + F.lane * 8); tb[s] = *(const f32x4*)(vr + (size_t)s * MC * 4096 + i * 512 + F.lane * 8 + 4); }
                __builtin_amdgcn_sched_barrier(0);
                const f32x4 a = ((ta[0] + ta[1]) + (ta[2] + ta[3])) + ((ta[4] + ta[5]) + (ta[6] + ta[7])), b = ((tb[0] + tb[1]) + (tb[2] + tb[3])) + ((tb[4] + tb[5]) + (tb[6] + tb[7]));
                v4u w; w.x = pkbf(a.x, a.y); w.y = pkbf(a.z, a.w); w.z = pkbf(b.x, b.y); w.w = pkbf(b.z, b.w); *(v4u*)(vo + i * 512 + F.lane * 8) = w; }
        }
        u32x2 wa[8], wb[8];
        if (!fromf) {
#pragma unroll
            for (int i = 0; i < 8; ++i) { wa[i] = *(const u32x2*)(zr + i * 512); wb[i] = *(const u32x2*)(zr + i * 512 + 32); }
        }
        __builtin_amdgcn_sched_barrier(0);
#pragma unroll
        for (int i = 0; i < 8; ++i) {
            f32x4 x1, x2;
            if (fromf) { if (i < 4) continue; const float* kr = KVF + (size_t)(m - ML) * 4096 + (i - 4) * 512 + go; f32x4 ta[8], tb[8];
#pragma unroll
                for (int s = 0; s < 8; ++s) { ta[s] = *(const f32x4*)(kr + (size_t)s * MC * 4096); tb[s] = *(const f32x4*)(kr + (size_t)s * MC * 4096 + 32); }
                __builtin_amdgcn_sched_barrier(0);
                x1 = ((ta[0] + ta[1]) + (ta[2] + ta[3])) + ((ta[4] + ta[5]) + (ta[6] + ta[7])); x2 = ((tb[0] + tb[1]) + (tb[2] + tb[3])) + ((tb[4] + tb[5]) + (tb[6] + tb[7])); }
            else { const u32x2 w0 = wa[i], w1 = wb[i];
                x1 = (f32x4){blo(w0.x), bhi(w0.x), blo(w0.y), bhi(w0.y)}; x2 = (f32x4){blo(w1.x), bhi(w1.x), blo(w1.y), bhi(w1.y)}; }
            float ss = (x1.x * x1.x + x1.y * x1.y) + (x1.z * x1.z + x1.w * x1.w) + (x2.x * x2.x + x2.y * x2.y) + (x2.z * x2.z + x2.w * x2.w);
            ss += sx(ss, 1, F.lane); ss += sx(ss, 2, F.lane); ss += sx(ss, 4, F.lane);
            const float r = __builtin_amdgcn_rsqf(ss * (1.f / 64.f) + EPS);
            x1 = x1 * r * (i < 4 ? gq0 : gk0); x2 = x2 * r * (i < 4 ? gq1 : gk1);
            const f32x4 y1 = x1 * cs - x2 * sn, y2 = x2 * cs + x1 * sn;
            u32x2 o0, o1; o0.x = pkbf(y1.x, y1.y); o0.y = pkbf(y1.z, y1.w); o1.x = pkbf(y2.x, y2.y); o1.y = pkbf(y2.z, y2.w);
            *(u32x2*)(qr + i * 512) = o0; *(u32x2*)(qr + i * 512 + 32) = o1;
        }
    }
}

__device__ __forceinline__ void conv_phase(const Args& A, const Ctx& F, int l, int nrows) {
    const bf16* Z = (const bf16*)(F.ws + WS_Z); bf16* CV = (bf16*)(F.ws + WS_XB);
    const float* cw = A.in[9] + (size_t)l * 3 * 2048; const float* cb = A.in[10] + (size_t)l * 2048;
    const int gtid = F.vcu * (NWAVES * 64) + F.tid, NTH = F.G * NWAVES * 64;
    for (int it = gtid; it < (nrows / 2) * 256; it += NTH) {
        const int m = 2 * (it >> 8), c = (it & 255) * 8;
        const int t = m < ML ? (m & (SEQ - 1)) : ((m - ML) & (CTXL - 1)), T = m < ML ? SEQ : CTXL;
        const bf16* zr = Z + (size_t)m * IN_DIM + c;
        const bool hp = t > 0, hn = t + 2 < T;
        const v4u zero = {0u, 0u, 0u, 0u};
        const v4u bgA = *(const v4u*)(zr + ZC_BG), bgB = *(const v4u*)(zr + IN_DIM + ZC_BG);
        const v4u c0 = *(const v4u*)(zr + ZC_CG), x0 = *(const v4u*)(zr + ZC_XIN), c1 = *(const v4u*)(zr + IN_DIM + ZC_CG), x1 = *(const v4u*)(zr + IN_DIM + ZC_XIN);
        const v4u cp = hp ? *(const v4u*)(zr - IN_DIM + ZC_CG) : zero, xp = hp ? *(const v4u*)(zr - IN_DIM + ZC_XIN) : zero;
        const v4u cn = hn ? *(const v4u*)(zr + 2 * IN_DIM + ZC_CG) : zero, xn = hn ? *(const v4u*)(zr + 2 * IN_DIM + ZC_XIN) : zero;
        const f32x4 w00 = *(const f32x4*)(cw + c), w01 = *(const f32x4*)(cw + c + 4), w10 = *(const f32x4*)(cw + 2048 + c), w11 = *(const f32x4*)(cw + 2048 + c + 4);
        const f32x4 w20 = *(const f32x4*)(cw + 4096 + c), w21 = *(const f32x4*)(cw + 4096 + c + 4), b0 = *(const f32x4*)(cb + c), b1 = *(const f32x4*)(cb + c + 4);
        float a[8], b[8], zp[8], z0[8], z1[8], zn[8], gA[8], gB[8];
        unpack8(cp, a); unpack8(xp, b);
#pragma unroll
        for (int e = 0; e < 8; ++e) zp[e] = a[e] * b[e];
        unpack8(c0, a); unpack8(x0, b);
#pragma unroll
        for (int e = 0; e < 8; ++e) z0[e] = a[e] * b[e];
        unpack8(c1, a); unpack8(x1, b);
#pragma unroll
        for (int e = 0; e < 8; ++e) z1[e] = a[e] * b[e];
        unpack8(cn, a); unpack8(xn, b);
#pragma unroll
        for (int e = 0; e < 8; ++e) zn[e] = a[e] * b[e];
        unpack8(bgA, gA); unpack8(bgB, gB);
        float yA[8], yB[8];
#pragma unroll
        for (int e = 0; e < 4; ++e) {
            yA[e] = gA[e] * (zp[e] * w00[e] + z0[e] * w10[e] + z1[e] * w20[e] + b0[e]); yA[4 + e] = gA[4 + e] * (zp[4 + e] * w01[e] + z0[4 + e] * w11[e] + z1[4 + e] * w21[e] + b1[e]);
            yB[e] = gB[e] * (z0[e] * w00[e] + z1[e] * w10[e] + zn[e] * w20[e] + b0[e]); yB[4 + e] = gB[4 + e] * (z0[4 + e] * w01[e] + z1[4 + e] * w11[e] + zn[4 + e] * w21[e] + b1[e]); }
        *(v4u*)(CV + (size_t)m * 2048 + c) = pack8(yA); *(v4u*)(CV + (size_t)(m + 1) * 2048 + c) = pack8(yB);
    }
}

__device__ __forceinline__ void mlp_unit(const Args& A, const Ctx& F, int l, int chunk, int g) {
    const bf16* Z = (const bf16*)(F.ws + WS_Z); bf16* MO = (bf16*)(F.ws + WS_XB) + (size_t)2 * MT * 2048; const float* RST = (const float*)(F.ws + WS_RST);
    const bf16* WSP = (const bf16*)(F.ws + WS_WSP) + ((size_t)l * 16 + g) * 128 * 128;
    const float* gnorm = A.in[17] + (size_t)l * 2048 + g * 128; const float* bsp = A.in[19] + ((size_t)l * 16 + g) * 128;
    LAS unsigned char* Vl = F.lds;
    const int r32 = F.lane & 31, hi = F.lane >> 5, rb = F.wave & 3, ch = F.wave >> 2, sr = F.tid >> 4, sc = (F.tid & 15) * 8, row0 = chunk * 128;
    att::bf16x8 pa[2][4];
#pragma unroll
    for (int kt = 0; kt < 2; ++kt)
#pragma unroll
        for (int s = 0; s < 4; ++s) pa[kt][s] = *(const att::bf16x8*)(WSP + (size_t)(32 * rb + r32) * 128 + 64 * kt + 16 * s + 8 * hi);
    const f32x4 gn0 = *(const f32x4*)(gnorm + sc), gn1 = *(const f32x4*)(gnorm + sc + 4);
#pragma unroll
    for (int i = 0; i < 4; ++i) { const int q = sr + 32 * i; float x[8]; unpack8(*(const v4u*)(Z + (size_t)(row0 + q) * IN_DIM + ZC_VM + g * 128 + sc), x);
        const float r = RST[row0 + q];
#pragma unroll
        for (int e = 0; e < 4; ++e) { x[e] = x[e] * r * gn0[e]; x[4 + e] = x[4 + e] * r * gn1[e]; }
        *(LAS v4u*)(Vl + (q >> 6) * 16384 + att::v_st(q & 63, sc)) = pack8(x); }
    __syncthreads();
    att::f32x16 acc0 = {}, acc1 = {};
#pragma unroll
    for (int kt = 0; kt < 2; ++kt) { const int vb = (int)(uintptr_t)Vl + kt * 16384 + ch * 1024 + att::v_rd_base(F.lane);
        att::pv_one<0>(acc0, vb, pa[kt][0], pa[kt][1], pa[kt][2], pa[kt][3]); att::pv_one<1>(acc1, vb, pa[kt][0], pa[kt][1], pa[kt][2], pa[kt][3]); }
    float bias[16]; bf16 u0[16], u1[16];
    const int col = g * 128 + ch * 64 + r32;
#pragma unroll
    for (int r = 0; r < 16; ++r) { const int pr = 32 * rb + att::crow(r, hi); const size_t row = (size_t)(row0 + pr);
        bias[r] = bsp[pr]; u0[r] = Z[row * IN_DIM + ZC_U + col]; u1[r] = Z[row * IN_DIM + ZC_U + col + 32]; }
    __builtin_amdgcn_sched_barrier(0);
#pragma unroll
    for (int r = 0; r < 16; ++r) { const int pr = 32 * rb + att::crow(r, hi); const size_t row = (size_t)(row0 + pr);
        const float a0 = __uint_as_float((unsigned)u0[r] << 16), a1 = __uint_as_float((unsigned)u1[r] << 16);
        MO[row * 2048 + col] = (bf16)(pkbf(a0 * (acc0[r] + bias[r]), 0.f) & 0xffffu); MO[row * 2048 + col + 32] = (bf16)(pkbf(a1 * (acc1[r] + bias[r]), 0.f) & 0xffffu); }
    __syncthreads();
}

__device__ __forceinline__ void attn_phase(const Args& A, const Ctx& F, int l, bool with_ctx, float lam_init) {
    static_assert(att::SHM_ATTN <= RING_BYTES, "attention LDS vs frame");
    const int nchunk = (with_ctx ? MT : ML) / 128;
    const bf16* Z = (const bf16*)(F.ws + WS_Z); const bf16* QK = (const bf16*)(F.ws + WS_QK); bf16* AO = (bf16*)(F.ws + WS_XB) + (size_t)MT * 2048;
    float* OS = (float*)(F.ws + WS_OS) + (size_t)F.vcu * 256 * 128;
    const float* lq = A.in[14] + (size_t)l * 256;
    const float s01 = wave_sum(lq[F.lane] * lq[64 + F.lane], F.lane), s23 = wave_sum(lq[128 + F.lane] * lq[192 + F.lane], F.lane);
    const float lam = __uint_as_float(__builtin_amdgcn_readfirstlane(__float_as_uint(expf(s01) - expf(s23) + lam_init))), osc = 1.f - lam_init;
    const float* subg = A.in[15] + (size_t)l * 128;
    float gqm = fabsf(A.in[12][l * 64 + F.lane]), gkm = fabsf(A.in[13][l * 64 + F.lane]);
#pragma unroll
    for (int o = 1; o < 64; o <<= 1) { gqm = fmaxf(gqm, sx(gqm, o, F.lane)); gkm = fmaxf(gkm, sx(gkm, o, F.lane)); }
    const float m0c = __uint_as_float(__builtin_amdgcn_readfirstlane(__float_as_uint(0.125f * 64.f * 1.02f * gqm * gkm * 1.4426950408889634f)));
    const int npair = 1024 + (with_ctx ? 32 : 0);
    for (int u = F.vcu; u < npair; u += F.G) {
        const bool isl = u < 1024; const int bh = isl ? (u >> 5) : (u - 1024), b = bh >> 4, h = bh & 15;
        const int qrow = isl ? b * SEQ + (u & 31) * 256 : ML + b * CTXL;
        const int rowa = isl ? b * SEQ : qrow, nt0 = isl ? SEQ / 64 : CTXL / 64, rowb = ML + b * CTXL, NT = isl ? SEQ / 64 + CTXL / 64 : CTXL / 64;
#pragma clang loop unroll(disable)
        for (int mp = 0; mp < 2; ++mp)
            att::attn_unit(mp, QK + (size_t)qrow * DM + h * 128 + mp * 64, QK + 2048 + h * 128 + mp * 64, Z + ZC_V + h * 128, OS, AO + (size_t)qrow * 2048 + h * 128, subg, lam, osc, m0c,
                           rowa, nt0, rowb, NT, (char*)F.lds, F.tid);
    }
    {   unsigned* tk = (unsigned*)(F.ws + WS_CTL) + 131072 + (8 + l) * 32; volatile LAS unsigned* slot = (volatile LAS unsigned*)(F.lds + 147440); const int nu = nchunk * 16;
        __syncthreads();
        if (F.tid == 0) slot[0] = __hip_atomic_fetch_add(tk, 1u, __ATOMIC_RELAXED, __HIP_MEMORY_SCOPE_AGENT);
        __syncthreads();
#pragma clang loop unroll(disable)
        for (int k = 0;; ++k) {
            const int u = __builtin_amdgcn_readfirstlane((int)slot[k & 1]);
            if (u >= nu) break;
            unsigned t = 0u; if (F.tid == 0) t = __hip_atomic_fetch_add(tk, 1u, __ATOMIC_RELAXED, __HIP_MEMORY_SCOPE_AGENT);
            mlp_unit(A, F, l, u >> 4, u & 15);
            if (F.tid == 0) slot[(k + 1) & 1] = t;
            __syncthreads();
        }
    }
}

__global__ void __launch_bounds__(NWAVES * 64, 2) fwd_kernel(Args args) {
    extern __shared__ __attribute__((aligned(16))) unsigned char lds[];
    Ctx F;
    F.lds = (LAS unsigned char*)lds; F.tid = threadIdx.x; F.lane = F.tid & 63; F.wave = __builtin_amdgcn_readfirstlane(F.tid >> 6);
    F.G = gridDim.x; F.bx = blockIdx.x; { const int bx = blockIdx.x; F.vcu = (F.G % 8 == 0) ? (bx % 8) * (F.G / 8) + bx / 8 : bx; }
    F.out = args.out; F.ws = args.ws;
    volatile LAS unsigned* MISC = (volatile LAS unsigned*)(F.lds + MISC_OFF);
    for (int u = F.tid; u < (LDS_BYTES - RING_BYTES) / 4; u += NWAVES * 64) ((LAS unsigned*)(F.lds + RING_BYTES))[u] = 0u;
    __syncthreads();
    const int lo = args.ph_lo, hi = args.ph_hi;
    unsigned* barw = (unsigned*)(F.ws + WS_CTL) + CW_BAR + args.bar_region * XCD_BAR_WORDS;
    XcdBarrier bar; bar.bar = barw; bar.x = 0; bar.st = nullptr;
    if (hi - lo > 1) bar = xcd_barrier_post(barw, MISC + 8);
#ifndef PHM
#define PHM 0xfff
#endif
#define IN(k) (lo <= (k) && (k) < hi)
#ifndef PROBE_BASE
#define PROBE_BASE 0
#endif
#ifdef PROBE_PHASE
#define PT0(k) do { if ((k) == PROBE_PHASE) { pc0 = __builtin_readcyclecounter(); pt0 = __builtin_amdgcn_s_memrealtime(); } } while (0)
#define PT1(k) do { if ((k) == PROBE_PHASE) { pc1 = __builtin_readcyclecounter(); pt1 = __builtin_amdgcn_s_memrealtime(); } } while (0)
#else
#define PT0(k) do {} while (0)
#define PT1(k) do {} while (0)
#endif
#if defined(CLOCK_PROBE) && CLOCK_PROBE == 9
#define SEAM(k) do { if (IN(k) && IN((k) + 1)) { const unsigned long long ta_ = __builtin_amdgcn_s_memrealtime(); xcd_barrier(bar); pwait += __builtin_amdgcn_s_memrealtime() - ta_; } } while (0)
#else
#define SEAM(k) do { if (IN(k) && IN((k) + 1)) xcd_barrier(bar); } while (0)
#endif
#define SEAMF(k) do { if (IN(k) && IN((k) + 1)) xcd_barrier_fill(bar, args, F, l == 0); } while (0)

#if defined(CLOCK_PROBE) || defined(PROBE_PHASE)
    unsigned long long pc0 = 0, pc1 = 0, pt0 = 0, pt1 = 1, pwait = 0; (void)pwait; (void)pc0; (void)pc1;
#endif
    if ((PHM & 1) && IN(0)) { PT0(0); const Ctx P = launder(F); p0_prologue(args, P); PT1(0); SEAM(0); }

    for (int l = 0; l < DEPTH; ++l) {
        const int pb = 1 + PPL * l; const bool last = l + 1 == DEPTH; const int MR = last ? ML : MT;
#define TK(k) ((unsigned*)(P.ws + WS_CTL) + 131072 + (l * 4 + (k)) * 32)
#define PTRS() bf16* Zb = (bf16*)(P.ws + WS_Z); bf16* ACT = (bf16*)(P.ws + WS_ACT); bf16* XB = (bf16*)(P.ws + WS_XB); float* YF = (float*)(P.ws + WS_O12); float* HC = (float*)(P.ws + WS_HC); \
        bf16* HID = (bf16*)(P.ws + WS_Z); const unsigned char* wl = P.ws + WS_W + (size_t)l * W_LAYER; const float* MODl = (const float*)(P.ws + WS_MOD) + (size_t)l * 3 * NMOD; \
        const float* h_lat = l == 0 ? args.in[0] : P.out; const float* h_ctx = l == 0 ? args.in[2] : HC; \
        (void)Zb; (void)ACT; (void)XB; (void)YF; (void)HC; (void)HID; (void)wl; (void)MODl; (void)h_lat; (void)h_ctx;
        if ((PHM & 2) && IN(pb + 0)) { PT0(pb + 0); const Ctx P = launder(F); PTRS(); norm_phase(P, l, 0, h_lat, h_ctx, MT, l > 0, false); if (l == 1) { __syncthreads(); while (weight_fill_one(args, P)) {} } PT1(pb + 0); SEAM(pb + 0); }
        if ((PHM & 4) && IN(pb + 1)) { PT0(pb + 1); const Ctx P = launder(F); PTRS();
            pg8::Gemm g{ACT, (const bf16*)(wl + W_IN), MT, IN_DIM, DM}; pg8::InOrder S; S.init(P.G, P.bx, last); S.S.ticketed(TK(0), P.lds);
            pg8::EpiZ E{Zb, (float*)(P.ws + WS_KVF)};
            pg8::gemm_phase<pg8::EpiZ, pg8::InOrder, true, true>(P.lds, P.tid, g, S, E);
            PT1(pb + 1); SEAMF(pb + 1);
        }
        if ((PHM & 8) && IN(pb + 2)) { PT0(pb + 2); { const Ctx P = launder(F); qk_phase(args, P, l, MR, last); } { const Ctx P = launder(F); conv_phase(args, P, l, MR); } PT1(pb + 2); SEAM(pb + 2); }
        if ((PHM & 16) && IN(pb + 3)) { PT0(pb + 3); const Ctx P = launder(F); attn_phase(args, P, l, !last, l == 0 ? 0.2f : 0.35550906759096924f); PT1(pb + 3); SEAM(pb + 3); }
        if ((PHM & 64) && IN(pb + 4)) { PT0(pb + 4); const Ctx P = launder(F); PTRS();
            pg8::Gemm g{XB, (const bf16*)(wl + W_BR), 3 * MT, 3 * DM, 2048}; pg8::BranchOrder S{P.G, P.bx, MR / 256};
            pg8::EpiBr E{Zb, ACT};
            pg8::gemm_phase<pg8::EpiBr, pg8::BranchOrder, true, true>(P.lds, P.tid, g, S, E);
            PT1(pb + 4); SEAMF(pb + 4);
        }
        if ((PHM & 128) && IN(pb + 5)) { PT0(pb + 5); const Ctx P = launder(F); PTRS();
            pg8::Gemm g{ACT, (const bf16*)(wl + W_O), MR, DM, DM}; pg8::ResOrder S; S.init(P.G, P.bx, DM, !last); S.S.ticketed(TK(1), P.lds);
            pg8::EpiRes E{h_lat, h_ctx, P.out, HC, MODl + 2 * DM, (float*)(P.ws + WS_SLAB)};
            pg8::gemm_phase<pg8::EpiRes, pg8::ResOrder, true, true>(P.lds, P.tid, g, S, E);
            PT1(pb + 5); SEAMF(pb + 5);
        }
        if ((PHM & 256) && IN(pb + 6)) { PT0(pb + 6); const Ctx P = launder(F); PTRS(); norm_phase(P, l, 1, P.out, l == 0 ? args.in[2] : HC, MR, !last, !last); if (l == 0) { __syncthreads(); while (weight_fill_peek(P) < (long)I_LAYER) (void)weight_fill_one(args, P); } PT1(pb + 6); SEAM(pb + 6); }
        if ((PHM & 512) && IN(pb + 7)) { PT0(pb + 7); const Ctx P = launder(F); PTRS();
            pg8::Gemm g{ACT, (const bf16*)(wl + W_GU), MR, 2 * FF, DM}; pg8::StaticOrder S; S.init(MR, 2 * FF, P.G, P.bx, DM); S.ticketed(TK(2), P.lds);
            pg8::EpiGU E{HID};
            pg8::gemm_phase<pg8::EpiGU, pg8::StaticOrder, true, true>(P.lds, P.tid, g, S, E);
            PT1(pb + 7); SEAMF(pb + 7);
        }
        if ((PHM & 1024) && IN(pb + 8)) { PT0(pb + 8); const Ctx P = launder(F); PTRS();
            pg8::Gemm g{HID, (const bf16*)(wl + W_D), MR, DM, FF}; pg8::ResOrder S; S.init(P.G, P.bx, FF, !last); S.S.ticketed(TK(3), P.lds);
            pg8::EpiRes E{P.out, HC, P.out, HC, MODl + 5 * DM, (float*)(P.ws + WS_SLAB)};
            pg8::gemm_phase<pg8::EpiRes, pg8::ResOrder, true, true>(P.lds, P.tid, g, S, E);
            PT1(pb + 8); SEAMF(pb + 8);
        }
    }
#if defined(CLOCK_PROBE) || defined(PROBE_PHASE)
    {
        unsigned* pa = (unsigned*)(F.ws + WS_CTL) + 65536;
        if (threadIdx.x == 0) pa[blockIdx.x] = (unsigned)(pt1 - pt0);
        xcd_barrier(bar);
        float val = 0.f;
#ifdef PROBE_PHASE
        if (blockIdx.x == 0 && threadIdx.x == 0) { unsigned mx = 0, mn = 0xffffffffu; unsigned long long sm = 0; int imx = 0;
            for (unsigned b = 0; b < gridDim.x; ++b) { const unsigned v = __hip_atomic_load(pa + b, __ATOMIC_RELAXED, __HIP_MEMORY_SCOPE_AGENT); sm += v; if (v > mx) { mx = v; imx = (int)b; } if (v < mn) mn = v; }
            const float ghz = (float)(pc1 - pc0) / (float)(pt1 - pt0) * 0.1f;
            float xm[8]; unsigned xc[8];
            for (int x = 0; x < 8; ++x) { xm[x] = 0.f; xc[x] = 0; }
            for (unsigned b = 0; b < gridDim.x; ++b) { const unsigned v = __hip_atomic_load(pa + b, __ATOMIC_RELAXED, __HIP_MEMORY_SCOPE_AGENT); xm[b & 7] += (float)v; xc[b & 7]++; }
            float xmax = 0.f, xmin = 1e30f; int ixmax = 0;
            for (int x = 0; x < 8; ++x) { const float m = xm[x] / (float)xc[x]; if (m > xmax) { xmax = m; ixmax = x; } if (m < xmin) xmin = m; }
            if (PROBE_KIND == 9) val = ((float)mx - (float)(sm / gridDim.x)) * 0.01f + 35.f; else if (PROBE_KIND == 8) val = (float)mx * 0.01f - (float)PROBE_BASE; else if (PROBE_KIND == 7) val = 10.f * ((float)mx * 0.001f - (float)PROBE_BASE); else if (PROBE_KIND == 5) val = (xmax - xmin) * 0.01f; else if (PROBE_KIND == 6) val = 40.f + 10.f * (float)ixmax; else
            val = PROBE_KIND == 0 ? (float)mx * 0.001f : PROBE_KIND == 1 ? (float)(mx - mn) * 0.01f : PROBE_KIND == 2 ? (float)(sm / gridDim.x) * 0.001f : PROBE_KIND == 3 ? (float)(imx & 7) * 10.f + 1.f : 100.f * ghz; }
#else
        val = CLOCK_PROBE == 9 ? (float)pwait * 0.001f : 0.f;
#endif
        f32x4* o4 = (f32x4*)F.out; const size_t n4 = (size_t)ML * DM / 4, per = n4 / gridDim.x;
        for (size_t i = (size_t)blockIdx.x * per + threadIdx.x; i < (size_t)(blockIdx.x + 1) * per; i += NWAVES * 64) o4[i] = (f32x4){3000.f, 3000.f, 3000.f, 3000.f};
        __syncthreads();
        if (blockIdx.x == 0 && threadIdx.x == 0) { asm volatile("s_waitcnt vmcnt(0)" ::: "memory"); F.out[0] = 100.f * val; }
    }
#endif
#undef IN
#undef SEAM
}

#ifndef MK_PER_PHASE
#define MK_PER_PHASE 0
#endif
extern "C" void kernel_launch(void* const* d_in, const int* in_sizes, int n_in, void* d_out, int out_size, void* d_ws, size_t ws_size, hipStream_t stream) {
    static int grid = 0;
    if (grid == 0) {
        if (n_in != 25 || in_sizes[0] != ML * DM || out_size != ML * DM || ws_size < WS_END) {
            fprintf(stderr, "kernel_launch: shape mismatch: n_in %d in0 %d out %d ws %zu (need %zu); nothing launched\n", n_in, n_in > 0 ? in_sizes[0] : -1, out_size, ws_size, (size_t)WS_END); grid = -1; return; }
        int dev = 0, cus = 0, per_cu = 0;
        if (hipGetDevice(&dev) != hipSuccess || hipDeviceGetAttribute(&cus, hipDeviceAttributeMultiprocessorCount, dev) != hipSuccess) { grid = -1; return; }
        if (hipFuncSetAttribute((const void*)fwd_kernel, hipFuncAttributeMaxDynamicSharedMemorySize, LDS_BYTES) != hipSuccess) { fprintf(stderr, "kernel_launch: hipFuncSetAttribute failed\n"); grid = -1; return; }
        if (hipOccupancyMaxActiveBlocksPerMultiprocessor(&per_cu, (const void*)fwd_kernel, NWAVES * 64, LDS_BYTES) != hipSuccess || per_cu < 1)
            fprintf(stderr, "kernel_launch: note: occupancy query reports %d workgroups per CU\n", per_cu);
        (void)hipGetLastError();
        grid = cus > MAX_GRID ? MAX_GRID : cus;
    }
    if (grid < 0) return;
    if (hipMemsetAsync((char*)d_ws + WS_CTL, 0, CTL_ZERO_BYTES, stream) != hipSuccess) return;
    Args a{};
    for (int i = 0; i < 25; ++i) a.in[i] = (const float*)d_in[i];
    a.out = (float*)d_out; a.ws = (unsigned char*)d_ws; a.pad = 0;
#if MK_PER_PHASE
    constexpr int NL = N_PHASES; int rl[NL][2]; for (int p = 0; p < NL; ++p) { rl[p][0] = p; rl[p][1] = p + 1; }
#elif defined(PROBE_SEQ)
    const int rl[][2] = PROBE_SEQ; constexpr int NL = sizeof(rl) / sizeof(rl[0]);
#else
    constexpr int NL = 1; const int rl[1][2] = {{0, N_PHASES}};
#endif
    for (int li = 0; li < NL; ++li) { a.ph_lo = rl[li][0]; a.ph_hi = rl[li][1]; a.bar_region = li;
        hipLaunchKernelGGL(fwd_kernel, dim3(grid), dim3(NWAVES * 64), LDS_BYTES, stream, a); }
    const hipError_t le = hipPeekAtLastError();
    if (le != hipSuccess) fprintf(stderr, "kernel_launch: launch failed: %s\n", hipGetErrorName(le));
}
```
